# Optimizing an MI355X kernel written in HIP

```python
import math
import jax, jax.numpy as jnp
from jax import lax
import numpy as np

D_MODEL = 1024
BATCH = 8
SEQ = 4096
DEPTH = 1

PLE_DIM = 256
MIX_WIDTH = D_MODEL
ATTN_WIDTH = MIX_WIDTH // 2
HYENA_WIDTH = MIX_WIDTH - ATTN_WIDTH
DIFF_HEADS = 4
DIFF_HEAD_DIM = ATTN_WIDTH // (2 * DIFF_HEADS)
DIFF_V_DIM = 2 * DIFF_HEAD_DIM
HYENA_GROUPS = 8
SHORT_CONV = 3
FILTER_EMB = 33
FILTER_ORDER = 64
FILTER_INNER = 2
FAST_DECAY_PCT = 0.3
SLOW_DECAY_PCT = 1.5
DECAY_TARGET = 1e-2
ROPE_THETA = 10000.0
N_EXPERTS = 32
TOP_K = 4
D_FF = D_MODEL
SWIGLU_ALPHA = 1.702
SWIGLU_LIMIT = 7.0
EXPERT_BLOCK = 256
Q_BLOCK = 128
EPS = 1e-6
SUBLN_EPS = 1e-5
IN_PROJ_WIDTH = 3 * ATTN_WIDTH + 3 * HYENA_WIDTH

kernel_name = 'hymba_diffattn_hyena_moe_block'


def rms_norm(x, g, eps=EPS):
    xf = x.astype(jnp.float32)
    y = xf * lax.rsqrt(jnp.mean(xf * xf, axis=-1, keepdims=True) + eps)
    return (y * g.astype(jnp.float32)).astype(x.dtype)


def apply_rope(x):
    S, d = x.shape[1], x.shape[-1]
    pos = jnp.arange(S, dtype=jnp.float32)
    inv = ROPE_THETA ** (-jnp.arange(0, d, 2, dtype=jnp.float32) / d)
    ang = pos[:, None] * inv[None, :]
    cos = jnp.cos(ang)[None, :, None, None, :]
    sin = jnp.sin(ang)[None, :, None, None, :]
    xf = x.astype(jnp.float32)
    x1, x2 = xf[..., : d // 2], xf[..., d // 2:]
    return jnp.concatenate([x1 * cos - x2 * sin, x2 * cos + x1 * sin], axis=-1).astype(x.dtype)


def diff_attention(q, k, v, lam, lambda_init, g_subln):
    B, S, H, _, dh = q.shape
    dv = v.shape[-1]
    scale = dh ** -0.5
    nq = S // Q_BLOCK
    qb = jnp.moveaxis(q.reshape(B, nq, Q_BLOCK, H, 2, dh), 1, 0)

    def block(qi):
        s = jnp.einsum('bqhcd,bkhcd->bhcqk', qi, k, preferred_element_type=jnp.float32) * scale
        pr = jax.nn.softmax(s, axis=-1)
        a = pr[:, :, 0] - lam * pr[:, :, 1]
        return jnp.einsum('bhqk,bkhe->bqhe', a.astype(v.dtype), v)

    o = lax.map(block, qb)
    o = jnp.moveaxis(o, 0, 1).reshape(B, S, H, dv)
    o = rms_norm(o, g_subln, SUBLN_EPS) * (1.0 - lambda_init)
    return o.reshape(B, S, H * dv)


def short_conv(x, w, b):
    half = SHORT_CONV // 2
    S = x.shape[1]
    xp = jnp.pad(x, ((0, 0), (half, SHORT_CONV - 1 - half), (0, 0)))
    y = b
    for j in range(SHORT_CONV):
        y = y + xp[:, j:j + S] * w[j]
    return y


def hyena_filters(seq, w1, b1, w_inner, b_inner, freq, w_out):
    f32 = jnp.float32
    pos = jnp.arange(seq, dtype=f32)
    t = pos / (seq - 1)
    bands = (FILTER_EMB - 1) // 2
    f = jnp.linspace(1e-4, bands - 1, bands, dtype=f32)
    fw = ((2.0 * math.pi / seq) * pos)[:, None] * f[None, :]
    z = jnp.concatenate([t[:, None], jnp.cos(fw), -jnp.sin(fw)], axis=-1)
    h = jnp.sin(freq[0].astype(f32) * (z @ w1.astype(f32) + b1.astype(f32)))
    for j in range(FILTER_INNER):
        h = jnp.sin(freq[j + 1].astype(f32) * (h @ w_inner[j].astype(f32) + b_inner[j].astype(f32)))
    h = h @ w_out.astype(f32)
    max_decay = math.log(DECAY_TARGET) / FAST_DECAY_PCT
    min_decay = math.log(DECAY_TARGET) / SLOW_DECAY_PCT
    deltas = jnp.abs(jnp.linspace(min_decay, max_decay, HYENA_WIDTH, dtype=f32))
    decay = jnp.exp(-t[:, None] * deltas[None, :])
    return h[:, :HYENA_WIDTH] * decay, h[:, HYENA_WIDTH:] * decay


def bidir_long_conv(u, h_fwd, h_bwd, d_skip):
    B, L, C = u.shape
    n = 2 * L
    lag0 = h_fwd[:1] + h_bwd[:1]
    kern = jnp.concatenate([lag0, h_fwd[1:], jnp.zeros((1, C), jnp.float32), h_bwd[:0:-1]], axis=0)
    u_f = jnp.fft.rfft(u.astype(jnp.float32), n=n, axis=1)
    k_f = jnp.fft.rfft(kern, n=n, axis=0)
    y = jnp.fft.irfft(u_f * k_f[None], n=n, axis=1)[:, :L]
    return (y + u.astype(jnp.float32) * d_skip.astype(jnp.float32)).astype(u.dtype)


def moe_ffn(h, router_w, router_b, w_gate, b_gate, w_up, b_up, w_down, b_down):
    B, S, D = h.shape
    T = B * S
    tok = h.reshape(T, D)
    logits = (tok @ router_w + router_b).astype(jnp.float32)
    top_logit, top_e = lax.top_k(logits, TOP_K)
    top_w = jax.nn.softmax(top_logit, axis=-1)
    A = T * TOP_K
    flat_e = top_e.reshape(A)
    order = jnp.argsort(flat_e)
    sorted_e = flat_e[order]
    sorted_tok = (order // TOP_K).astype(jnp.int32)
    sorted_w = top_w.reshape(A)[order]
    counts = jnp.bincount(flat_e, length=N_EXPERTS)
    padded = (counts + EXPERT_BLOCK - 1) // EXPERT_BLOCK * EXPERT_BLOCK
    pad_end = jnp.cumsum(padded)
    pad_start = pad_end - padded
    start = jnp.cumsum(counts) - counts
    dest = pad_start[sorted_e] + jnp.arange(A) - start[sorted_e]
    n_blocks = -(-A // EXPERT_BLOCK) + N_EXPERTS
    P = n_blocks * EXPERT_BLOCK
    slot_tok = jnp.full((P,), T, jnp.int32).at[dest].set(sorted_tok)
    slot_w = jnp.zeros((P,), jnp.float32).at[dest].set(sorted_w)
    block_e = jnp.minimum(
        jnp.searchsorted(pad_end, jnp.arange(n_blocks) * EXPERT_BLOCK, side='right'), N_EXPERTS - 1)
    tok_pad = jnp.concatenate([tok, jnp.zeros((1, D), tok.dtype)], axis=0)

    def expert_block(args):
        e, idx = args
        xb = tok_pad[idx]
        g = jnp.minimum(xb @ w_gate[e] + b_gate[e], SWIGLU_LIMIT)
        u = jnp.clip(xb @ w_up[e] + b_up[e], -SWIGLU_LIMIT, SWIGLU_LIMIT)
        a = (u + 1.0) * (g * jax.nn.sigmoid(SWIGLU_ALPHA * g))
        return a @ w_down[e] + b_down[e]

    y = lax.map(expert_block, (block_e, slot_tok.reshape(n_blocks, EXPERT_BLOCK)))
    y = y.reshape(P, D) * slot_w[:, None].astype(y.dtype)
    out = jax.ops.segment_sum(y, slot_tok, num_segments=T + 1)[:T]
    return out.reshape(B, S, D)


def setup_inputs(seed: int = 0) -> dict:
    key = jax.random.key(seed)
    ks = iter(jax.random.split(key, 48))

    def nrm(shape, scale):
        return jax.random.normal(next(ks), shape, jnp.float32) * scale

    def gain(shape):
        return 1.0 + nrm(shape, 0.02)

    Dh = HYENA_WIDTH
    return {
        'x': nrm((BATCH, SEQ, D_MODEL), 1.0),
        'p': nrm((DEPTH, BATCH, SEQ, PLE_DIM), 1.0),
        'g_mix': gain((DEPTH, D_MODEL)),
        'w_in': nrm((DEPTH, D_MODEL, IN_PROJ_WIDTH), D_MODEL ** -0.5),
        'hyena_conv_w': nrm((DEPTH, SHORT_CONV, 3 * Dh), SHORT_CONV ** -0.5),
        'hyena_conv_b': nrm((DEPTH, 3 * Dh), 0.02),
        'flt_w1': nrm((DEPTH, FILTER_EMB, FILTER_ORDER), FILTER_EMB ** -0.5),
        'flt_b1': nrm((DEPTH, FILTER_ORDER), 0.02),
        'flt_w_inner': nrm((DEPTH, FILTER_INNER, FILTER_ORDER, FILTER_ORDER), FILTER_ORDER ** -0.5),
        'flt_b_inner': nrm((DEPTH, FILTER_INNER, FILTER_ORDER), 0.02),
        'flt_freq': gain((DEPTH, FILTER_INNER + 1, FILTER_ORDER)),
        'flt_w_out': nrm((DEPTH, FILTER_ORDER, 2 * Dh), FILTER_ORDER ** -0.5),
        'hyena_d': nrm((DEPTH, Dh), 1.0),
        'hyena_gn': gain((DEPTH, Dh)),
        'lambda_q1': nrm((DEPTH, DIFF_HEAD_DIM), 0.1),
        'lambda_k1': nrm((DEPTH, DIFF_HEAD_DIM), 0.1),
        'lambda_q2': nrm((DEPTH, DIFF_HEAD_DIM), 0.1),
        'lambda_k2': nrm((DEPTH, DIFF_HEAD_DIM), 0.1),
        'attn_subln': gain((DEPTH, DIFF_V_DIM)),
        'w_out': nrm((DEPTH, MIX_WIDTH, D_MODEL), MIX_WIDTH ** -0.5),
        'g_ffn': gain((DEPTH, D_MODEL)),
        'router_w': nrm((DEPTH, D_MODEL, N_EXPERTS), D_MODEL ** -0.5),
        'router_b': nrm((DEPTH, N_EXPERTS), 0.01),
        'w_gate': nrm((DEPTH, N_EXPERTS, D_MODEL, D_FF), D_MODEL ** -0.5),
        'b_gate': nrm((DEPTH, N_EXPERTS, D_FF), 0.02),
        'w_up': nrm((DEPTH, N_EXPERTS, D_MODEL, D_FF), D_MODEL ** -0.5),
        'b_up': nrm((DEPTH, N_EXPERTS, D_FF), 0.02),
        'w_down': nrm((DEPTH, N_EXPERTS, D_FF, D_MODEL), D_FF ** -0.5),
        'b_down': nrm((DEPTH, N_EXPERTS, D_MODEL), 0.02),
        'w_ple': nrm((DEPTH, PLE_DIM, D_MODEL), PLE_DIM ** -0.5),
        'g_ple': gain((DEPTH, D_MODEL)),
        'w_ple_gate': nrm((DEPTH, D_MODEL, D_MODEL), D_MODEL ** -0.5),
        'b_ple_gate': nrm((DEPTH, D_MODEL), 0.02),
        'g_final': gain((D_MODEL,)),
    }


def reference(x, p, g_mix, w_in, hyena_conv_w, hyena_conv_b, flt_w1, flt_b1, flt_w_inner,
              flt_b_inner, flt_freq, flt_w_out, hyena_d, hyena_gn, lambda_q1, lambda_k1,
              lambda_q2, lambda_k2, attn_subln, w_out, g_ffn, router_w, router_b, w_gate,
              b_gate, w_up, b_up, w_down, b_down, w_ple, g_ple, w_ple_gate, b_ple_gate, g_final):
    B, S, _ = x.shape
    H, dh, dv = DIFF_HEADS, DIFF_HEAD_DIM, DIFF_V_DIM
    h = x
    for i in range(DEPTH):
        a = rms_norm(h, g_mix[i])
        proj = a @ w_in[i]
        q = proj[..., :ATTN_WIDTH].reshape(B, S, H, 2, dh)
        k = proj[..., ATTN_WIDTH:2 * ATTN_WIDTH].reshape(B, S, H, 2, dh)
        v = proj[..., 2 * ATTN_WIDTH:3 * ATTN_WIDTH].reshape(B, S, H, dv)
        hy_in = proj[..., 3 * ATTN_WIDTH:]

        lambda_init = 0.8 - 0.6 * math.exp(-0.3 * i)
        f32 = jnp.float32
        lam = (jnp.exp(jnp.sum(lambda_q1[i].astype(f32) * lambda_k1[i].astype(f32)))
               - jnp.exp(jnp.sum(lambda_q2[i].astype(f32) * lambda_k2[i].astype(f32)))
               + lambda_init)
        attn_out = diff_attention(apply_rope(q), apply_rope(k), v, lam, lambda_init, attn_subln[i])

        hy = short_conv(hy_in, hyena_conv_w[i], hyena_conv_b[i])
        hv = hy[..., :HYENA_WIDTH]
        hx0 = hy[..., HYENA_WIDTH:2 * HYENA_WIDTH]
        hx1 = hy[..., 2 * HYENA_WIDTH:]
        h_fwd, h_bwd = hyena_filters(S, flt_w1[i], flt_b1[i], flt_w_inner[i], flt_b_inner[i],
                                     flt_freq[i], flt_w_out[i])
        z = bidir_long_conv(hv * hx1, h_fwd, h_bwd, hyena_d[i]) * hx0
        z = rms_norm(z.reshape(B, S, HYENA_GROUPS, HYENA_WIDTH // HYENA_GROUPS),
                     hyena_gn[i].reshape(HYENA_GROUPS, HYENA_WIDTH // HYENA_GROUPS))
        hyena_out = z.reshape(B, S, HYENA_WIDTH)

        mix = jnp.concatenate([attn_out, hyena_out], axis=-1) @ w_out[i]
        h = h + mix

        h = h + moe_ffn(rms_norm(h, g_ffn[i]), router_w[i], router_b[i], w_gate[i], b_gate[i],
                        w_up[i], b_up[i], w_down[i], b_down[i])

        e = rms_norm(p[i] @ w_ple[i], g_ple[i])
        gate = jax.nn.sigmoid(h @ w_ple_gate[i] + b_ple_gate[i])
        h = h + gate * e
    return rms_norm(h, g_final)
```

```cpp
#include <hip/hip_runtime.h>
#include <stdint.h>
#include <stdio.h>

#ifndef MK_ONE_LAUNCH
#define MK_ONE_LAUNCH 1
#endif

#define LAS __attribute__((address_space(3)))
typedef unsigned short bf16_t;
typedef short bf16x8 __attribute__((ext_vector_type(8)));
typedef float f32x4 __attribute__((ext_vector_type(4)));
typedef unsigned u32x4 __attribute__((ext_vector_type(4)));
typedef unsigned u32x2 __attribute__((ext_vector_type(2)));

constexpr int T = 32768, DM = 1024, SEQ = 4096, NBATCH = 8, NH = 4, NEXP = 32, HW = 512;
constexpr int LDS_BYTES = 163840;

#define XB_TMO      128
#define XB_XCNT(j)  (256  + 64 * (j))
#define XB_XSUB(j)  (1280 + 64 * (j))
#define XB_XGEN(j)  (2304 + 64 * (j))
#define XB_TOP      3328
#define XB_TOPGEN   3392
#define XCD_BAR_WORDS 3456
#define XB_SPIN_CAP (1u << 18)

__device__ __forceinline__ unsigned xb_ld(unsigned* p)              { return __hip_atomic_load(p, __ATOMIC_RELAXED, __HIP_MEMORY_SCOPE_AGENT); }
__device__ __forceinline__ unsigned xb_add(unsigned* p, unsigned v) { return __hip_atomic_fetch_add(p, v, __ATOMIC_RELAXED, __HIP_MEMORY_SCOPE_AGENT); }
__device__ __forceinline__ unsigned xb_xcc_id() { return (unsigned)__builtin_amdgcn_s_getreg((3 << 11) | 20) & 0xFu; }
#define XB_SPIN(cond, bar) do { unsigned _sp = 0; while (cond) { __builtin_amdgcn_s_sleep(1); \
    if ((++_sp & 255u) == 0u) { if (xb_ld(&(bar)[XB_TMO])) break; if (_sp > XB_SPIN_CAP) { atomicAdd(&(bar)[XB_TMO], 1u); break; } } } } while (0)

struct XcdBarrier { unsigned* bar; unsigned x; volatile LAS unsigned* st; int wv; };
__device__ __forceinline__ unsigned lane_id_volatile() { unsigned l; asm volatile("v_mbcnt_lo_u32_b32 %0, -1, 0\n\tv_mbcnt_hi_u32_b32 %0, -1, %0" : "=v"(l)); return l; }
__device__ __forceinline__ bool xb_thread0(int wv) { return wv == 0 && lane_id_volatile() == 0u; }

__device__ __forceinline__ XcdBarrier xcd_barrier_post(unsigned* bar, volatile LAS unsigned* st, int wv) {
    XcdBarrier b; b.bar = bar; b.x = xb_xcc_id(); b.st = st; b.wv = wv;
    if (xb_thread0(wv)) (void)xb_add(&bar[XB_XCNT(b.x)], 1u);
    return b;
}
__device__ __forceinline__ void xcd_barrier_complete(unsigned* bar, unsigned x, unsigned& nloc, unsigned& nx) {
    const unsigned G = gridDim.x * gridDim.y * gridDim.z;
    unsigned sum, cnt, mine, sp = 0u;
    for (;;) {
        sum = 0u; cnt = 0u; mine = 0u;
#pragma unroll
        for (unsigned j = 0; j < 16; ++j) { const unsigned c = xb_ld(&bar[XB_XCNT(j)]); sum += c; cnt += (c > 0u) ? 1u : 0u; mine = (j == x) ? c : mine; }
        if (sum == G) break;
        __builtin_amdgcn_s_sleep(1);
        if ((++sp & 255u) == 0u) { if (xb_ld(&bar[XB_TMO])) break; if (sp > XB_SPIN_CAP) { atomicAdd(&bar[XB_TMO], 1u); break; } }
    }
    nloc = mine > 0u ? mine : 1u; nx = cnt > 0u ? cnt : 1u;
}
__device__ __forceinline__ void xcd_barrier(const XcdBarrier& b) {
    asm volatile("s_waitcnt vmcnt(0)" ::: "memory");
    __syncthreads();
    if (xb_thread0(b.wv)) {
        unsigned* bar = b.bar;
        __builtin_amdgcn_s_waitcnt(0);
        unsigned nloc = b.st[0], nx = b.st[1];
        if (nloc == 0u) { xcd_barrier_complete(bar, b.x, nloc, nx); b.st[0] = nloc; b.st[1] = nx; }
        const unsigned old = xb_add(&bar[XB_XSUB(b.x)], 1u);
        const unsigned gen = old / nloc;
        if (old + 1u == (gen + 1u) * nloc) {
            __builtin_amdgcn_fence(__ATOMIC_RELEASE, "agent");
            asm volatile("s_waitcnt vmcnt(0)" ::: "memory");
            const unsigned og = xb_add(&bar[XB_TOP], 1u);
            const unsigned tg = og / nx;
            if (og + 1u == (tg + 1u) * nx) xb_add(&bar[XB_TOPGEN], 1u);
            else XB_SPIN(xb_ld(&bar[XB_TOPGEN]) == tg, bar);
            __builtin_amdgcn_fence(__ATOMIC_ACQUIRE, "agent");
            xb_add(&bar[XB_XGEN(b.x)], 1u);
            asm volatile("s_waitcnt vmcnt(0)" ::: "memory");
        } else {
            XB_SPIN(xb_ld(&bar[XB_XGEN(b.x)]) == gen, bar);
            __builtin_amdgcn_fence(__ATOMIC_ACQUIRE, "agent");
            asm volatile("s_waitcnt vmcnt(0)" ::: "memory");
        }
    }
    __syncthreads();
}

__device__ __forceinline__ float bf2f(bf16_t b) { return __uint_as_float(((unsigned)b) << 16); }
typedef float f32x2_t __attribute__((ext_vector_type(2)));
typedef __bf16 bf16x2_t __attribute__((ext_vector_type(2)));
__device__ __forceinline__ unsigned pk2(float lo, float hi) { const f32x2_t v = {lo, hi}; bf16x2_t b = __builtin_convertvector(v, bf16x2_t); return *reinterpret_cast<unsigned*>(&b); }
__device__ __forceinline__ bf16_t f2bf(float f) { return (bf16_t)(pk2(f, 0.f) & 0xFFFFu); }
__device__ __forceinline__ float wave_sum(float v) {
#pragma unroll
    for (int o = 32; o >= 1; o >>= 1) v += __shfl_xor(v, o);
    return v;
}
__device__ __forceinline__ int opaque_tid(int wv) { int t = wv * 64 + (int)lane_id_volatile(); return t; }
__device__ __forceinline__ float sigmoidf_(float x) { return __builtin_amdgcn_rcpf(1.0f + __builtin_amdgcn_exp2f(-1.4426950408889634f * x)); }

struct Params {
    const float *x, *p, *g_mix, *w_in, *conv_w, *conv_b, *flt_w1, *flt_b1, *flt_wi, *flt_bi, *flt_freq, *flt_wo, *hy_d, *hy_gn,
                *lq1, *lk1, *lq2, *lk2, *subln, *w_out, *g_ffn, *router_w, *router_b, *w_gate, *b_gate, *w_up, *b_up, *w_down, *b_down,
                *w_ple, *g_ple, *w_pg, *b_pg, *g_final;
    float* out;
    unsigned* bar; int* cnt; float* lam; int* kmax;
    float2* rope; float* kt;
    bf16_t *win_t, *wout_t, *wple_t, *wpg_t, *wgu_t, *wd_t;
    int *tope, *pos, *list; float *topw, *rstd_e, *listw, *listr;
    bf16_t *xn, *q, *k, *v, *hy, *ut, *hx0t, *zt, *mixin, *hn, *act, *y, *pb, *h2b, *epre;
};

__device__ __forceinline__ float lambda_full(const Params& p) {
    float s1 = 0.f, s2 = 0.f;
    for (int i = 0; i < 64; ++i) { s1 += p.lq1[i] * p.lk1[i]; s2 += p.lq2[i] * p.lk2[i]; }
    return expf(s1) - expf(s2) + 0.2f;
}

template <class ARow, class Epi>
__device__ __forceinline__ void gemm_tile_simple(int K, ARow arow, const bf16_t* __restrict__ Bt, Epi epi) {
    const int lane = threadIdx.x & 63, wid = threadIdx.x >> 6, wm = wid & 3, wn = wid >> 2, fr = lane & 15, fq = lane >> 4;
    f32x4 acc[4][4];
#pragma unroll
    for (int i = 0; i < 4; ++i)
#pragma unroll
        for (int j = 0; j < 4; ++j) acc[i][j] = (f32x4){0.f, 0.f, 0.f, 0.f};
    const bf16_t* ap[4]; const bf16_t* bp[4];
#pragma unroll
    for (int i = 0; i < 4; ++i) ap[i] = arow(wm * 64 + i * 16 + fr) + fq * 8;
#pragma unroll
    for (int j = 0; j < 4; ++j) bp[j] = Bt + (size_t)(wn * 64 + j * 16 + fr) * K + fq * 8;
    for (int k = 0; k < K; k += 32) {
        bf16x8 a[4], b[4];
#pragma unroll
        for (int i = 0; i < 4; ++i) a[i] = *(const bf16x8*)(ap[i] + k);
#pragma unroll
        for (int j = 0; j < 4; ++j) b[j] = *(const bf16x8*)(bp[j] + k);
#pragma unroll
        for (int i = 0; i < 4; ++i)
#pragma unroll
            for (int j = 0; j < 4; ++j) acc[i][j] = __builtin_amdgcn_mfma_f32_16x16x32_bf16(b[j], a[i], acc[i][j], 0, 0, 0);
    }
#pragma unroll
    for (int i = 0; i < 4; ++i)
#pragma unroll
        for (int j = 0; j < 4; ++j) epi(wm * 64 + i * 16 + fr, wn * 64 + j * 16 + fq * 4, acc[i][j]);
}


namespace pg8 {
constexpr int BM = 256, BK = 64, HALF = 128, HTB = HALF * BK * 2, STAGE_BYTES = 8 * HTB;
__device__ __forceinline__ int lds_byte(int r, int c) { const int st = (r >> 4) * 2 + (c >> 5), rr = r & 15, cc = c & 31, ob = rr * 64 + cc * 2; return st * 1024 + (ob ^ (((ob >> 9) & 1) << 5)); }
__device__ __forceinline__ int perm32(int rho) { const int n = rho >> 4, i = rho & 15; return 8 * (i >> 2) + 4 * n + (i & 3); }
__device__ __forceinline__ void stage_rc(int b, int& R, int& C) { const int st = b / 1024, sb = b % 1024, swz = sb ^ (((sb >> 9) & 1) << 5); R = (st >> 1) * 16 + swz / 64; C = (st & 1) * 32 + (swz % 64) / 2; }

template <class Sched, class Epi>
__device__ __forceinline__ void gemm_phase(LAS unsigned char* lds, const char* Abase, int K_, const Sched& S, const Epi& E, int wv) {
    int K = K_;
    typedef typename Sched::Unit Unit;
    const int tid = opaque_tid(wv);
    const int wid = __builtin_amdgcn_readfirstlane(tid >> 6), lane = tid & 63, wr = wid >> 2, wc = wid & 3, fr = lane & 15, fq = lane >> 4;
    asm volatile("" : "+s"(K));
    const int nt = K / BK;
    int sR[2], sC[2]; unsigned voffB[2];
#pragma unroll
    for (int i = 0; i < 2; ++i) { stage_rc(tid * 16 + i * 8192, sR[i], sC[i]); const int Rb = (sR[i] & ~31) + perm32(sR[i] & 31); voffB[i] = (unsigned)(Rb * K + sC[i]) * 2u; }
    const size_t kstep = (size_t)(BK * 2);
    const size_t hstep = (size_t)HALF * K * 2;
    const unsigned ldsw = (unsigned)wid * 1024u;
    const int aoff = lds_byte(wr * 64 + fr, fq * 8), boff = lds_byte(wc * 32 + fr, fq * 8);
#define PG8_SA(b, h) (((b) * 2 + (h)) * HTB)
#define PG8_SB(b, h) ((4 + (b) * 2 + (h)) * HTB)
#define PG8_STAGEB(bufoff, gbase) do { _Pragma("unroll") for (int _i = 0; _i < 2; ++_i) \
        __builtin_amdgcn_global_load_lds((const unsigned*)((const char*)(gbase) + voffB[_i]), (LAS unsigned*)(lds + (bufoff) + ldsw + _i * 8192), 16, 0, 0); } while (0)
#define PG8_STAGEA(bufoff, gbase, o0, o1) do { \
        __builtin_amdgcn_global_load_lds((const unsigned*)((const char*)(gbase) + (o0)), (LAS unsigned*)(lds + (bufoff) + ldsw), 16, 0, 0); \
        __builtin_amdgcn_global_load_lds((const unsigned*)((const char*)(gbase) + (o1)), (LAS unsigned*)(lds + (bufoff) + ldsw + 8192), 16, 0, 0); } while (0)
#define PG8_LDA(dst, b, h) do { _Pragma("unroll") for (int m = 0; m < 4; ++m) _Pragma("unroll") for (int k = 0; k < 2; ++k) dst[m][k] = *(const LAS bf16x8*)(lds + PG8_SA(b, h) + aoff + m * 2048 + k * 1024); } while (0)
#define PG8_LDB(dst, b, h) do { _Pragma("unroll") for (int n = 0; n < 2; ++n) _Pragma("unroll") for (int k = 0; k < 2; ++k) dst[n][k] = *(const LAS bf16x8*)(lds + PG8_SB(b, h) + boff + n * 2048 + k * 1024); } while (0)
#define PG8_MMA(ai, bj, At, Bt) do { __builtin_amdgcn_s_setprio(1); _Pragma("unroll") for (int m = 0; m < 4; ++m) _Pragma("unroll") for (int n = 0; n < 2; ++n) _Pragma("unroll") for (int k = 0; k < 2; ++k) \
        acc[ai][bj][m][n] = __builtin_amdgcn_mfma_f32_16x16x32_bf16(Bt[n][k], At[m][k], acc[ai][bj][m][n], 0, 0, 0); __builtin_amdgcn_s_setprio(0); } while (0)
#define PG8_WAIT_V(n) asm volatile("s_waitcnt vmcnt(" #n ")" ::: "memory")
#define PG8_WAIT_L(n) asm volatile("s_waitcnt lgkmcnt(" #n ")" ::: "memory")
#define PG8_BAR __builtin_amdgcn_s_barrier()
#define PG8_SCHED __builtin_amdgcn_sched_barrier(0)
    Unit cur, nxt; int ui = 0;
    if (!S.next(0, cur)) return;
    f32x4 acc[2][2][4][2];
#pragma unroll
    for (int a = 0; a < 2; ++a)
#pragma unroll
        for (int b = 0; b < 2; ++b)
#pragma unroll
            for (int m = 0; m < 4; ++m)
#pragma unroll
                for (int n = 0; n < 2; ++n) acc[a][b][m][n] = (f32x4){0.f, 0.f, 0.f, 0.f};
    bf16x8 At[4][2], B0[2][2], B1[2][2];
    constexpr bool GATHER = Unit::GATHER;
    unsigned pa0 = 0, pa1 = 0, pn0 = 0, pn1 = 0;
    const unsigned rowb = S.rowbytes();
    const unsigned voffA0 = (unsigned)sR[0] * rowb + sC[0] * 2, voffA1 = (unsigned)sR[1] * rowb + sC[1] * 2;
    const unsigned cbyte = (unsigned)sC[0] * 2u;
    const size_t hstepA = (size_t)HALF * rowb;
    const char* cA = Abase; const char* nA = Abase;
    if constexpr (GATHER) {
        pa0 = cur.arow_idx(sR[0]) | (cur.arow_idx(sR[0] + 64) << 16); pa1 = cur.arow_idx(HALF + sR[0]) | (cur.arow_idx(HALF + sR[0] + 64) << 16);
    } else { cA = Abase + cur.abyte(); }
#define PG8_GLO(pk) ((((pk) & 0xFFFFu) << 11) + cbyte)
#define PG8_GHI(pk) ((((pk) >> 16) << 11) + cbyte)
#define PG8_STAGEA0(bufoff, gbase, pk) do { if constexpr (GATHER) PG8_STAGEA(bufoff, gbase, PG8_GLO(pk), PG8_GHI(pk)); else PG8_STAGEA(bufoff, gbase, voffA0, voffA1); } while (0)
#define PG8_STAGEA1(bufoff, gbase, pk) do { if constexpr (GATHER) PG8_STAGEA(bufoff, gbase, PG8_GLO(pk), PG8_GHI(pk)); else PG8_STAGEA(bufoff, (gbase) + hstepA, voffA0, voffA1); } while (0)
    const char* cB = cur.bbase();
    PG8_STAGEB(PG8_SB(0, 0), cB); PG8_STAGEA0(PG8_SA(0, 0), cA, pa0); PG8_STAGEB(PG8_SB(0, 1), cB + hstep); PG8_STAGEA1(PG8_SA(0, 1), cA, pa1);
    if (wr == 1) PG8_BAR;
    PG8_WAIT_V(4); PG8_BAR;
    PG8_STAGEB(PG8_SB(1, 0), cB + kstep); PG8_STAGEA0(PG8_SA(1, 0), cA + kstep, pa0); PG8_STAGEB(PG8_SB(1, 1), cB + hstep + kstep);
    PG8_WAIT_V(6); PG8_BAR;
    for (;;) {
        const bool has_next = S.next(ui + 1, nxt);
        const char* nB = has_next ? nxt.bbase() : cB;
        if constexpr (!GATHER) nA = has_next ? Abase + nxt.abyte() : cA;
        for (int t = 0; t < nt; t += 2) {
            const bool last = (t == nt - 2);
            if constexpr (GATHER) {
                if (t == nt - 4) {
                    int R0, C0; stage_rc(tid * 16, R0, C0);
                    if (has_next) { pn0 = nxt.arow_idx(R0) | (nxt.arow_idx(R0 + 64) << 16); pn1 = nxt.arow_idx(HALF + R0) | (nxt.arow_idx(HALF + R0 + 64) << 16); }
                    else { pn0 = pa0; pn1 = pa1; }
                }
            }
            const char* a1 = cA + (size_t)(t + 1) * kstep;
            const char* a2 = last ? nA : cA + (size_t)(t + 2) * kstep; const char* a3 = a2 + kstep;
            unsigned q0 = pa0, q1 = pa1;
            if constexpr (GATHER) { q0 = last ? pn0 : pa0; q1 = last ? pn1 : pa1; }
            const char* b2 = last ? nB : cB + (size_t)(t + 2) * kstep; const char* b3 = b2 + kstep;
            PG8_LDB(B0, 0, 0); PG8_SCHED; PG8_LDA(At, 0, 0); PG8_STAGEA1(PG8_SA(1, 1), a1, pa1);
            PG8_WAIT_L(8); PG8_BAR; PG8_WAIT_L(0); PG8_MMA(0, 0, At, B0); PG8_BAR; PG8_SCHED;
            PG8_LDB(B1, 0, 1); PG8_STAGEB(PG8_SB(0, 0), b2);
            PG8_BAR; PG8_WAIT_L(0); PG8_MMA(0, 1, At, B1); PG8_BAR;
            PG8_LDA(At, 0, 1); PG8_STAGEA0(PG8_SA(0, 0), a2, q0);
            PG8_BAR; PG8_WAIT_L(0); PG8_MMA(1, 0, At, B0); PG8_BAR; PG8_SCHED;
            PG8_STAGEB(PG8_SB(0, 1), b2 + hstep);
            PG8_WAIT_V(6); PG8_BAR; PG8_MMA(1, 1, At, B1); PG8_BAR;
            PG8_LDB(B0, 1, 0); PG8_SCHED; PG8_LDA(At, 1, 0); PG8_STAGEA1(PG8_SA(0, 1), a2, q1);
            PG8_WAIT_L(8); PG8_BAR; PG8_WAIT_L(0); PG8_MMA(0, 0, At, B0); PG8_BAR; PG8_SCHED;
            PG8_LDB(B1, 1, 1); PG8_STAGEB(PG8_SB(1, 0), b3);
            PG8_BAR; PG8_WAIT_L(0); PG8_MMA(0, 1, At, B1); PG8_BAR;
            PG8_LDA(At, 1, 1); PG8_STAGEA0(PG8_SA(1, 0), a3, q0);
            PG8_BAR; PG8_WAIT_L(0); PG8_MMA(1, 0, At, B0); PG8_BAR; PG8_SCHED;
            PG8_STAGEB(PG8_SB(1, 1), b3 + hstep);
            PG8_WAIT_V(6); PG8_BAR; PG8_MMA(1, 1, At, B1); PG8_BAR;
        }
        if (wr == 0) PG8_BAR;
        {
            int fr_e = fr, cb = wc * 32 + fq * 8; asm volatile("" : "+v"(fr_e), "+v"(cb));
#define PG8_ROW(g) (((g) >> 2) * HALF + wr * 64 + ((g) & 3) * 16 + fr_e)
            const typename Epi::ColPre cp = E.colpre(cur, cb);
            typename Epi::RowPre rp[8];
#pragma unroll
            for (int g = 0; g < 8; ++g) rp[g] = E.rowpre(cur, PG8_ROW(g), cb);
            constexpr int GB = Epi::BATCH;
#pragma unroll
            for (int b0 = 0; b0 < 8; b0 += GB) {
                typename Epi::Pre pr[GB];
#pragma unroll
                for (int gg = 0; gg < GB; ++gg) pr[gg] = E.pre(cur, PG8_ROW(b0 + gg), cb, rp[b0 + gg], cp);
#pragma unroll
                for (int gg = 0; gg < GB; ++gg) { const int g = b0 + gg;
                    E.store(cur, PG8_ROW(g), cb, acc[g >> 2][0][g & 3][0], acc[g >> 2][0][g & 3][1], acc[g >> 2][1][g & 3][0], acc[g >> 2][1][g & 3][1], rp[g], cp, pr[gg]); }
            }
#undef PG8_ROW
        }
        if (!has_next) break;
#pragma unroll
        for (int a = 0; a < 2; ++a)
#pragma unroll
            for (int b = 0; b < 2; ++b)
#pragma unroll
                for (int m = 0; m < 4; ++m)
#pragma unroll
                    for (int n = 0; n < 2; ++n) acc[a][b][m][n] = (f32x4){0.f, 0.f, 0.f, 0.f};
        cur = nxt; cB = nB; cA = nA; if constexpr (GATHER) { pa0 = pn0; pa1 = pn1; } ++ui;
        if (wr == 1) PG8_BAR;
    }
    PG8_WAIT_V(0);
    PG8_BAR;
#undef PG8_SA
#undef PG8_SB
#undef PG8_GLO
#undef PG8_GHI
#undef PG8_STAGEA0
#undef PG8_STAGEA1
#undef PG8_STAGEA
#undef PG8_STAGEB
#undef PG8_LDA
#undef PG8_LDB
#undef PG8_MMA
#undef PG8_WAIT_V
#undef PG8_WAIT_L
#undef PG8_BAR
#undef PG8_SCHED
}

struct DenseUnit {
    static constexpr bool GATHER = false;
    int pm, pn; const char* bt; unsigned rowb;
    __device__ __forceinline__ const char* bbase() const { return bt; }
    __device__ __forceinline__ size_t abyte() const { return (size_t)pm * BM * rowb; }
    __device__ __forceinline__ unsigned arow_idx(int) const { return 0u; }
};
struct DenseOrder {
    typedef DenseUnit Unit;
    int nM, nN, nwg, G, c, K; const bf16_t* Bt;
    __device__ __forceinline__ unsigned rowbytes() const { return (unsigned)K * 2u; }
    __device__ __forceinline__ void init(int M, int N, int K_, const bf16_t* Bt_, int G_, int c_) { nM = M / BM; nN = N / BM; nwg = nM * nN; G = G_; c = c_; K = K_; Bt = Bt_; }
    __device__ __forceinline__ bool next(int i, Unit& u) const {
        const long L = (long)i * G + c; if (L >= nwg) return false;
        int wgid = (int)L; { const int q = nwg / 8, r = nwg % 8, xcd = wgid % 8, off = wgid / 8; wgid = (xcd < r ? xcd * (q + 1) : r * (q + 1) + (xcd - r) * q) + off; }
        const int nig = 8 * nN, gid = wgid / nig, fm = gid * 8, gsz = (nM - fm) < 8 ? (nM - fm) : 8;
        u.pm = fm + ((wgid % nig) % gsz); u.pn = (wgid % nig) / gsz;
        u.bt = (const char*)Bt + (size_t)u.pn * BM * K * 2; u.rowb = (unsigned)K * 2u;
        return true;
    }
};
}

__device__ __forceinline__ int rowmap(int mode, int n) {
    if (mode == 1) { if (n < 1024) { const int d = n & 63; return (n & ~63) + 2 * (d & 31) + (d >> 5); } return n; }
    if (mode == 2) return (n >> 7) * 256 + (n & 127);
    if (mode == 3) return (n >> 7) * 256 + 128 + (n & 127);
    return n;
}
__device__ __forceinline__ void transpose_tile(const float* __restrict__ src, int N, bf16_t* __restrict__ dst, int K, int k0, int n0, int mode, float* tile, int lane) {
    float4 v[16];
#pragma unroll
    for (int it = 0; it < 16; ++it) v[it] = *(const float4*)(src + (size_t)(k0 + it * 4 + (lane >> 4)) * N + n0 + (lane & 15) * 4);
#pragma unroll
    for (int it = 0; it < 16; ++it) { float* t = tile + (it * 4 + (lane >> 4)) * 65 + (lane & 15) * 4; t[0] = v[it].x; t[1] = v[it].y; t[2] = v[it].z; t[3] = v[it].w; }
    asm volatile("s_waitcnt lgkmcnt(0)" ::: "memory");
#pragma unroll
    for (int it = 0; it < 8; ++it) {
        const int n = it * 8 + (lane >> 3), k8 = (lane & 7) * 8;
        u32x4 w;
        w.x = pk2(tile[(k8 + 0) * 65 + n], tile[(k8 + 1) * 65 + n]);
        w.y = pk2(tile[(k8 + 2) * 65 + n], tile[(k8 + 3) * 65 + n]);
        w.z = pk2(tile[(k8 + 4) * 65 + n], tile[(k8 + 5) * 65 + n]);
        w.w = pk2(tile[(k8 + 6) * 65 + n], tile[(k8 + 7) * 65 + n]);
        *(u32x4*)(dst + (size_t)rowmap(mode, n0 + n) * K + k0 + k8) = w;
    }
    asm volatile("s_waitcnt lgkmcnt(0)" ::: "memory");
}
__device__ __forceinline__ void transpose_matrix(const float* src, int Ksrc, int N, bf16_t* dst, int mode, int gw, int nw, float* tile, int lane) {
    const int tk = Ksrc / 64, tn = N / 64;
    for (int u = gw; u < tk * tn; u += nw) transpose_tile(src, N, dst, Ksrc, (u / tn) * 64, (u % tn) * 64, mode, tile, lane);
}

__device__ __forceinline__ void phase_prologue(const Params& p, int bid, int nblk, char* smem, int wv) {
    const int tid = opaque_tid(wv), lane = tid & 63, wid = tid >> 6;
    float* tile = (float*)smem + wid * (64 * 65);
    const int gw = bid * 8 + wid, nw = nblk * 8;
    transpose_matrix(p.w_in, 1024, 3072, p.win_t, 1, gw, nw, tile, lane);
    transpose_matrix(p.w_out, 1024, 1024, p.wout_t, 0, gw, nw, tile, lane);
    transpose_matrix(p.w_ple, 256, 1024, p.wple_t, 0, gw, nw, tile, lane);
    transpose_matrix(p.w_pg, 1024, 1024, p.wpg_t, 0, gw, nw, tile, lane);
    if (bid == 0 && tid == 0) p.lam[0] = lambda_full(p);
    for (int i = bid * 512 + tid; i < T; i += nblk * 512) p.rstd_e[i] = 0.f;
    for (int row = bid * 8 + wid; row < T; row += nblk * 8) {
        const float4* xr = (const float4*)(p.x + (size_t)row * DM);
        float4 v[4]; float ss = 0.f;
#pragma unroll
        for (int i = 0; i < 4; ++i) { v[i] = xr[lane + 64 * i]; ss += v[i].x * v[i].x + v[i].y * v[i].y + v[i].z * v[i].z + v[i].w * v[i].w; }
        ss = wave_sum(ss);
        const float rstd = 1.0f / sqrtf(ss * (1.0f / 1024.0f) + 1e-6f);
#pragma unroll
        for (int i = 0; i < 4; ++i) {
            const float4 g = ((const float4*)p.g_mix)[lane + 64 * i];
            u32x2 w; w.x = pk2(v[i].x * rstd * g.x, v[i].y * rstd * g.y); w.y = pk2(v[i].z * rstd * g.z, v[i].w * rstd * g.w);
            *(u32x2*)(p.xn + (size_t)row * DM + (lane + 64 * i) * 4) = w;
        }
    }
    for (int idx = bid * 512 + tid; idx < SEQ * 32; idx += nblk * 512) {
        const int s = idx >> 5, f = idx & 31;
        const float inv = exp2f(-(float)f * (13.287712379549449f / 32.0f));
        const float ang = (float)s * inv;
        p.rope[idx] = make_float2(cosf(ang), sinf(ang));
    }
    {
        float* zs = (float*)smem;
        float* ha = zs + 16 * 36;
        float* hb = ha + 16 * 64;
        float* h3t = hb + 16 * 64;
        for (int blk = bid; blk < SEQ / 16; blk += nblk) {
            const int l0 = blk * 16;
            __syncthreads();
            for (int idx = tid; idx < 16 * 33; idx += 512) {
                const int ps = idx / 33, i = idx % 33, l = l0 + ps;
                float zi;
                if (i == 0) zi = (float)l / 4095.0f;
                else {
                    const int fi = (i - 1) & 15;
                    const float f = 1e-4f + (float)fi * ((15.0f - 1e-4f) / 15.0f);
                    const float w = (float)(2.0 * 3.14159265358979323846 / 4096.0) * (float)l;
                    const float fw = w * f;
                    zi = i <= 16 ? cosf(fw) : -sinf(fw);
                }
                zs[ps * 36 + i] = zi;
            }
            __syncthreads();
            const int j = tid & 63;
#pragma unroll
            for (int r = 0; r < 2; ++r) { const int ps = (tid >> 6) + 8 * r; float s = p.flt_b1[j];
#pragma unroll 4
                for (int i = 0; i < 33; ++i) s += zs[ps * 36 + i] * p.flt_w1[i * 64 + j];
                ha[ps * 64 + j] = sinf(p.flt_freq[j] * s); }
            __syncthreads();
#pragma unroll
            for (int r = 0; r < 2; ++r) { const int ps = (tid >> 6) + 8 * r; float s = p.flt_bi[j];
#pragma unroll 4
                for (int i = 0; i < 64; ++i) s += ha[ps * 64 + i] * p.flt_wi[i * 64 + j];
                hb[ps * 64 + j] = sinf(p.flt_freq[64 + j] * s); }
            __syncthreads();
#pragma unroll
            for (int r = 0; r < 2; ++r) { const int ps = (tid >> 6) + 8 * r; float s = p.flt_bi[64 + j];
#pragma unroll 4
                for (int i = 0; i < 64; ++i) s += hb[ps * 64 + i] * p.flt_wi[(64 + i) * 64 + j];
                h3t[j * 16 + ps] = sinf(p.flt_freq[128 + j] * s); }
            __syncthreads();
            float of[16], ob[16];
#pragma unroll
            for (int q = 0; q < 16; ++q) { of[q] = 0.f; ob[q] = 0.f; }
#pragma unroll 2
            for (int i = 0; i < 64; ++i) {
                const float wf = p.flt_wo[i * 1024 + tid], wb = p.flt_wo[i * 1024 + 512 + tid];
#pragma unroll
                for (int q4 = 0; q4 < 4; ++q4) { const float4 h = *(const float4*)(h3t + i * 16 + q4 * 4);
                    of[q4 * 4] += h.x * wf; of[q4 * 4 + 1] += h.y * wf; of[q4 * 4 + 2] += h.z * wf; of[q4 * 4 + 3] += h.w * wf;
                    ob[q4 * 4] += h.x * wb; ob[q4 * 4 + 1] += h.y * wb; ob[q4 * 4 + 2] += h.z * wb; ob[q4 * 4 + 3] += h.w * wb; }
            }
            const float mind = -4.605170185988091f / 1.5f, maxd = -4.605170185988091f / 0.3f;
            const float delta = fabsf(mind + (float)tid * ((maxd - mind) / 511.0f));
            float* kr = p.kt + (size_t)tid * 8192;
#pragma unroll
            for (int q = 0; q < 16; ++q) {
                const int l = l0 + q;
                const float dec = expf(-((float)l / 4095.0f) * delta);
                const float hf = of[q] * dec, hbk = ob[q] * dec;
                if (l == 0) { kr[4096] = hf + hbk; kr[0] = 0.f; }
                else { kr[4096 + l] = hf; kr[4096 - l] = hbk; }
            }
        }
    }
}

__device__ __forceinline__ void inproj_store(const Params& p, int row, int col, f32x4 v) {
    const int b = row >> 12, s = row & 4095;
    if (col < 1024) {
        const int j = col & 63, f = j >> 1;
        const float2 c0 = p.rope[s * 32 + f], c1 = p.rope[s * 32 + f + 1];
        const float o0 = v[0] * c0.x - v[1] * c0.y, o1 = v[1] * c0.x + v[0] * c0.y;
        const float o2 = v[2] * c1.x - v[3] * c1.y, o3 = v[3] * c1.x + v[2] * c1.y;
        const int hh = (col & 511) >> 7, dd = col & 127;
        bf16_t* dst = (col < 512 ? p.q : p.k) + ((size_t)((b * NH + hh) * SEQ + s)) * 128 + dd;
        u32x2 w; w.x = pk2(o0, o1); w.y = pk2(o2, o3);
        *(u32x2*)dst = w;
    } else if (col < 1536) {
        const int hh = (col - 1024) >> 7, dd = col & 127;
        bf16_t* dst = p.v + ((size_t)((b * NH + hh) * SEQ + s)) * 128 + dd;
        u32x2 w; w.x = pk2(v[0], v[1]); w.y = pk2(v[2], v[3]);
        *(u32x2*)dst = w;
    } else {
        u32x2 w; w.x = pk2(v[0], v[1]); w.y = pk2(v[2], v[3]);
        *(u32x2*)(p.hy + (size_t)row * 1536 + (col - 1536)) = w;
    }
}
__device__ __forceinline__ u32x4 pk8(f32x4 a, f32x4 b) { u32x4 w; w.x = pk2(a[0], a[1]); w.y = pk2(a[2], a[3]); w.z = pk2(b[0], b[1]); w.w = pk2(b[2], b[3]); return w; }
struct EpiNone {};
struct EpiInproj {
    const Params& p;
    static constexpr int BATCH = 8;
    typedef EpiNone ColPre; struct RowPre { f32x4 a, b; }; typedef EpiNone Pre;
    __device__ __forceinline__ ColPre colpre(const pg8::DenseUnit&, int) const { return ColPre{}; }
    __device__ __forceinline__ RowPre rowpre(const pg8::DenseUnit& u, int r, int cb) const {
        RowPre x; x.a = (f32x4){1.f, 0.f, 1.f, 0.f}; x.b = x.a;
        if (u.pn < 4) { const int s = (u.pm * 256 + r) & 4095; const f32x4* rp = (const f32x4*)(p.rope + s * 32 + ((cb & 63) >> 1)); x.a = rp[0]; x.b = rp[1]; }
        return x;
    }
    __device__ __forceinline__ Pre pre(const pg8::DenseUnit&, int, int, const RowPre&, const ColPre&) const { return Pre{}; }
    __device__ __forceinline__ void store(const pg8::DenseUnit& u, int r, int cb, f32x4 v00, f32x4 v01, f32x4 v10, f32x4 v11, const RowPre& rp, const ColPre&, const Pre&) const {
        const int row = u.pm * 256 + r, b = row >> 12, s = row & 4095;
#pragma unroll
        for (int bj = 0; bj < 2; ++bj) {
            f32x4 v0 = bj ? v10 : v00, v1 = bj ? v11 : v01;
            const int col = u.pn * 256 + bj * 128 + cb;
            if (u.pn < 4) {
                f32x4 o0, o1;
                o0[0] = v0[0] * rp.a[0] - v0[1] * rp.a[1]; o0[1] = v0[1] * rp.a[0] + v0[0] * rp.a[1];
                o0[2] = v0[2] * rp.a[2] - v0[3] * rp.a[3]; o0[3] = v0[3] * rp.a[2] + v0[2] * rp.a[3];
                o1[0] = v1[0] * rp.b[0] - v1[1] * rp.b[1]; o1[1] = v1[1] * rp.b[0] + v1[0] * rp.b[1];
                o1[2] = v1[2] * rp.b[2] - v1[3] * rp.b[3]; o1[3] = v1[3] * rp.b[2] + v1[2] * rp.b[3];
                const int hh = (col & 511) >> 7, dd = col & 127;
                if (col < 512) { o0 = o0 * (0.125f * 1.4426950408889634f); o1 = o1 * (0.125f * 1.4426950408889634f); }
                *(u32x4*)((col < 512 ? p.q : p.k) + ((size_t)((b * NH + hh) * SEQ + s)) * 128 + dd) = pk8(o0, o1);
            } else if (u.pn < 6) {
                const int hh = (col - 1024) >> 7, dd = col & 127;
                *(u32x4*)(p.v + ((size_t)((b * NH + hh) * SEQ + s)) * 128 + dd) = pk8(v0, v1);
            } else {
                *(u32x4*)(p.hy + (size_t)row * 1536 + (col - 1536)) = pk8(v0, v1);
            }
        }
    }
};
__device__ __forceinline__ void phase_inproj(const Params& p, int bid, int nblk, char* smem, int wv) {
    pg8::DenseOrder S; S.init(T, 3072, 1024, p.win_t, nblk, bid);
    pg8::gemm_phase((LAS unsigned char*)smem, (const char*)p.xn, 1024, S, EpiInproj{p}, wv);
}

__device__ __forceinline__ void phase_hyprep(const Params& p, int bid, int nblk, char* smem, int wv) {
    bf16_t* tu = (bf16_t*)smem;
    bf16_t* tx = tu + 64 * 72;
    const int tid = opaque_tid(wv);
    for (int u = bid; u < 8 * 64 * 8; u += nblk) {
        const int ct = u & 7, st = (u >> 3) & 63, b = u >> 9;
        const int s0 = st * 64, c0 = ct * 64;
        const int sl = tid >> 3, c8 = (tid & 7) * 8, s = s0 + sl;
        float hyv[3][8];
#pragma unroll
        for (int part = 0; part < 3; ++part) {
            const int ch = part * 512 + c0 + c8;
            float xm[8], xc[8], xp[8];
            const bf16_t* base = p.hy + (size_t)(b * SEQ + s) * 1536 + ch;
            const bf16x8 vc = *(const bf16x8*)base;
            bf16x8 vm = (bf16x8){0, 0, 0, 0, 0, 0, 0, 0}, vp = (bf16x8){0, 0, 0, 0, 0, 0, 0, 0};
            if (s > 0) vm = *(const bf16x8*)(base - 1536);
            if (s < SEQ - 1) vp = *(const bf16x8*)(base + 1536);
#pragma unroll
            for (int i = 0; i < 8; ++i) { xm[i] = bf2f((bf16_t)vm[i]); xc[i] = bf2f((bf16_t)vc[i]); xp[i] = bf2f((bf16_t)vp[i]); }
#pragma unroll
            for (int i = 0; i < 8; ++i)
                hyv[part][i] = p.conv_b[ch + i] + xm[i] * p.conv_w[ch + i] + xc[i] * p.conv_w[1536 + ch + i] + xp[i] * p.conv_w[3072 + ch + i];
        }
#pragma unroll
        for (int i = 0; i < 8; ++i) {
            tu[(c8 + i) * 72 + sl] = f2bf(hyv[0][i] * hyv[2][i]);
            tx[(c8 + i) * 72 + sl] = f2bf(hyv[1][i]);
        }
        __syncthreads();
        {
            const int c = tid >> 3, s8 = (tid & 7) * 8;
            const size_t off = ((size_t)(c0 + c) * NBATCH + b) * SEQ + s0 + s8;
            *(u32x4*)(p.ut + off) = *(const u32x4*)(tu + c * 72 + s8);
            *(u32x4*)(p.hx0t + off) = *(const u32x4*)(tx + c * 72 + s8);
        }
        __syncthreads();
    }
    for (int item = bid * 512 + tid; item < NBATCH * NH * 2 * SEQ; item += nblk * 512) {
        const int key = item & 4095, grp = item >> 12, map = grp & 1, bh = grp >> 1;
        const bf16_t* kp = p.k + ((size_t)bh * SEQ + key) * 128 + map * 64;
        float ss = 0.f;
#pragma unroll
        for (int i = 0; i < 8; ++i) { const bf16x8 v = *(const bf16x8*)(kp + i * 8);
#pragma unroll
            for (int jj = 0; jj < 8; ++jj) { const float f = bf2f((bf16_t)v[jj]); ss += f * f; } }
#pragma unroll
        for (int o = 32; o >= 1; o >>= 1) ss = fmaxf(ss, __shfl_xor(ss, o));
        if ((tid & 63) == 0) atomicMax(p.kmax + grp, (int)__float_as_uint(sqrtf(ss)));
    }
}

typedef float f32x16 __attribute__((ext_vector_type(16)));
typedef short s16x4 __attribute__((ext_vector_type(4)));
constexpr float AT_SCALE = 0.125f, AT_THR = 8.f;
constexpr int AT_SHM_V = 64 * 128 * 2, AT_SHM_K = 64 * 128 * 2;
#define KSWZ(row, colB) ((row) * 256 + ((colB) ^ (((row) & 7) << 4)))
#define SBAR() __builtin_amdgcn_sched_barrier(0)
__device__ __forceinline__ int crow(int r, int hi) { return (r & 3) + 8 * (r >> 2) + 4 * hi; }
__device__ __forceinline__ unsigned cvtpk(float lo, float hi) { unsigned r; asm volatile("v_cvt_pk_bf16_f32 %0, %1, %2" : "=v"(r) : "v"(lo), "v"(hi)); return r; }
__device__ __forceinline__ void partialSM(f32x16& p0, f32x16& p1, float) {
#pragma unroll
    for (int r = 0; r < 16; ++r) p0[r] = __builtin_amdgcn_exp2f(p0[r]);
}
__device__ __forceinline__ void finishSM(f32x16& p0, f32x16& p1, float& l_reg, bf16x8& pa0, bf16x8& pa1, bf16x8& pa2, bf16x8& pa3) {
#pragma unroll
    for (int r = 0; r < 16; ++r) p1[r] = __builtin_amdgcn_exp2f(p1[r]);
    float ps = 0;
#pragma unroll
    for (int r = 0; r < 16; ++r) ps += p0[r];
#pragma unroll
    for (int r = 0; r < 16; ++r) ps += p1[r];
    l_reg += ps;
#define PK4(P, BASE, OUT) do { unsigned a0 = cvtpk(P[BASE + 0], P[BASE + 1]), a1 = cvtpk(P[BASE + 2], P[BASE + 3]);   \
    unsigned b0 = cvtpk(P[BASE + 4], P[BASE + 5]), b1 = cvtpk(P[BASE + 6], P[BASE + 7]);                              \
    auto r0 = __builtin_amdgcn_permlane32_swap(a0, b0, false, false); auto r1 = __builtin_amdgcn_permlane32_swap(a1, b1, false, false); \
    u32x4 w = {r0[0], r1[0], r0[1], r1[1]}; OUT = *reinterpret_cast<bf16x8*>(&w); } while (0)
    PK4(p0, 0, pa0); PK4(p0, 8, pa1); PK4(p1, 0, pa2); PK4(p1, 8, pa3);
#undef PK4
}
__device__ __forceinline__ void qkt(f32x16& p0, f32x16& p1, const char* Ks, const bf16x8* qr, int r32, int hi, int mb, float mC) {
#pragma unroll
    for (int r = 0; r < 16; ++r) { p0[r] = -mC; p1[r] = -mC; }
#pragma unroll
    for (int d0 = 0; d0 < 4; ++d0) { const int cb = mb + (d0 * 16 + hi * 8) * 2;
        const bf16x8 b0 = *reinterpret_cast<const bf16x8*>(Ks + KSWZ(r32, cb));
        const bf16x8 b1 = *reinterpret_cast<const bf16x8*>(Ks + KSWZ(32 + r32, cb));
        p0 = __builtin_amdgcn_mfma_f32_32x32x16_bf16(b0, qr[d0], p0, 0, 0, 0);
        p1 = __builtin_amdgcn_mfma_f32_32x32x16_bf16(b1, qr[d0], p1, 0, 0, 0); }
}
__device__ __forceinline__ int v_st(int k, int c) { const int kk = (k & ~0xC) | ((k & 4) << 1) | ((k & 8) >> 1); return ((kk >> 3) * 4 + (c >> 5)) * 512 + ((kk & 7) * 32 + (c & 31)) * 2; }
__device__ __forceinline__ int v_rd_base(int lane) { return ((lane & 3) << 3) | (((lane >> 2) & 3) << 6) | (((lane >> 4) & 1) << 5) | (((lane >> 5) & 1) << 8); }
constexpr int v_rd_off(int d0, int ks, int half) { return d0 * 512 + ks * 4096 + half * 2048; }
template <int OFF> __device__ __forceinline__ s16x4 tr_read(int vb) {
    s16x4 r; asm volatile("ds_read_b64_tr_b16 %0, %1 offset:%2" : "=&v"(r) : "v"(vb), "i"(OFF) : "memory"); return r;
}
template <int D0> __device__ __forceinline__ void pv_one(f32x16& od, int vb, bf16x8 pa0, bf16x8 pa1, bf16x8 pa2, bf16x8 pa3) {
    const s16x4 l0 = tr_read<v_rd_off(D0, 0, 0)>(vb), h0 = tr_read<v_rd_off(D0, 0, 1)>(vb), l1 = tr_read<v_rd_off(D0, 1, 0)>(vb), h1 = tr_read<v_rd_off(D0, 1, 1)>(vb);
    const s16x4 l2 = tr_read<v_rd_off(D0, 2, 0)>(vb), h2 = tr_read<v_rd_off(D0, 2, 1)>(vb), l3 = tr_read<v_rd_off(D0, 3, 0)>(vb), h3 = tr_read<v_rd_off(D0, 3, 1)>(vb);
    asm volatile("s_waitcnt lgkmcnt(0)" ::: "memory"); SBAR();
#define PKV(L, H) (bf16x8){L[0], L[1], L[2], L[3], H[0], H[1], H[2], H[3]}
    od = __builtin_amdgcn_mfma_f32_32x32x16_bf16(pa0, PKV(l0, h0), od, 0, 0, 0);
    od = __builtin_amdgcn_mfma_f32_32x32x16_bf16(pa1, PKV(l1, h1), od, 0, 0, 0);
    od = __builtin_amdgcn_mfma_f32_32x32x16_bf16(pa2, PKV(l2, h2), od, 0, 0, 0);
    od = __builtin_amdgcn_mfma_f32_32x32x16_bf16(pa3, PKV(l3, h3), od, 0, 0, 0);
#undef PKV
}
__device__ __forceinline__ void pv_d0(f32x16* o, int vb, bf16x8 pa0, bf16x8 pa1, bf16x8 pa2, bf16x8 pa3) {
    pv_one<0>(o[0], vb, pa0, pa1, pa2, pa3); pv_one<1>(o[1], vb, pa0, pa1, pa2, pa3); pv_one<2>(o[2], vb, pa0, pa1, pa2, pa3); pv_one<3>(o[3], vb, pa0, pa1, pa2, pa3);
}
__device__ __forceinline__ void attn_unit(const Params& p, int unit, char* lds, int wv) {
    const int qb = unit & 31, h = (unit >> 5) & 3, b = unit >> 7;
    const int tid = opaque_tid(wv);
    const int wid = tid >> 6, lane = tid & 63, r32 = lane & 31, hi = lane >> 5, map = wid >> 2, wq = wid & 3;
    const size_t hb = (size_t)(b * NH + h) * SEQ;
    const bf16_t* Kh = p.k + hb * 128; const bf16_t* Vh = p.v + hb * 128;
    char* V_lds = lds; char* K_lds = lds + 2 * AT_SHM_V;
    float* wsl = (float*)(lds + 2 * AT_SHM_V + 2 * AT_SHM_K) + wid * 64; float* li_l = wsl; float* al_l = wsl + 32;
    float l_reg = 0; f32x16 o[4] = {}; bf16x8 qr[4];
    const int mb = map * 128;
    __syncthreads();
    float mC;
    {
        const bf16_t* Qw = p.q + (hb + qb * 128 + wq * 32 + r32) * 128 + map * 64 + hi * 8;
        float qs = 0.f;
#pragma unroll
        for (int d0 = 0; d0 < 4; ++d0) { qr[d0] = *(const bf16x8*)(Qw + d0 * 16);
#pragma unroll
            for (int jj = 0; jj < 8; ++jj) { const float f = bf2f((bf16_t)qr[d0][jj]); qs += f * f; } }
        qs += __shfl_xor(qs, 32);
        const float kmx = __uint_as_float((unsigned)p.kmax[(b * NH + h) * 2 + map]);
        mC = sqrtf(qs) * kmx;
    }
    const int sr = tid >> 4, sc = (tid & 15) * 8, vst0 = v_st(sr, sc), vst1 = v_st(32 + sr, sc);
    const int vb0 = (int)(uintptr_t)(LAS char*)V_lds + v_rd_base(lane);
    struct { bf16x8 vs0, vs1, ks0, ks1; } sr_[1];
#define SLOAD(i, k0) do { sr_[i].vs0 = *(const bf16x8*)(&Vh[(size_t)((k0) + sr) * 128 + sc]); sr_[i].vs1 = *(const bf16x8*)(&Vh[(size_t)((k0) + 32 + sr) * 128 + sc]); \
    sr_[i].ks0 = *(const bf16x8*)(&Kh[(size_t)((k0) + sr) * 128 + sc]); sr_[i].ks1 = *(const bf16x8*)(&Kh[(size_t)((k0) + 32 + sr) * 128 + sc]); } while (0)
#define SWRITE(bb, i) do { *(bf16x8*)(V_lds + (bb) * AT_SHM_V + vst0) = sr_[i].vs0;          \
    *(bf16x8*)(V_lds + (bb) * AT_SHM_V + vst1) = sr_[i].vs1; const int kc = sc * 2;               \
    *(bf16x8*)(K_lds + (bb) * AT_SHM_K + KSWZ(sr, kc)) = sr_[i].ks0;                       \
    *(bf16x8*)(K_lds + (bb) * AT_SHM_K + KSWZ(32 + sr, kc)) = sr_[i].ks1; } while (0)
#define SWAIT() asm volatile("s_waitcnt vmcnt(0)" ::: "memory")
    f32x16 pA0, pA1, pB0, pB1; bf16x8 pa0, pa1, pa2, pa3; constexpr int NT = SEQ / 64;
    SLOAD(0, 0); SWAIT(); SWRITE(0, 0); __syncthreads();
    qkt(pA0, pA1, K_lds, qr, r32, hi, mb, mC); partialSM(pA0, pA1, mC);
    SLOAD(0, 64);
    SWAIT(); SWRITE(1, 0); __syncthreads();
    for (int j = 1; j + 1 < NT; j += 2) {
        SBAR(); qkt(pB0, pB1, K_lds + AT_SHM_K, qr, r32, hi, mb, mC);
        finishSM(pA0, pA1, l_reg, pa0, pa1, pa2, pa3); SBAR();
        SLOAD(0, (j + 1) * 64); SBAR();
        pv_d0(o, vb0, pa0, pa1, pa2, pa3); partialSM(pB0, pB1, mC);
        __syncthreads(); SWAIT(); SWRITE(0, 0);
        __syncthreads();
        SBAR(); qkt(pA0, pA1, K_lds, qr, r32, hi, mb, mC);
        finishSM(pB0, pB1, l_reg, pa0, pa1, pa2, pa3); SBAR();
        SLOAD(0, (j + 2) * 64); SBAR();
        pv_d0(o, vb0 + AT_SHM_V, pa0, pa1, pa2, pa3); partialSM(pA0, pA1, mC);
        __syncthreads(); SWAIT(); SWRITE(1, 0);
        __syncthreads();
    }
    SBAR(); qkt(pB0, pB1, K_lds + AT_SHM_K, qr, r32, hi, mb, mC);
    finishSM(pA0, pA1, l_reg, pa0, pa1, pa2, pa3); SBAR();
    pv_d0(o, vb0, pa0, pa1, pa2, pa3); partialSM(pB0, pB1, mC);
    __syncthreads();
    finishSM(pB0, pB1, l_reg, pa0, pa1, pa2, pa3); SBAR();
    pv_d0(o, vb0 + AT_SHM_V, pa0, pa1, pa2, pa3);
    l_reg += __shfl_xor(l_reg, 32);
    if (hi == 0) li_l[r32] = l_reg;
    asm volatile("s_waitcnt lgkmcnt(0)" ::: "memory");
    float rli[16];
#pragma unroll
    for (int r = 0; r < 16; ++r) rli[r] = 1.0f / li_l[crow(r, hi)];
    __syncthreads();
    float* X = (float*)lds;
    bf16_t* Ob = (bf16_t*)(lds + 65536 + 2048) + wq * 4096;
    if (map == 1) {
        const float lam = p.lam[0];
#pragma unroll
        for (int r = 0; r < 16; ++r)
#pragma unroll
            for (int d0 = 0; d0 < 4; ++d0) X[(wq * 32 + crow(r, hi)) * 128 + d0 * 32 + r32] = o[d0][r] * rli[r] * lam;
    }
    __syncthreads();
    if (map == 0) {
        float ss[16];
#pragma unroll
        for (int r = 0; r < 16; ++r) { ss[r] = 0.f;
#pragma unroll
            for (int d0 = 0; d0 < 4; ++d0) { const float f = o[d0][r] * rli[r] - X[(wq * 32 + crow(r, hi)) * 128 + d0 * 32 + r32]; o[d0][r] = f; ss[r] += f * f; } }
#pragma unroll
        for (int r = 0; r < 16; ++r) {
#pragma unroll
            for (int off = 16; off >= 1; off >>= 1) ss[r] += __shfl_xor(ss[r], off);
            ss[r] = 0.8f / sqrtf(ss[r] * (1.0f / 128.0f) + 1e-5f);
        }
#pragma unroll
        for (int d0 = 0; d0 < 4; ++d0) { const float g = p.subln[d0 * 32 + r32];
#pragma unroll
            for (int r = 0; r < 16; ++r) Ob[crow(r, hi) * 128 + d0 * 32 + r32] = f2bf(o[d0][r] * ss[r] * g); }
        asm volatile("s_waitcnt lgkmcnt(0)" ::: "memory");
        bf16_t* dst = p.mixin + (size_t)(b * SEQ + qb * 128 + wq * 32) * DM + h * 128;
#pragma unroll
        for (int i = 0; i < 8; ++i) { const int id = lane + 64 * i, row = id >> 4, c8 = (id & 15) * 8;
            *(u32x4*)(dst + (size_t)row * DM + c8) = *(const u32x4*)(Ob + row * 128 + c8); }
    }
#undef SLOAD
#undef SWRITE
#undef SWAIT
}

constexpr int CV_UPITCH = 144;
constexpr int CV_UBYTES = 8 * 64 * CV_UPITCH;
constexpr int CV_CPITCH = 8200 * 2 + 64;
__device__ __forceinline__ void conv_unit(const Params& p, int c, char* smem, int wv) {
    const int tid = opaque_tid(wv);
    const int lane = tid & 63, b = __builtin_amdgcn_readfirstlane(tid >> 6), fr = lane & 15, fq = lane >> 4;
    LAS char* lds = (LAS char*)smem;
    LAS char* Us = lds;
    LAS char* Cs = lds + CV_UBYTES;
    __syncthreads();
    {
        const u32x4* src = (const u32x4*)(p.ut + (size_t)c * NBATCH * SEQ);
#pragma unroll
        for (int i = 0; i < 8; ++i) { const int id = tid + i * 512, row = id >> 3, ch = id & 7; *(LAS u32x4*)(Us + row * CV_UPITCH + ch * 16) = src[id]; }
    }
    {
        const float* kt = p.kt + (size_t)c * 8192;
        for (int id = tid; id < 4 * 4100; id += 512) {
            const int r = id / 4100, pos = (id % 4100) * 2;
            const int i0 = 8192 + r - pos, i1 = i0 - 1;
            const float v0 = (i0 >= 1 && i0 <= 8191) ? kt[i0] : 0.f, v1 = (i1 >= 1 && i1 <= 8191) ? kt[i1] : 0.f;
            *(LAS unsigned*)(Cs + r * CV_CPITCH + pos * 2) = pk2(v0, v1);
        }
    }
    __syncthreads();
    f32x4 acc[4][4];
#pragma unroll
    for (int mi = 0; mi < 4; ++mi)
#pragma unroll
        for (int ni = 0; ni < 4; ++ni) acc[mi][ni] = (f32x4){0.f, 0.f, 0.f, 0.f};
    LAS char* Ub = Us + b * 64 * CV_UPITCH;
    const int r4 = fr & 3;
    LAS char* lb = Cs + r4 * CV_CPITCH + (8 * fq - fr + r4 + 4096 - 48) * 2;
    typedef short s16x4 __attribute__((ext_vector_type(4)));
#define CV_LOAD(D, BF, AF) do { LAS char* bD_ = lb - 128 * (D); \
        _Pragma("unroll") for (int ni = 0; ni < 4; ++ni) _Pragma("unroll") for (int kk = 0; kk < 2; ++kk) { const int off_ = (kk * 32 + (3 - ni) * 16) * 2; \
            const s16x4 lo_ = *(const LAS s16x4*)(bD_ + off_), hi_ = *(const LAS s16x4*)(bD_ + off_ + 8); \
            BF[ni][kk] = (bf16x8){lo_[0], lo_[1], lo_[2], lo_[3], hi_[0], hi_[1], hi_[2], hi_[3]}; } \
        _Pragma("unroll") for (int mi = 0; mi < 4; ++mi) { const int ru_ = 16 * mi + fr - (D); const int rc_ = ru_ < 0 ? 0 : (ru_ > 63 ? 63 : ru_); \
            AF[mi][0] = *(const LAS bf16x8*)(Ub + rc_ * CV_UPITCH + fq * 16); AF[mi][1] = *(const LAS bf16x8*)(Ub + rc_ * CV_UPITCH + 64 + fq * 16); \
            if ((unsigned)ru_ >= 64u) { AF[mi][0] = (bf16x8){0, 0, 0, 0, 0, 0, 0, 0}; AF[mi][1] = AF[mi][0]; } } } while (0)
#define CV_MMA(D, BF, AF) do { const int ilo_ = (D) > 0 ? (D) : 0, ihi_ = (D) < 0 ? 63 + (D) : 63; \
        _Pragma("unroll") for (int mi = 0; mi < 4; ++mi) { if (16 * mi + 15 >= ilo_ && 16 * mi <= ihi_) { \
            _Pragma("unroll") for (int ni = 0; ni < 4; ++ni) { \
                acc[mi][ni] = __builtin_amdgcn_mfma_f32_16x16x32_bf16(AF[mi][0], BF[ni][0], acc[mi][ni], 0, 0, 0); \
                acc[mi][ni] = __builtin_amdgcn_mfma_f32_16x16x32_bf16(AF[mi][1], BF[ni][1], acc[mi][ni], 0, 0, 0); } } } } while (0)
    {
        bf16x8 bA[4][2], aA[4][2], bB[4][2], aB[4][2];
        CV_LOAD(-63, bA, aA);
        for (int D = -63; D <= 61; D += 2) {
            CV_LOAD(D + 1, bB, aB);
            CV_MMA(D, bA, aA);
            CV_LOAD(D + 2, bA, aA);
            CV_MMA(D + 1, bB, aB);
        }
        CV_MMA(63, bA, aA);
    }
#undef CV_LOAD
#undef CV_MMA
    const float dsk = p.hy_d[c];
#pragma unroll
    for (int mi = 0; mi < 4; ++mi)
#pragma unroll
        for (int ni = 0; ni < 4; ++ni)
#pragma unroll
            for (int rg = 0; rg < 4; ++rg) {
                LAS bf16_t* up = (LAS bf16_t*)(Ub + (16 * mi + 4 * fq + rg) * CV_UPITCH + (16 * ni + fr) * 2);
                const float y = acc[mi][ni][rg] + dsk * bf2f(*up);
                *up = f2bf(y);
            }
    asm volatile("s_waitcnt lgkmcnt(0)" ::: "memory");
    {
        const size_t base = ((size_t)c * NBATCH + b) * SEQ;
#pragma unroll
        for (int i = 0; i < 8; ++i) {
            const int id = lane + 64 * i, row = id >> 3, c8 = (id & 7) * 8;
            const bf16x8 yv = *(const LAS bf16x8*)(Ub + row * CV_UPITCH + c8 * 2);
            const bf16x8 hv = *(const bf16x8*)(p.hx0t + base + row * 64 + c8);
            u32x4 w;
            w.x = pk2(bf2f((bf16_t)yv[0]) * bf2f((bf16_t)hv[0]), bf2f((bf16_t)yv[1]) * bf2f((bf16_t)hv[1]));
            w.y = pk2(bf2f((bf16_t)yv[2]) * bf2f((bf16_t)hv[2]), bf2f((bf16_t)yv[3]) * bf2f((bf16_t)hv[3]));
            w.z = pk2(bf2f((bf16_t)yv[4]) * bf2f((bf16_t)hv[4]), bf2f((bf16_t)yv[5]) * bf2f((bf16_t)hv[5]));
            w.w = pk2(bf2f((bf16_t)yv[6]) * bf2f((bf16_t)hv[6]), bf2f((bf16_t)yv[7]) * bf2f((bf16_t)hv[7]));
            *(u32x4*)(p.zt + base + row * 64 + c8) = w;
        }
    }
}
__device__ __forceinline__ void moew_unit(const Params& p, int tu, char* smem, int wv) {
    const int tid = opaque_tid(wv), lane = tid & 63, wid = tid >> 6;
    LAS char* lds = (LAS char*)smem;
    __syncthreads();
    f32x4 ld[16];
#define MW_SRC(t, SRC, DST, MODE, K0, N0) do { const int tile_ = tu * 6 + (t), mat_ = tile_ >> 5, tt_ = tile_ & 31, which_ = mat_ / 32, e_ = mat_ % 32; \
        SRC = (which_ == 0 ? p.w_gate : which_ == 1 ? p.w_up : p.w_down) + (size_t)e_ * 1048576; \
        DST = which_ == 2 ? p.wd_t + (size_t)e_ * 1048576 : p.wgu_t + (size_t)e_ * 2097152; MODE = which_ == 0 ? 2 : which_ == 1 ? 3 : 0; K0 = (tt_ >> 2) * 128; N0 = (tt_ & 3) * 256; } while (0)
    {
        const float* src; bf16_t* dst; int mode, k0, n0; MW_SRC(0, src, dst, mode, k0, n0);
#pragma unroll
        for (int i = 0; i < 16; ++i) ld[i] = *(const f32x4*)(src + (size_t)(k0 + 16 * wid + i) * 1024 + n0 + lane * 4);
    }
    for (int t = 0; t < 6; ++t) {
        LAS char* buf = lds + (t & 1) * 65536;
#pragma unroll
        for (int c = 0; c < 4; ++c) {
            u32x4 w0, w1;
            w0.x = pk2(ld[0][c], ld[1][c]); w0.y = pk2(ld[2][c], ld[3][c]); w0.z = pk2(ld[4][c], ld[5][c]); w0.w = pk2(ld[6][c], ld[7][c]);
            w1.x = pk2(ld[8][c], ld[9][c]); w1.y = pk2(ld[10][c], ld[11][c]); w1.z = pk2(ld[12][c], ld[13][c]); w1.w = pk2(ld[14][c], ld[15][c]);
            LAS char* row = buf + (4 * lane + c) * 256;
            *(LAS u32x4*)(row + (((2 * wid) ^ (lane & 15)) << 4)) = w0;
            *(LAS u32x4*)(row + (((2 * wid + 1) ^ (lane & 15)) << 4)) = w1;
        }
        const float* src; bf16_t* dst; int mode, k0, n0; MW_SRC(t, src, dst, mode, k0, n0);
        if (t + 1 < 6) {
            const float* src2; bf16_t* dst2; int mode2, k02, n02; MW_SRC(t + 1, src2, dst2, mode2, k02, n02);
#pragma unroll
            for (int i = 0; i < 16; ++i) ld[i] = *(const f32x4*)(src2 + (size_t)(k02 + 16 * wid + i) * 1024 + n02 + lane * 4);
        }
        __syncthreads();
#pragma unroll
        for (int i = 0; i < 8; ++i) {
            const int n = i * 32 + (tid >> 4), kc = tid & 15;
            const u32x4 w = *(const LAS u32x4*)(buf + n * 256 + ((kc ^ ((n >> 2) & 15)) << 4));
            *(u32x4*)(dst + (size_t)rowmap(mode, n0 + n) * 1024 + k0 + kc * 8) = w;
        }
    }
#undef MW_SRC
}
__device__ __forceinline__ void phase_mix(const Params& p, int bid, int nblk, char* smem, int wv) {
    const int nsteps = (2048 + nblk - 1) / nblk;
    for (int j = 0; j < nsteps; ++j) {
        const int u = j * nblk + (bid + j) % nblk;
        if (u >= 2048) continue;
        const int g = u >> 3, r = u & 7;
        if (r < 4) attn_unit(p, ((g >> 5) * 4 + r) * 32 + (g & 31), smem, wv);
        else if (r < 6) conv_unit(p, g * 2 + (r - 4), smem, wv);
        else moew_unit(p, g * 2 + (r - 6), smem, wv);
    }
}

__device__ __forceinline__ void phase_hypost(const Params& p, int bid, int nblk, char* smem, int wv) {
    float* tz = (float*)smem;
    const int tid = opaque_tid(wv);
    for (int u = bid; u < 8 * 64 * 8; u += nblk) {
        const int g = u & 7, st = (u >> 3) & 63, b = u >> 9, s0 = st * 64;
        {
            const int c = tid >> 3, s8 = (tid & 7) * 8;
            const bf16x8 v = *(const bf16x8*)(p.zt + ((size_t)(g * 64 + c) * NBATCH + b) * SEQ + s0 + s8);
#pragma unroll
            for (int i = 0; i < 8; ++i) tz[c * 65 + s8 + i] = bf2f((bf16_t)v[i]);
        }
        __syncthreads();
        {
            const int s = tid >> 3, c8 = (tid & 7) * 8;
            float z[8]; float ss = 0.f;
#pragma unroll
            for (int i = 0; i < 8; ++i) { z[i] = tz[(c8 + i) * 65 + s]; ss += z[i] * z[i]; }
            ss += __shfl_xor(ss, 1); ss += __shfl_xor(ss, 2); ss += __shfl_xor(ss, 4);
            const float rstd = 1.0f / sqrtf(ss * (1.0f / 64.0f) + 1e-6f);
            u32x4 w;
            const float* gn = p.hy_gn + g * 64 + c8;
            w.x = pk2(z[0] * rstd * gn[0], z[1] * rstd * gn[1]); w.y = pk2(z[2] * rstd * gn[2], z[3] * rstd * gn[3]);
            w.z = pk2(z[4] * rstd * gn[4], z[5] * rstd * gn[5]); w.w = pk2(z[6] * rstd * gn[6], z[7] * rstd * gn[7]);
            *(u32x4*)(p.mixin + (size_t)(b * SEQ + s0 + s) * DM + 512 + g * 64 + c8) = w;
        }
        __syncthreads();
    }
}

struct EpiOutproj {
    const Params& p;
    static constexpr int BATCH = 4;
    typedef EpiNone ColPre; typedef EpiNone RowPre; struct Pre { f32x4 x[2][2]; };
    __device__ __forceinline__ ColPre colpre(const pg8::DenseUnit&, int) const { return ColPre{}; }
    __device__ __forceinline__ RowPre rowpre(const pg8::DenseUnit&, int, int) const { return RowPre{}; }
    __device__ __forceinline__ Pre pre(const pg8::DenseUnit& u, int r, int cb, const RowPre&, const ColPre&) const {
        const float* xp = p.x + (size_t)(u.pm * 256 + r) * DM + u.pn * 256 + cb; Pre x;
        x.x[0][0] = *(const f32x4*)xp; x.x[0][1] = *(const f32x4*)(xp + 4); x.x[1][0] = *(const f32x4*)(xp + 128); x.x[1][1] = *(const f32x4*)(xp + 132); return x; }
    __device__ __forceinline__ void store(const pg8::DenseUnit& u, int r, int cb, f32x4 v00, f32x4 v01, f32x4 v10, f32x4 v11, const RowPre&, const ColPre&, const Pre& x) const {
        float* op = p.out + (size_t)(u.pm * 256 + r) * DM + u.pn * 256 + cb;
        *(f32x4*)op = x.x[0][0] + v00; *(f32x4*)(op + 4) = x.x[0][1] + v01; *(f32x4*)(op + 128) = x.x[1][0] + v10; *(f32x4*)(op + 132) = x.x[1][1] + v11; }
};
__device__ __forceinline__ void phase_outproj(const Params& p, int bid, int nblk, char* smem, int wv) {
    pg8::DenseOrder S; S.init(T, 1024, 1024, p.wout_t, nblk, bid);
    pg8::gemm_phase((LAS unsigned char*)smem, (const char*)p.mixin, 1024, S, EpiOutproj{p}, wv);
}

constexpr int RT_PITCH = 1032;
__device__ __forceinline__ void phase_router(const Params& p, int bid, int nblk, char* smem, int wv) {
    const int tid = opaque_tid(wv), lane = tid & 63, wid = tid >> 6, fr = lane & 15, fq = lane >> 4;
    bf16_t* rwh = (bf16_t*)smem;
    bf16_t* rwl = rwh + 32 * RT_PITCH;
    float* lgs = (float*)(smem + 2 * 32 * RT_PITCH * 2) + wid * 512;
    for (int i = tid; i < 1024 * 32; i += 512) {
        const int k = i >> 5, e = i & 31; const float w = p.router_w[i];
        const bf16_t h = f2bf(w); rwh[e * RT_PITCH + k] = h; rwl[e * RT_PITCH + k] = f2bf(w - bf2f(h));
    }
    __syncthreads();
    int* hist = (int*)(smem + 2 * 32 * RT_PITCH * 2 + 8 * 2048);
    for (int g0 = bid * 8; g0 < T / 16; g0 += nblk * 8) {
        const int grp = g0 + wid; const bool live = grp < T / 16;
        const int t0 = (live ? grp : 0) * 16;
        if (tid < 32) hist[tid] = 0;
        const float* hrow = p.out + (size_t)(t0 + fr) * DM + fq * 8;
        bf16_t* hnrow = p.hn + (size_t)(t0 + fr) * DM + fq * 8;
        f32x4 acc0 = (f32x4){0.f, 0.f, 0.f, 0.f}, acc1 = acc0; float ss = 0.f;
#pragma unroll 4
        for (int ks = 0; ks < 32; ++ks) {
            const f32x4 h0 = *(const f32x4*)(hrow + ks * 32), h1 = *(const f32x4*)(hrow + ks * 32 + 4);
            const f32x4 g0 = *(const f32x4*)(p.g_ffn + ks * 32 + fq * 8), g1 = *(const f32x4*)(p.g_ffn + ks * 32 + fq * 8 + 4);
            ss += h0[0] * h0[0] + h0[1] * h0[1] + h0[2] * h0[2] + h0[3] * h0[3] + h1[0] * h1[0] + h1[1] * h1[1] + h1[2] * h1[2] + h1[3] * h1[3];
            const f32x4 x0 = h0 * g0, x1 = h1 * g1;
            const u32x4 hi = pk8(x0, x1);
            f32x4 r0, r1;
            r0[0] = x0[0] - __uint_as_float(hi.x << 16); r0[1] = x0[1] - __uint_as_float(hi.x & 0xFFFF0000u); r0[2] = x0[2] - __uint_as_float(hi.y << 16); r0[3] = x0[3] - __uint_as_float(hi.y & 0xFFFF0000u);
            r1[0] = x1[0] - __uint_as_float(hi.z << 16); r1[1] = x1[1] - __uint_as_float(hi.z & 0xFFFF0000u); r1[2] = x1[2] - __uint_as_float(hi.w << 16); r1[3] = x1[3] - __uint_as_float(hi.w & 0xFFFF0000u);
            const u32x4 lo = pk8(r0, r1);
            if (live) *(u32x4*)(hnrow + ks * 32) = hi;
            const bf16x8 ah = *reinterpret_cast<const bf16x8*>(&hi), al = *reinterpret_cast<const bf16x8*>(&lo);
            const bf16x8 bh0 = *(const bf16x8*)(rwh + fr * RT_PITCH + ks * 32 + fq * 8), bh1 = *(const bf16x8*)(rwh + (16 + fr) * RT_PITCH + ks * 32 + fq * 8);
            const bf16x8 bl0 = *(const bf16x8*)(rwl + fr * RT_PITCH + ks * 32 + fq * 8), bl1 = *(const bf16x8*)(rwl + (16 + fr) * RT_PITCH + ks * 32 + fq * 8);
            acc0 = __builtin_amdgcn_mfma_f32_16x16x32_bf16(ah, bh0, acc0, 0, 0, 0); acc1 = __builtin_amdgcn_mfma_f32_16x16x32_bf16(ah, bh1, acc1, 0, 0, 0);
            acc0 = __builtin_amdgcn_mfma_f32_16x16x32_bf16(al, bh0, acc0, 0, 0, 0); acc1 = __builtin_amdgcn_mfma_f32_16x16x32_bf16(al, bh1, acc1, 0, 0, 0);
            acc0 = __builtin_amdgcn_mfma_f32_16x16x32_bf16(ah, bl0, acc0, 0, 0, 0); acc1 = __builtin_amdgcn_mfma_f32_16x16x32_bf16(ah, bl1, acc1, 0, 0, 0);
        }
        ss += __shfl_xor(ss, 16); ss += __shfl_xor(ss, 32);
#pragma unroll
        for (int rg = 0; rg < 4; ++rg) { lgs[(4 * fq + rg) * 32 + fr] = acc0[rg]; lgs[(4 * fq + rg) * 32 + 16 + fr] = acc1[rg]; }
        asm volatile("s_waitcnt lgkmcnt(0)" ::: "memory");
        const int tk = lane >> 2;
        const float rstd = 1.0f / sqrtf(__shfl(ss, tk) * (1.0f / 1024.0f) + 1e-6f);
        float lg[32];
#pragma unroll
        for (int e4 = 0; e4 < 8; ++e4) { const f32x4 v = *(const f32x4*)(lgs + tk * 32 + e4 * 4); const f32x4 bb = *(const f32x4*)(p.router_b + e4 * 4);
            lg[4 * e4] = v[0] * rstd + bb[0]; lg[4 * e4 + 1] = v[1] * rstd + bb[1]; lg[4 * e4 + 2] = v[2] * rstd + bb[2]; lg[4 * e4 + 3] = v[3] * rstd + bb[3]; }
        int te[4]; float tl[4];
#pragma unroll
        for (int k = 0; k < 4; ++k) {
            float best = -3.0e38f; int bi = 0;
#pragma unroll
            for (int e = 0; e < 32; ++e) { if (lg[e] > best) { best = lg[e]; bi = e; } }
            te[k] = bi; tl[k] = best;
#pragma unroll
            for (int e = 0; e < 32; ++e) if (e == bi) lg[e] = -3.0e38f;
        }
        const float e1 = expf(tl[1] - tl[0]), e2 = expf(tl[2] - tl[0]), e3 = expf(tl[3] - tl[0]);
        const float inv = 1.0f / (1.0f + e1 + e2 + e3);
        const int kk = lane & 3;
        const int my_e = kk == 0 ? te[0] : kk == 1 ? te[1] : kk == 2 ? te[2] : te[3];
        const float my_w = (kk == 0 ? 1.0f : kk == 1 ? e1 : kk == 2 ? e2 : e3) * inv;
        __syncthreads();
        int lp = 0;
        if (live) lp = atomicAdd(hist + my_e, 1);
        __syncthreads();
        if (tid < 32) { const int n = hist[tid]; hist[32 + tid] = n ? atomicAdd(p.cnt + tid, n) : 0; }
        __syncthreads();
        if (live) {
            const int asg = grp * 64 + lane;
            const int ps = hist[32 + my_e] + lp;
            p.list[my_e * T + ps] = asg; p.listw[my_e * T + ps] = my_w; p.listr[my_e * T + ps] = rstd;
            p.tope[asg] = my_e; p.topw[asg] = my_w; p.pos[asg] = ps;
        }
        __syncthreads();
    }
    for (int i = bid * 512 + tid; i < T * 256 / 4; i += nblk * 512) { const float4 pv = ((const float4*)p.p)[i]; u32x2 w; w.x = pk2(pv.x, pv.y); w.y = pk2(pv.z, pv.w); *(u32x2*)(p.pb + (size_t)i * 4) = w; }
}

struct MoeTab { int tiles[33]; int start[33]; };
__device__ __forceinline__ void moe_setup(const Params& p, MoeTab* tab, int wv) {
    __syncthreads();
    if (xb_thread0(wv)) {
        int a = 0, b = 0;
        for (int e = 0; e < 32; ++e) { const int c = p.cnt[e]; tab->tiles[e] = a; tab->start[e] = b; a += (c + 255) >> 8; b += c; }
        tab->tiles[32] = a; tab->start[32] = b;
    }
    __syncthreads();
}
__device__ __forceinline__ int moe_find(const MoeTab* tab, int tile) {
    int e = 0;
#pragma unroll
    for (int i = 0; i < 32; ++i) if (tile >= tab->tiles[i + 1]) e = i + 1;
    return e;
}

struct MoeUnit1 {
    static constexpr bool GATHER = true;
    int e, tn, nvalid, slot0; const int* lst; const float* lstr; const char* bt;
    __device__ __forceinline__ const char* bbase() const { return bt; }
    __device__ __forceinline__ size_t abyte() const { return 0; }
    __device__ __forceinline__ unsigned arow_idx(int r) const { const int rr = r < nvalid ? r : nvalid - 1; return (unsigned)(lst[rr] >> 2); }
};
struct MoeUnit2 {
    static constexpr bool GATHER = false;
    int e, tn, nvalid, slot0; const int* lst; const float* lstw; const char* bt;
    __device__ __forceinline__ const char* bbase() const { return bt; }
    __device__ __forceinline__ size_t abyte() const { return (size_t)slot0 * 2048; }
    __device__ __forceinline__ unsigned arow_idx(int) const { return 0u; }
};
template <class U, int NT  > struct MoeOrder {
    typedef U Unit;
    const MoeTab* tab; const Params* p; int G, c;
    __device__ __forceinline__ unsigned rowbytes() const { return 2048u; }
    __device__ __forceinline__ bool next(int i, Unit& u) const {
        int tile, tn;
        if (G == 256) { const int x = c & 7, j = c >> 3; constexpr int TPX = 32 / NT; tile = i * (256 / NT) + x * TPX + j / NT; tn = j % NT; }
        else { const long L = (long)i * G + c; tile = (int)(L / NT); tn = (int)(L % NT); }
        if (tile >= __builtin_amdgcn_readfirstlane(tab->tiles[32])) return false;
        const int e = __builtin_amdgcn_readfirstlane(moe_find(tab, tile)), mt = tile - __builtin_amdgcn_readfirstlane(tab->tiles[e]);
        const int st0 = __builtin_amdgcn_readfirstlane(tab->start[e]), cnt = __builtin_amdgcn_readfirstlane(tab->start[e + 1]) - st0;
        u.e = e; u.tn = tn; u.nvalid = cnt - mt * 256 < 256 ? cnt - mt * 256 : 256; u.slot0 = st0 + mt * 256;
        u.lst = p->list + (size_t)e * T + mt * 256;
        fill(u, e, mt, tn);
        return true;
    }
    __device__ __forceinline__ void fill(MoeUnit1& u, int e, int mt, int tn) const { u.bt = (const char*)(p->wgu_t + (size_t)e * 2097152 + (size_t)tn * 256 * 1024); u.lstr = p->listr + (size_t)e * T + mt * 256; }
    __device__ __forceinline__ void fill(MoeUnit2& u, int e, int mt, int tn) const { u.bt = (const char*)(p->wd_t + (size_t)e * 1048576 + (size_t)tn * 256 * 1024); u.lstw = p->listw + (size_t)e * T + mt * 256; }
};
struct EpiMoe1 {
    const Params& p;
    static constexpr int BATCH = 8;
    struct ColPre { f32x4 bg[2], bu[2]; }; typedef float RowPre; typedef EpiNone Pre;
    __device__ __forceinline__ ColPre colpre(const MoeUnit1& u, int cb) const { const int j = u.e * 1024 + u.tn * 128 + cb; ColPre x;
        x.bg[0] = *(const f32x4*)(p.b_gate + j); x.bg[1] = *(const f32x4*)(p.b_gate + j + 4); x.bu[0] = *(const f32x4*)(p.b_up + j); x.bu[1] = *(const f32x4*)(p.b_up + j + 4); return x; }
    __device__ __forceinline__ RowPre rowpre(const MoeUnit1& u, int r, int) const { return r < u.nvalid ? u.lstr[r] : 0.f; }
    __device__ __forceinline__ Pre pre(const MoeUnit1&, int, int, const RowPre&, const ColPre&) const { return Pre{}; }
    __device__ __forceinline__ void store(const MoeUnit1& u, int r, int cb, f32x4 g0, f32x4 g1, f32x4 u0, f32x4 u1, const RowPre& rs, const ColPre& cp, const Pre&) const {
        if (r < u.nvalid) {
            f32x4 ga = g0 * rs + cp.bg[0], gb = g1 * rs + cp.bg[1], ua = u0 * rs + cp.bu[0], ub = u1 * rs + cp.bu[1];
#pragma unroll
            for (int i = 0; i < 4; ++i) { ga[i] = fminf(ga[i], 7.0f); gb[i] = fminf(gb[i], 7.0f); ua[i] = __builtin_amdgcn_fmed3f(ua[i], -7.0f, 7.0f); ub[i] = __builtin_amdgcn_fmed3f(ub[i], -7.0f, 7.0f); }
            f32x4 ea = ga * (-1.702f * 1.4426950408889634f), eb = gb * (-1.702f * 1.4426950408889634f);
#pragma unroll
            for (int i = 0; i < 4; ++i) { ea[i] = __builtin_amdgcn_exp2f(ea[i]); eb[i] = __builtin_amdgcn_exp2f(eb[i]); }
            ea = ea + 1.0f; eb = eb + 1.0f;
#pragma unroll
            for (int i = 0; i < 4; ++i) { ea[i] = __builtin_amdgcn_rcpf(ea[i]); eb[i] = __builtin_amdgcn_rcpf(eb[i]); }
            const f32x4 sa = ga * ea, sb = gb * eb;
            const f32x4 a0 = ua * sa + sa, a1 = ub * sb + sb;
            *(u32x4*)(p.act + (size_t)(u.slot0 + r) * DM + u.tn * 128 + cb) = pk8(a0, a1);
        }
    }
};
__device__ __forceinline__ void phase_moe1(const Params& p, int bid, int nblk, char* smem, int wv) {
    MoeTab* tab = (MoeTab*)(smem + 131072);
    moe_setup(p, tab, wv);
    MoeOrder<MoeUnit1, 8> S; S.tab = tab; S.p = &p; S.G = nblk; S.c = bid;
    pg8::gemm_phase((LAS unsigned char*)smem, (const char*)p.hn, 1024, S, EpiMoe1{p}, wv);
}
struct EpiMoe2 {
    const Params& p;
    static constexpr int BATCH = 1;
    struct ColPre { f32x4 bd[2][2]; }; struct RowPre { int asg; float w; }; struct Pre { f32x4 h[2][2]; };
    __device__ __forceinline__ ColPre colpre(const MoeUnit2& u, int cb) const { const float* bp = p.b_down + u.e * 1024 + u.tn * 256 + cb; ColPre x;
        x.bd[0][0] = *(const f32x4*)bp; x.bd[0][1] = *(const f32x4*)(bp + 4); x.bd[1][0] = *(const f32x4*)(bp + 128); x.bd[1][1] = *(const f32x4*)(bp + 132); return x; }
    __device__ __forceinline__ RowPre rowpre(const MoeUnit2& u, int r, int) const { RowPre x; x.asg = -1; x.w = 0.f; if (r < u.nvalid) { x.asg = u.lst[r]; x.w = u.lstw[r]; } return x; }
    __device__ __forceinline__ Pre pre(const MoeUnit2& u, int, int cb, const RowPre& rp, const ColPre&) const {
        Pre x; x.h[0][0] = (f32x4){0.f, 0.f, 0.f, 0.f}; x.h[0][1] = x.h[0][0]; x.h[1][0] = x.h[0][0]; x.h[1][1] = x.h[0][0];
        if (rp.asg >= 0 && (rp.asg & 3) == 0) { const float* hp = p.out + (size_t)(rp.asg >> 2) * DM + u.tn * 256 + cb;
            x.h[0][0] = *(const f32x4*)hp; x.h[0][1] = *(const f32x4*)(hp + 4); x.h[1][0] = *(const f32x4*)(hp + 128); x.h[1][1] = *(const f32x4*)(hp + 132); }
        return x; }
    __device__ __forceinline__ void store(const MoeUnit2& u, int, int cb, f32x4 v00, f32x4 v01, f32x4 v10, f32x4 v11, const RowPre& rp, const ColPre& cp, const Pre& x) const {
        if (rp.asg >= 0) {
            const int tok = rp.asg >> 2, k = rp.asg & 3, col = u.tn * 256 + cb;
            const f32x4 a = (v00 + cp.bd[0][0]) * rp.w, b = (v01 + cp.bd[0][1]) * rp.w, c = (v10 + cp.bd[1][0]) * rp.w, d = (v11 + cp.bd[1][1]) * rp.w;
            if (k == 0) { float* hp = p.out + (size_t)tok * DM + col;
                *(f32x4*)hp = x.h[0][0] + a; *(f32x4*)(hp + 4) = x.h[0][1] + b; *(f32x4*)(hp + 128) = x.h[1][0] + c; *(f32x4*)(hp + 132) = x.h[1][1] + d; }
            else { bf16_t* yp = p.y + ((size_t)tok * 3 + (k - 1)) * DM + col; *(u32x4*)yp = pk8(a, b); *(u32x4*)(yp + 128) = pk8(c, d); }
        }
    }
};
__device__ __forceinline__ void phase_moe2(const Params& p, int bid, int nblk, char* smem, int wv) {
    MoeTab* tab = (MoeTab*)(smem + 131072);
    moe_setup(p, tab, wv);
    MoeOrder<MoeUnit2, 4> S; S.tab = tab; S.p = &p; S.G = nblk; S.c = bid;
    pg8::gemm_phase((LAS unsigned char*)smem, (const char*)p.act, 1024, S, EpiMoe2{p}, wv);
}
struct EpiPle {
    const Params& p;
    static constexpr int BATCH = 8;
    typedef EpiNone ColPre; typedef EpiNone RowPre; typedef EpiNone Pre;
    __device__ __forceinline__ ColPre colpre(const pg8::DenseUnit&, int) const { return ColPre{}; }
    __device__ __forceinline__ RowPre rowpre(const pg8::DenseUnit&, int, int) const { return RowPre{}; }
    __device__ __forceinline__ Pre pre(const pg8::DenseUnit&, int, int, const RowPre&, const ColPre&) const { return Pre{}; }
    __device__ __forceinline__ void store(const pg8::DenseUnit& u, int r, int cb, f32x4 v00, f32x4 v01, f32x4 v10, f32x4 v11, const RowPre&, const ColPre&, const Pre&) const {
        const int row = u.pm * 256 + r;
        bf16_t* ep = p.epre + (size_t)row * DM + u.pn * 256 + cb;
        const u32x4 w0 = pk8(v00, v01), w1 = pk8(v10, v11);
        *(u32x4*)ep = w0; *(u32x4*)(ep + 128) = w1;
        float s = 0.f;
#pragma unroll
        for (int i = 0; i < 4; ++i) { const unsigned a = w0[i], b = w1[i];
            const float a0 = __uint_as_float(a << 16), a1 = __uint_as_float(a & 0xFFFF0000u), b0 = __uint_as_float(b << 16), b1 = __uint_as_float(b & 0xFFFF0000u);
            s += a0 * a0 + a1 * a1 + b0 * b0 + b1 * b1; }
        s += __shfl_xor(s, 16); s += __shfl_xor(s, 32);
        if (((cb >> 3) & 3) == 0) atomicAdd(p.rstd_e + row, s); }
};
__device__ __forceinline__ void phase_ple(const Params& p, int bid, int nblk, char* smem, int wv) {
    pg8::DenseOrder S; S.init(T, 1024, 256, p.wple_t, nblk, bid);
    pg8::gemm_phase((LAS unsigned char*)smem, (const char*)p.pb, 256, S, EpiPle{p}, wv);
}
__device__ __forceinline__ void phase_combine(const Params& p, int bid, int nblk, char* smem, int wv) {
    const int tid = opaque_tid(wv), lane = tid & 63, wid = tid >> 6;
    for (int t0 = (bid * 8 + wid) * 2; t0 < T; t0 += nblk * 16) {
        float4 h[2][4]; u32x2 yv[2][4][3];
#pragma unroll
        for (int rr = 0; rr < 2; ++rr)
#pragma unroll
            for (int i = 0; i < 4; ++i) { const int c4 = lane + 64 * i; h[rr][i] = ((const float4*)(p.out + (size_t)(t0 + rr) * DM))[c4];
#pragma unroll
                for (int k = 0; k < 3; ++k) yv[rr][i][k] = *(const u32x2*)(p.y + ((size_t)(t0 + rr) * 3 + k) * DM + c4 * 4); }
#pragma unroll
        for (int rr = 0; rr < 2; ++rr)
#pragma unroll
            for (int i = 0; i < 4; ++i) { const int c4 = lane + 64 * i; float4 hh = h[rr][i];
#pragma unroll
                for (int k = 0; k < 3; ++k) { const u32x2 y = yv[rr][i][k];
                    hh.x += __uint_as_float(y.x << 16); hh.y += __uint_as_float(y.x & 0xFFFF0000u); hh.z += __uint_as_float(y.y << 16); hh.w += __uint_as_float(y.y & 0xFFFF0000u); }
                ((float4*)(p.out + (size_t)(t0 + rr) * DM))[c4] = hh;
                u32x2 w; w.x = pk2(hh.x, hh.y); w.y = pk2(hh.z, hh.w);
                *(u32x2*)(p.h2b + (size_t)(t0 + rr) * DM + c4 * 4) = w; }
    }
}
struct EpiGate {
    const Params& p;
    static constexpr int BATCH = 2;
    struct ColPre { f32x4 bg[2][2], gp[2][2]; }; typedef float RowPre; struct Pre { f32x4 h[2][2]; u32x4 ev[2]; };
    __device__ __forceinline__ ColPre colpre(const pg8::DenseUnit& u, int cb) const { ColPre x;
#pragma unroll
        for (int bj = 0; bj < 2; ++bj)
#pragma unroll
            for (int n = 0; n < 2; ++n) { const int c = u.pn * 256 + bj * 128 + cb + 4 * n; x.bg[bj][n] = *(const f32x4*)(p.b_pg + c); x.gp[bj][n] = *(const f32x4*)(p.g_ple + c); }
        return x; }
    __device__ __forceinline__ RowPre rowpre(const pg8::DenseUnit& u, int r, int) const { return __builtin_amdgcn_rsqf(p.rstd_e[u.pm * 256 + r] * (1.0f / 1024.0f) + 1e-6f); }
    __device__ __forceinline__ Pre pre(const pg8::DenseUnit& u, int r, int cb, const RowPre&, const ColPre&) const {
        const size_t off = (size_t)(u.pm * 256 + r) * DM + u.pn * 256 + cb; Pre x;
        x.h[0][0] = *(const f32x4*)(p.out + off); x.h[0][1] = *(const f32x4*)(p.out + off + 4); x.h[1][0] = *(const f32x4*)(p.out + off + 128); x.h[1][1] = *(const f32x4*)(p.out + off + 132);
        x.ev[0] = *(const u32x4*)(p.epre + off); x.ev[1] = *(const u32x4*)(p.epre + off + 128); return x; }
    __device__ __forceinline__ void store(const pg8::DenseUnit& u, int r, int cb, f32x4 v00, f32x4 v01, f32x4 v10, f32x4 v11, const RowPre& rs, const ColPre& cp, const Pre& x) const {
        const size_t off = (size_t)(u.pm * 256 + r) * DM + u.pn * 256 + cb;
#pragma unroll
        for (int bj = 0; bj < 2; ++bj)
#pragma unroll
            for (int n = 0; n < 2; ++n) {
                const f32x4 v = bj ? (n ? v11 : v10) : (n ? v01 : v00);
                const unsigned w0 = n ? x.ev[bj].z : x.ev[bj].x, w1 = n ? x.ev[bj].w : x.ev[bj].y;
                f32x4 e; e[0] = __uint_as_float(w0 << 16); e[1] = __uint_as_float(w0 & 0xFFFF0000u); e[2] = __uint_as_float(w1 << 16); e[3] = __uint_as_float(w1 & 0xFFFF0000u);
                f32x4 h = x.h[bj][n];
#pragma unroll
                for (int i = 0; i < 4; ++i) h[i] += sigmoidf_(v[i] + cp.bg[bj][n][i]) * (e[i] * rs * cp.gp[bj][n][i]);
                *(f32x4*)(p.out + off + bj * 128 + n * 4) = h;
            }
    }
};
__device__ __forceinline__ void phase_gate(const Params& p, int bid, int nblk, char* smem, int wv) {
    pg8::DenseOrder S; S.init(T, 1024, 1024, p.wpg_t, nblk, bid);
    pg8::gemm_phase((LAS unsigned char*)smem, (const char*)p.h2b, 1024, S, EpiGate{p}, wv);
}
__device__ __forceinline__ void phase_final(const Params& p, int bid, int nblk, char* smem, int wv) {
    const int tid = opaque_tid(wv), lane = tid & 63, wid = tid >> 6;
    float4 g[4];
#pragma unroll
    for (int i = 0; i < 4; ++i) g[i] = ((const float4*)p.g_final)[lane + 64 * i];
    for (int t = (bid * 8 + wid) * 2; t < T; t += nblk * 16) {
        float4* hr0 = (float4*)(p.out + (size_t)t * DM); float4* hr1 = hr0 + DM / 4;
        float4 v0[4], v1[4]; float s0 = 0.f, s1 = 0.f;
#pragma unroll
        for (int i = 0; i < 4; ++i) { v0[i] = hr0[lane + 64 * i]; v1[i] = hr1[lane + 64 * i]; }
#pragma unroll
        for (int i = 0; i < 4; ++i) { s0 += v0[i].x * v0[i].x + v0[i].y * v0[i].y + v0[i].z * v0[i].z + v0[i].w * v0[i].w; s1 += v1[i].x * v1[i].x + v1[i].y * v1[i].y + v1[i].z * v1[i].z + v1[i].w * v1[i].w; }
        s0 = wave_sum(s0); s1 = wave_sum(s1);
        const float r0 = __builtin_amdgcn_rsqf(s0 * (1.0f / 1024.0f) + 1e-6f), r1 = __builtin_amdgcn_rsqf(s1 * (1.0f / 1024.0f) + 1e-6f);
#pragma unroll
        for (int i = 0; i < 4; ++i) {
            hr0[lane + 64 * i] = make_float4(v0[i].x * r0 * g[i].x, v0[i].y * r0 * g[i].y, v0[i].z * r0 * g[i].z, v0[i].w * r0 * g[i].w);
            hr1[lane + 64 * i] = make_float4(v1[i].x * r1 * g[i].x, v1[i].y * r1 * g[i].y, v1[i].z * r1 * g[i].z, v1[i].w * r1 * g[i].w);
        }
    }
}

template <int PH> __device__ __forceinline__ void run_phase(const Params& p, int bid, int nblk, char* smem, int wv) {
    if constexpr (PH == 0) phase_prologue(p, bid, nblk, smem, wv);
    else if constexpr (PH == 1) phase_inproj(p, bid, nblk, smem, wv);
    else if constexpr (PH == 2) phase_hyprep(p, bid, nblk, smem, wv);
    else if constexpr (PH == 3) phase_mix(p, bid, nblk, smem, wv);
    else if constexpr (PH == 4) phase_hypost(p, bid, nblk, smem, wv);
    else if constexpr (PH == 5) phase_outproj(p, bid, nblk, smem, wv);
    else if constexpr (PH == 6) phase_router(p, bid, nblk, smem, wv);
    else if constexpr (PH == 7) phase_moe1(p, bid, nblk, smem, wv);
    else if constexpr (PH == 8) phase_moe2(p, bid, nblk, smem, wv);
    else if constexpr (PH == 9) { phase_ple(p, bid, nblk, smem, wv); phase_combine(p, bid, nblk, smem, wv); }
    else if constexpr (PH == 10) {}
    else if constexpr (PH == 11) phase_gate(p, bid, nblk, smem, wv);
    else if constexpr (PH == 12) phase_final(p, bid, nblk, smem, wv);
}

template <int PH> __global__ void __launch_bounds__(512, 2) k_phase(Params p) {
    extern __shared__ __attribute__((aligned(16))) char smem[];
    run_phase<PH>(p, blockIdx.x, gridDim.x, smem, __builtin_amdgcn_readfirstlane(threadIdx.x >> 6));
}

__global__ void __launch_bounds__(512, 2) k_mega(Params p) {
    extern __shared__ __attribute__((aligned(16))) char smem[];
    const int bid = blockIdx.x, nblk = gridDim.x, wv = __builtin_amdgcn_readfirstlane(threadIdx.x >> 6);
    uint4* xbw = (uint4*)(smem + LDS_BYTES - 16);
    if (xb_thread0(wv)) *xbw = make_uint4(0u, 0u, 0u, 0u);
    __syncthreads();
    XcdBarrier bar = xcd_barrier_post(p.bar, (volatile LAS unsigned*)xbw, wv);
    run_phase<0>(p, bid, nblk, smem, wv); xcd_barrier(bar);
    run_phase<1>(p, bid, nblk, smem, wv); xcd_barrier(bar);
    run_phase<2>(p, bid, nblk, smem, wv); xcd_barrier(bar);
    run_phase<3>(p, bid, nblk, smem, wv); xcd_barrier(bar);
    run_phase<4>(p, bid, nblk, smem, wv); xcd_barrier(bar);
    run_phase<5>(p, bid, nblk, smem, wv); xcd_barrier(bar);
    run_phase<6>(p, bid, nblk, smem, wv); xcd_barrier(bar);
    run_phase<7>(p, bid, nblk, smem, wv); xcd_barrier(bar);
    run_phase<8>(p, bid, nblk, smem, wv); xcd_barrier(bar);
    run_phase<9>(p, bid, nblk, smem, wv); xcd_barrier(bar);
    run_phase<11>(p, bid, nblk, smem, wv); xcd_barrier(bar);
    run_phase<12>(p, bid, nblk, smem, wv);
}

template <int PH> static void launch_phase(const Params& p, int grid, hipStream_t stream) {
    static bool attr = false;
    if (!attr) { (void)hipFuncSetAttribute((const void*)k_phase<PH>, hipFuncAttributeMaxDynamicSharedMemorySize, LDS_BYTES); attr = true; }
    hipLaunchKernelGGL(k_phase<PH>, dim3(grid), dim3(512), LDS_BYTES, stream, p);
}

extern "C" void kernel_launch(void* const* d_in, const int* in_sizes, int n_in,
                              void* d_out, int out_size, void* d_ws, size_t ws_size,
                              hipStream_t stream) {
    constexpr size_t MiB = 1048576;
    char* ws = (char*)d_ws;
    size_t off = 0;
    auto take = [&](size_t bytes) { char* r = ws + off; off += (bytes + 255) & ~(size_t)255; return r; };
    Params p{};
    const float** in = (const float**)&p.x;
    for (int i = 0; i < 34; ++i) in[i] = (const float*)d_in[i];
    p.out = (float*)d_out;
    char* ctrl = take(65536);
    p.bar = (unsigned*)ctrl; p.cnt = (int*)(ctrl + 16384); p.lam = (float*)(ctrl + 32768); p.kmax = (int*)(ctrl + 20480);
    p.rope = (float2*)take(1 * MiB);
    p.kt = (float*)take(16 * MiB);
    p.pb = (bf16_t*)p.kt;
    p.win_t = (bf16_t*)take(6 * MiB); p.wout_t = (bf16_t*)take(2 * MiB); p.wple_t = (bf16_t*)take(MiB / 2); p.wpg_t = (bf16_t*)take(2 * MiB);
    p.tope = (int*)take(MiB / 2); p.topw = (float*)take(MiB / 2); p.pos = (int*)take(MiB / 2); p.list = (int*)take(4 * MiB); p.listw = (float*)take(4 * MiB); p.listr = (float*)take(4 * MiB); p.rstd_e = (float*)take(MiB / 8);
    p.wd_t = (bf16_t*)take(64 * MiB);
    p.wgu_t = (bf16_t*)take(128 * MiB);
    char* dyn = ws + off;
    p.xn = (bf16_t*)dyn; p.ut = (bf16_t*)dyn; p.hx0t = (bf16_t*)(dyn + 32 * MiB);
    p.q = (bf16_t*)(dyn + 64 * MiB); p.k = (bf16_t*)(dyn + 96 * MiB); p.v = (bf16_t*)(dyn + 128 * MiB);
    p.hy = (bf16_t*)(dyn + 160 * MiB); p.zt = (bf16_t*)(dyn + 160 * MiB); p.mixin = (bf16_t*)(dyn + 192 * MiB);
    p.hn = (bf16_t*)dyn; p.act = (bf16_t*)(dyn + 64 * MiB);
    p.y = p.wgu_t;
    p.h2b = (bf16_t*)(dyn + 64 * MiB); p.epre = (bf16_t*)(dyn + 128 * MiB);
    const size_t need = off + 64 * MiB + (size_t)(131072 + 256) * 2048;
    if (ws_size < need || n_in != 34 || out_size != T * DM) { fprintf(stderr, "kernel_launch: bad sizes ws %zu need %zu\n", ws_size, need); return; }

    (void)hipMemsetAsync(ctrl, 0, 32768, stream);
#if MK_ONE_LAUNCH
    static int grid = 0;
    if (!grid) {
        int dev = 0, cus = 0, per_cu = 0;
        (void)hipGetDevice(&dev);
        (void)hipDeviceGetAttribute(&cus, hipDeviceAttributeMultiprocessorCount, dev);
        (void)hipFuncSetAttribute((const void*)k_mega, hipFuncAttributeMaxDynamicSharedMemorySize, LDS_BYTES);
        (void)hipOccupancyMaxActiveBlocksPerMultiprocessor(&per_cu, (const void*)k_mega, 512, LDS_BYTES);
        grid = cus * (per_cu < 1 ? per_cu : 1);
    }
    if (grid > 0) hipLaunchKernelGGL(k_mega, dim3(grid), dim3(512), LDS_BYTES, stream, p);
#else
    const int grid = 256;
    launch_phase<0>(p, grid, stream); launch_phase<1>(p, grid, stream); launch_phase<2>(p, grid, stream); launch_phase<3>(p, grid, stream);
    launch_phase<4>(p, grid, stream); launch_phase<5>(p, grid, stream); launch_phase<6>(p, grid, stream); launch_phase<7>(p, grid, stream);
    launch_phase<8>(p, grid, stream); launch_phase<9>(p, grid, stream); launch_phase<10>(p, grid, stream); launch_phase<11>(p, grid, stream);
    launch_phase<12>(p, grid, stream);
#endif
}
```

```cpp
#include <hip/hip_runtime.h>
#include <stdint.h>
#include <stdio.h>

#ifndef MK_ONE_LAUNCH
#define MK_ONE_LAUNCH 1
#endif

#define LAS __attribute__((address_space(3)))
typedef unsigned short bf16_t;
typedef short bf16x8 __attribute__((ext_vector_type(8)));
typedef float f32x4 __attribute__((ext_vector_type(4)));
typedef unsigned u32x4 __attribute__((ext_vector_type(4)));
typedef unsigned u32x2 __attribute__((ext_vector_type(2)));

constexpr int T = 32768, DM = 1024, SEQ = 4096, NBATCH = 8, NH = 4, NEXP = 32, HW = 512;
constexpr int LDS_BYTES = 163840;

#define XB_TMO      128
#define XB_XCNT(j)  (256  + 64 * (j))
#define XB_XSUB(j)  (1280 + 64 * (j))
#define XB_XGEN(j)  (2304 + 64 * (j))
#define XB_TOP      3328
#define XB_TOPGEN   3392
#define XCD_BAR_WORDS 3456
#define XB_SPIN_CAP (1u << 18)

__device__ __forceinline__ unsigned xb_ld(unsigned* p)              { return __hip_atomic_load(p, __ATOMIC_RELAXED, __HIP_MEMORY_SCOPE_AGENT); }
__device__ __forceinline__ unsigned xb_add(unsigned* p, unsigned v) { return __hip_atomic_fetch_add(p, v, __ATOMIC_RELAXED, __HIP_MEMORY_SCOPE_AGENT); }
__device__ __forceinline__ unsigned xb_xcc_id() { return (unsigned)__builtin_amdgcn_s_getreg((3 << 11) | 20) & 0xFu; }
#define XB_SPIN(cond, bar) do { unsigned _sp = 0; while (cond) { __builtin_amdgcn_s_sleep(1); \
    if ((++_sp & 255u) == 0u) { if (xb_ld(&(bar)[XB_TMO])) break; if (_sp > XB_SPIN_CAP) { atomicAdd(&(bar)[XB_TMO], 1u); break; } } } } while (0)

struct XcdBarrier { unsigned* bar; unsigned x; volatile LAS unsigned* st; int wv; };
__device__ __forceinline__ unsigned lane_id_volatile() { unsigned l; asm volatile("v_mbcnt_lo_u32_b32 %0, -1, 0\n\tv_mbcnt_hi_u32_b32 %0, -1, %0" : "=v"(l)); return l; }
__device__ __forceinline__ bool xb_thread0(int wv) { return wv == 0 && lane_id_volatile() == 0u; }

__device__ __forceinline__ XcdBarrier xcd_barrier_post(unsigned* bar, volatile LAS unsigned* st, int wv) {
    XcdBarrier b; b.bar = bar; b.x = xb_xcc_id(); b.st = st; b.wv = wv;
    if (xb_thread0(wv)) (void)xb_add(&bar[XB_XCNT(b.x)], 1u);
    return b;
}
__device__ __forceinline__ void xcd_barrier_complete(unsigned* bar, unsigned x, unsigned& nloc, unsigned& nx) {
    const unsigned G = gridDim.x * gridDim.y * gridDim.z;
    unsigned sum, cnt, mine, sp = 0u;
    for (;;) {
        sum = 0u; cnt = 0u; mine = 0u;
#pragma unroll
        for (unsigned j = 0; j < 16; ++j) { const unsigned c = xb_ld(&bar[XB_XCNT(j)]); sum += c; cnt += (c > 0u) ? 1u : 0u; mine = (j == x) ? c : mine; }
        if (sum == G) break;
        __builtin_amdgcn_s_sleep(1);
        if ((++sp & 255u) == 0u) { if (xb_ld(&bar[XB_TMO])) break; if (sp > XB_SPIN_CAP) { atomicAdd(&bar[XB_TMO], 1u); break; } }
    }
    nloc = mine > 0u ? mine : 1u; nx = cnt > 0u ? cnt : 1u;
}
__device__ __forceinline__ void xcd_barrier(const XcdBarrier& b) {
    asm volatile("s_waitcnt vmcnt(0)" ::: "memory");
    __syncthreads();
    if (xb_thread0(b.wv)) {
        unsigned* bar = b.bar;
        __builtin_amdgcn_s_waitcnt(0);
        unsigned nloc = b.st[0], nx = b.st[1];
        if (nloc == 0u) { xcd_barrier_complete(bar, b.x, nloc, nx); b.st[0] = nloc; b.st[1] = nx; }
        const unsigned old = xb_add(&bar[XB_XSUB(b.x)], 1u);
        const unsigned gen = old / nloc;
        if (old + 1u == (gen + 1u) * nloc) {
            __builtin_amdgcn_fence(__ATOMIC_RELEASE, "agent");
            asm volatile("s_waitcnt vmcnt(0)" ::: "memory");
            const unsigned og = xb_add(&bar[XB_TOP], 1u);
            const unsigned tg = og / nx;
            if (og + 1u == (tg + 1u) * nx) xb_add(&bar[XB_TOPGEN], 1u);
            else XB_SPIN(xb_ld(&bar[XB_TOPGEN]) == tg, bar);
            __builtin_amdgcn_fence(__ATOMIC_ACQUIRE, "agent");
            xb_add(&bar[XB_XGEN(b.x)], 1u);
            asm volatile("s_waitcnt vmcnt(0)" ::: "memory");
        } else {
            XB_SPIN(xb_ld(&bar[XB_XGEN(b.x)]) == gen, bar);
            __builtin_amdgcn_fence(__ATOMIC_ACQUIRE, "agent");
            asm volatile("s_waitcnt vmcnt(0)" ::: "memory");
        }
    }
    __syncthreads();
}

__device__ __forceinline__ float bf2f(bf16_t b) { return __uint_as_float(((unsigned)b) << 16); }
typedef float f32x2_t __attribute__((ext_vector_type(2)));
typedef __bf16 bf16x2_t __attribute__((ext_vector_type(2)));
__device__ __forceinline__ unsigned pk2(float lo, float hi) { const f32x2_t v = {lo, hi}; bf16x2_t b = __builtin_convertvector(v, bf16x2_t); return *reinterpret_cast<unsigned*>(&b); }
__device__ __forceinline__ bf16_t f2bf(float f) { return (bf16_t)(pk2(f, 0.f) & 0xFFFFu); }
__device__ __forceinline__ float wave_sum(float v) {
#pragma unroll
    for (int o = 32; o >= 1; o >>= 1) v += __shfl_xor(v, o);
    return v;
}
__device__ __forceinline__ int opaque_tid(int wv) { int t = wv * 64 + (int)lane_id_volatile(); return t; }
__device__ __forceinline__ float sigmoidf_(float x) { return __builtin_amdgcn_rcpf(1.0f + __builtin_amdgcn_exp2f(-1.4426950408889634f * x)); }

struct Params {
    const float *x, *p, *g_mix, *w_in, *conv_w, *conv_b, *flt_w1, *flt_b1, *flt_wi, *flt_bi, *flt_freq, *flt_wo, *hy_d, *hy_gn,
                *lq1, *lk1, *lq2, *lk2, *subln, *w_out, *g_ffn, *router_w, *router_b, *w_gate, *b_gate, *w_up, *b_up, *w_down, *b_down,
                *w_ple, *g_ple, *w_pg, *b_pg, *g_final;
    float* out;
    unsigned* bar; int* cnt; float* lam; int* kmax;
    float2* rope; float* kt;
    bf16_t *win_t, *wout_t, *wple_t, *wpg_t, *wgu_t, *wd_t;
    int *tope, *pos, *list; float *topw, *rstd_e, *listw, *listr;
    bf16_t *xn, *q, *k, *v, *hy, *ut, *hx0t, *zt, *mixin, *hn, *act, *y, *pb, *h2b, *epre;
};

__device__ __forceinline__ float lambda_full(const Params& p) {
    float s1 = 0.f, s2 = 0.f;
    for (int i = 0; i < 64; ++i) { s1 += p.lq1[i] * p.lk1[i]; s2 += p.lq2[i] * p.lk2[i]; }
    return expf(s1) - expf(s2) + 0.2f;
}

template <class ARow, class Epi>
__device__ __forceinline__ void gemm_tile_simple(int K, ARow arow, const bf16_t* __restrict__ Bt, Epi epi) {
    const int lane = threadIdx.x & 63, wid = threadIdx.x >> 6, wm = wid & 3, wn = wid >> 2, fr = lane & 15, fq = lane >> 4;
    f32x4 acc[4][4];
#pragma unroll
    for (int i = 0; i < 4; ++i)
#pragma unroll
        for (int j = 0; j < 4; ++j) acc[i][j] = (f32x4){0.f, 0.f, 0.f, 0.f};
    const bf16_t* ap[4]; const bf16_t* bp[4];
#pragma unroll
    for (int i = 0; i < 4; ++i) ap[i] = arow(wm * 64 + i * 16 + fr) + fq * 8;
#pragma unroll
    for (int j = 0; j < 4; ++j) bp[j] = Bt + (size_t)(wn * 64 + j * 16 + fr) * K + fq * 8;
    for (int k = 0; k < K; k += 32) {
        bf16x8 a[4], b[4];
#pragma unroll
        for (int i = 0; i < 4; ++i) a[i] = *(const bf16x8*)(ap[i] + k);
#pragma unroll
        for (int j = 0; j < 4; ++j) b[j] = *(const bf16x8*)(bp[j] + k);
#pragma unroll
        for (int i = 0; i < 4; ++i)
#pragma unroll
            for (int j = 0; j < 4; ++j) acc[i][j] = __builtin_amdgcn_mfma_f32_16x16x32_bf16(b[j], a[i], acc[i][j], 0, 0, 0);
    }
#pragma unroll
    for (int i = 0; i < 4; ++i)
#pragma unroll
        for (int j = 0; j < 4; ++j) epi(wm * 64 + i * 16 + fr, wn * 64 + j * 16 + fq * 4, acc[i][j]);
}


namespace pg8 {
constexpr int BM = 256, BK = 64, HALF = 128, HTB = HALF * BK * 2, STAGE_BYTES = 8 * HTB;
__device__ __forceinline__ int lds_byte(int r, int c) { const int st = (r >> 4) * 2 + (c >> 5), rr = r & 15, cc = c & 31, ob = rr * 64 + cc * 2; return st * 1024 + (ob ^ (((ob >> 9) & 1) << 5)); }
__device__ __forceinline__ int perm32(int rho) { const int n = rho >> 4, i = rho & 15; return 8 * (i >> 2) + 4 * n + (i & 3); }
__device__ __forceinline__ void stage_rc(int b, int& R, int& C) { const int st = b / 1024, sb = b % 1024, swz = sb ^ (((sb >> 9) & 1) << 5); R = (st >> 1) * 16 + swz / 64; C = (st & 1) * 32 + (swz % 64) / 2; }

template <class Sched, class Epi>
__device__ __forceinline__ void gemm_phase(LAS unsigned char* lds, const char* Abase, int K_, const Sched& S, const Epi& E, int wv) {
    int K = K_;
    typedef typename Sched::Unit Unit;
    const int tid = opaque_tid(wv);
    const int wid = __builtin_amdgcn_readfirstlane(tid >> 6), lane = tid & 63, wr = wid >> 2, wc = wid & 3, fr = lane & 15, fq = lane >> 4;
    asm volatile("" : "+s"(K));
    const int nt = K / BK;
    int sR[2], sC[2]; unsigned voffB[2];
#pragma unroll
    for (int i = 0; i < 2; ++i) { stage_rc(tid * 16 + i * 8192, sR[i], sC[i]); const int Rb = (sR[i] & ~31) + perm32(sR[i] & 31); voffB[i] = (unsigned)(Rb * K + sC[i]) * 2u; }
    const size_t kstep = (size_t)(BK * 2);
    const size_t hstep = (size_t)HALF * K * 2;
    const unsigned ldsw = (unsigned)wid * 1024u;
    const int aoff = lds_byte(wr * 64 + fr, fq * 8), boff = lds_byte(wc * 32 + fr, fq * 8);
#define PG8_SA(b, h) (((b) * 2 + (h)) * HTB)
#define PG8_SB(b, h) ((4 + (b) * 2 + (h)) * HTB)
#define PG8_STAGEB(bufoff, gbase) do { _Pragma("unroll") for (int _i = 0; _i < 2; ++_i) \
        __builtin_amdgcn_global_load_lds((const unsigned*)((const char*)(gbase) + voffB[_i]), (LAS unsigned*)(lds + (bufoff) + ldsw + _i * 8192), 16, 0, 0); } while (0)
#define PG8_STAGEA(bufoff, gbase, o0, o1) do { \
        __builtin_amdgcn_global_load_lds((const unsigned*)((const char*)(gbase) + (o0)), (LAS unsigned*)(lds + (bufoff) + ldsw), 16, 0, 0); \
        __builtin_amdgcn_global_load_lds((const unsigned*)((const char*)(gbase) + (o1)), (LAS unsigned*)(lds + (bufoff) + ldsw + 8192), 16, 0, 0); } while (0)
#define PG8_LDA(dst, b, h) do { _Pragma("unroll") for (int m = 0; m < 4; ++m) _Pragma("unroll") for (int k = 0; k < 2; ++k) dst[m][k] = *(const LAS bf16x8*)(lds + PG8_SA(b, h) + aoff + m * 2048 + k * 1024); } while (0)
#define PG8_LDB(dst, b, h) do { _Pragma("unroll") for (int n = 0; n < 2; ++n) _Pragma("unroll") for (int k = 0; k < 2; ++k) dst[n][k] = *(const LAS bf16x8*)(lds + PG8_SB(b, h) + boff + n * 2048 + k * 1024); } while (0)
#define PG8_MMA(ai, bj, At, Bt) do { __builtin_amdgcn_s_setprio(1); _Pragma("unroll") for (int m = 0; m < 4; ++m) _Pragma("unroll") for (int n = 0; n < 2; ++n) _Pragma("unroll") for (int k = 0; k < 2; ++k) \
        acc[ai][bj][m][n] = __builtin_amdgcn_mfma_f32_16x16x32_bf16(Bt[n][k], At[m][k], acc[ai][bj][m][n], 0, 0, 0); __builtin_amdgcn_s_setprio(0); } while (0)
#define PG8_WAIT_V(n) asm volatile("s_waitcnt vmcnt(" #n ")" ::: "memory")
#define PG8_WAIT_L(n) asm volatile("s_waitcnt lgkmcnt(" #n ")" ::: "memory")
#define PG8_BAR __builtin_amdgcn_s_barrier()
#define PG8_SCHED __builtin_amdgcn_sched_barrier(0)
    Unit cur, nxt; int ui = 0;
    if (!S.next(0, cur)) return;
    f32x4 acc[2][2][4][2];
#pragma unroll
    for (int a = 0; a < 2; ++a)
#pragma unroll
        for (int b = 0; b < 2; ++b)
#pragma unroll
            for (int m = 0; m < 4; ++m)
#pragma unroll
                for (int n = 0; n < 2; ++n) acc[a][b][m][n] = (f32x4){0.f, 0.f, 0.f, 0.f};
    bf16x8 At[4][2], B0[2][2], B1[2][2];
    constexpr bool GATHER = Unit::GATHER;
    unsigned pa0 = 0, pa1 = 0, pn0 = 0, pn1 = 0;
    const unsigned rowb = S.rowbytes();
    const unsigned voffA0 = (unsigned)sR[0] * rowb + sC[0] * 2, voffA1 = (unsigned)sR[1] * rowb + sC[1] * 2;
    const unsigned cbyte = (unsigned)sC[0] * 2u;
    const size_t hstepA = (size_t)HALF * rowb;
    const char* cA = Abase; const char* nA = Abase;
    if constexpr (GATHER) {
        pa0 = cur.arow_idx(sR[0]) | (cur.arow_idx(sR[0] + 64) << 16); pa1 = cur.arow_idx(HALF + sR[0]) | (cur.arow_idx(HALF + sR[0] + 64) << 16);
    } else { cA = Abase + cur.abyte(); }
#define PG8_GLO(pk) ((((pk) & 0xFFFFu) << 11) + cbyte)
#define PG8_GHI(pk) ((((pk) >> 16) << 11) + cbyte)
#define PG8_STAGEA0(bufoff, gbase, pk) do { if constexpr (GATHER) PG8_STAGEA(bufoff, gbase, PG8_GLO(pk), PG8_GHI(pk)); else PG8_STAGEA(bufoff, gbase, voffA0, voffA1); } while (0)
#define PG8_STAGEA1(bufoff, gbase, pk) do { if constexpr (GATHER) PG8_STAGEA(bufoff, gbase, PG8_GLO(pk), PG8_GHI(pk)); else PG8_STAGEA(bufoff, (gbase) + hstepA, voffA0, voffA1); } while (0)
    const char* cB = cur.bbase();
    PG8_STAGEB(PG8_SB(0, 0), cB); PG8_STAGEA0(PG8_SA(0, 0), cA, pa0); PG8_STAGEB(PG8_SB(0, 1), cB + hstep); PG8_STAGEA1(PG8_SA(0, 1), cA, pa1);
    if (wr == 1) PG8_BAR;
    PG8_WAIT_V(4); PG8_BAR;
    PG8_STAGEB(PG8_SB(1, 0), cB + kstep); PG8_STAGEA0(PG8_SA(1, 0), cA + kstep, pa0); PG8_STAGEB(PG8_SB(1, 1), cB + hstep + kstep);
    PG8_WAIT_V(6); PG8_BAR;
    for (;;) {
        const bool has_next = S.next(ui + 1, nxt);
        const char* nB = has_next ? nxt.bbase() : cB;
        if constexpr (!GATHER) nA = has_next ? Abase + nxt.abyte() : cA;
        for (int t = 0; t < nt; t += 2) {
            const bool last = (t == nt - 2);
            if constexpr (GATHER) {
                if (t == nt - 4) {
                    int R0, C0; stage_rc(tid * 16, R0, C0);
                    if (has_next) { pn0 = nxt.arow_idx(R0) | (nxt.arow_idx(R0 + 64) << 16); pn1 = nxt.arow_idx(HALF + R0) | (nxt.arow_idx(HALF + R0 + 64) << 16); }
                    else { pn0 = pa0; pn1 = pa1; }
                }
            }
            const char* a1 = cA + (size_t)(t + 1) * kstep;
            const char* a2 = last ? nA : cA + (size_t)(t + 2) * kstep; const char* a3 = a2 + kstep;
            unsigned q0 = pa0, q1 = pa1;
            if constexpr (GATHER) { q0 = last ? pn0 : pa0; q1 = last ? pn1 : pa1; }
            const char* b2 = last ? nB : cB + (size_t)(t + 2) * kstep; const char* b3 = b2 + kstep;
            PG8_LDB(B0, 0, 0); PG8_SCHED; PG8_LDA(At, 0, 0); PG8_STAGEA1(PG8_SA(1, 1), a1, pa1);
            PG8_WAIT_L(8); PG8_BAR; PG8_WAIT_L(0); PG8_MMA(0, 0, At, B0); PG8_BAR; PG8_SCHED;
            PG8_LDB(B1, 0, 1); PG8_STAGEB(PG8_SB(0, 0), b2);
            PG8_BAR; PG8_WAIT_L(0); PG8_MMA(0, 1, At, B1); PG8_BAR;
            PG8_LDA(At, 0, 1); PG8_STAGEA0(PG8_SA(0, 0), a2, q0);
            PG8_BAR; PG8_WAIT_L(0); PG8_MMA(1, 0, At, B0); PG8_BAR; PG8_SCHED;
            PG8_STAGEB(PG8_SB(0, 1), b2 + hstep);
            PG8_WAIT_V(6); PG8_BAR; PG8_MMA(1, 1, At, B1); PG8_BAR;
            PG8_LDB(B0, 1, 0); PG8_SCHED; PG8_LDA(At, 1, 0); PG8_STAGEA1(PG8_SA(0, 1), a2, q1);
            PG8_WAIT_L(8); PG8_BAR; PG8_WAIT_L(0); PG8_MMA(0, 0, At, B0); PG8_BAR; PG8_SCHED;
            PG8_LDB(B1, 1, 1); PG8_STAGEB(PG8_SB(1, 0), b3);
            PG8_BAR; PG8_WAIT_L(0); PG8_MMA(0, 1, At, B1); PG8_BAR;
            PG8_LDA(At, 1, 1); PG8_STAGEA0(PG8_SA(1, 0), a3, q0);
            PG8_BAR; PG8_WAIT_L(0); PG8_MMA(1, 0, At, B0); PG8_BAR; PG8_SCHED;
            PG8_STAGEB(PG8_SB(1, 1), b3 + hstep);
            PG8_WAIT_V(6); PG8_BAR; PG8_MMA(1, 1, At, B1); PG8_BAR;
        }
        if (wr == 0) PG8_BAR;
        {
            int fr_e = fr, cb = wc * 32 + fq * 8; asm volatile("" : "+v"(fr_e), "+v"(cb));
#define PG8_ROW(g) (((g) >> 2) * HALF + wr * 64 + ((g) & 3) * 16 + fr_e)
            const typename Epi::ColPre cp = E.colpre(cur, cb);
            typename Epi::RowPre rp[8];
#pragma unroll
            for (int g = 0; g < 8; ++g) rp[g] = E.rowpre(cur, PG8_ROW(g), cb);
            constexpr int GB = Epi::BATCH;
#pragma unroll
            for (int b0 = 0; b0 < 8; b0 += GB) {
                typename Epi::Pre pr[GB];
#pragma unroll
                for (int gg = 0; gg < GB; ++gg) pr[gg] = E.pre(cur, PG8_ROW(b0 + gg), cb, rp[b0 + gg], cp);
#pragma unroll
                for (int gg = 0; gg < GB; ++gg) { const int g = b0 + gg;
                    E.store(cur, PG8_ROW(g), cb, acc[g >> 2][0][g & 3][0], acc[g >> 2][0][g & 3][1], acc[g >> 2][1][g & 3][0], acc[g >> 2][1][g & 3][1], rp[g], cp, pr[gg]); }
            }
#undef PG8_ROW
        }
        if (!has_next) break;
#pragma unroll
        for (int a = 0; a < 2; ++a)
#pragma unroll
            for (int b = 0; b < 2; ++b)
#pragma unroll
                for (int m = 0; m < 4; ++m)
#pragma unroll
                    for (int n = 0; n < 2; ++n) acc[a][b][m][n] = (f32x4){0.f, 0.f, 0.f, 0.f};
        cur = nxt; cB = nB; cA = nA; if constexpr (GATHER) { pa0 = pn0; pa1 = pn1; } ++ui;
        if (wr == 1) PG8_BAR;
    }
    PG8_WAIT_V(0);
    PG8_BAR;
#undef PG8_SA
#undef PG8_SB
#undef PG8_GLO
#undef PG8_GHI
#undef PG8_STAGEA0
#undef PG8_STAGEA1
#undef PG8_STAGEA
#undef PG8_STAGEB
#undef PG8_LDA
#undef PG8_LDB
#undef PG8_MMA
#undef PG8_WAIT_V
#undef PG8_WAIT_L
#undef PG8_BAR
#undef PG8_SCHED
}

struct DenseUnit {
    static constexpr bool GATHER = false;
    int pm, pn; const char* bt; unsigned rowb;
    __device__ __forceinline__ const char* bbase() const { return bt; }
    __device__ __forceinline__ size_t abyte() const { return (size_t)pm * BM * rowb; }
    __device__ __forceinline__ unsigned arow_idx(int) const { return 0u; }
};
struct DenseOrder {
    typedef DenseUnit Unit;
    int nM, nN, nwg, G, c, K; const bf16_t* Bt;
    __device__ __forceinline__ unsigned rowbytes() const { return (unsigned)K * 2u; }
    __device__ __forceinline__ void init(int M, int N, int K_, const bf16_t* Bt_, int G_, int c_) { nM = M / BM; nN = N / BM; nwg = nM * nN; G = G_; c = c_; K = K_; Bt = Bt_; }
    __device__ __forceinline__ bool next(int i, Unit& u) const {
        const long L = (long)i * G + c; if (L >= nwg) return false;
        int wgid = (int)L; { const int q = nwg / 8, r = nwg % 8, xcd = wgid % 8, off = wgid / 8; wgid = (xcd < r ? xcd * (q + 1) : r * (q + 1) + (xcd - r) * q) + off; }
        const int nig = 8 * nN, gid = wgid / nig, fm = gid * 8, gsz = (nM - fm) < 8 ? (nM - fm) : 8;
        u.pm = fm + ((wgid % nig) % gsz); u.pn = (wgid % nig) / gsz;
        u.bt = (const char*)Bt + (size_t)u.pn * BM * K * 2; u.rowb = (unsigned)K * 2u;
        return true;
    }
};
}

__device__ __forceinline__ int rowmap(int mode, int n) {
    if (mode == 1) { if (n < 1024) { const int d = n & 63; return (n & ~63) + 2 * (d & 31) + (d >> 5); } return n; }
    if (mode == 2) return (n >> 7) * 256 + (n & 127);
    if (mode == 3) return (n >> 7) * 256 + 128 + (n & 127);
    return n;
}
__device__ __forceinline__ void transpose_tile(const float* __restrict__ src, int N, bf16_t* __restrict__ dst, int K, int k0, int n0, int mode, float* tile, int lane) {
    float4 v[16];
#pragma unroll
    for (int it = 0; it < 16; ++it) v[it] = *(const float4*)(src + (size_t)(k0 + it * 4 + (lane >> 4)) * N + n0 + (lane & 15) * 4);
#pragma unroll
    for (int it = 0; it < 16; ++it) { float* t = tile + (it * 4 + (lane >> 4)) * 65 + (lane & 15) * 4; t[0] = v[it].x; t[1] = v[it].y; t[2] = v[it].z; t[3] = v[it].w; }
    asm volatile("s_waitcnt lgkmcnt(0)" ::: "memory");
#pragma unroll
    for (int it = 0; it < 8; ++it) {
        const int n = it * 8 + (lane >> 3), k8 = (lane & 7) * 8;
        u32x4 w;
        w.x = pk2(tile[(k8 + 0) * 65 + n], tile[(k8 + 1) * 65 + n]);
        w.y = pk2(tile[(k8 + 2) * 65 + n], tile[(k8 + 3) * 65 + n]);
        w.z = pk2(tile[(k8 + 4) * 65 + n], tile[(k8 + 5) * 65 + n]);
        w.w = pk2(tile[(k8 + 6) * 65 + n], tile[(k8 + 7) * 65 + n]);
        *(u32x4*)(dst + (size_t)rowmap(mode, n0 + n) * K + k0 + k8) = w;
    }
    asm volatile("s_waitcnt lgkmcnt(0)" ::: "memory");
}
__device__ __forceinline__ void transpose_matrix(const float* src, int Ksrc, int N, bf16_t* dst, int mode, int gw, int nw, float* tile, int lane) {
    const int tk = Ksrc / 64, tn = N / 64;
    for (int u = gw; u < tk * tn; u += nw) transpose_tile(src, N, dst, Ksrc, (u / tn) * 64, (u % tn) * 64, mode, tile, lane);
}

__device__ __forceinline__ void phase_prologue(const Params& p, int bid, int nblk, char* smem, int wv) {
    const int tid = opaque_tid(wv), lane = tid & 63, wid = tid >> 6;
    float* tile = (float*)smem + wid * (64 * 65);
    const int gw = bid * 8 + wid, nw = nblk * 8;
    transpose_matrix(p.w_in, 1024, 3072, p.win_t, 1, gw, nw, tile, lane);
    transpose_matrix(p.w_out, 1024, 1024, p.wout_t, 0, gw, nw, tile, lane);
    transpose_matrix(p.w_ple, 256, 1024, p.wple_t, 0, gw, nw, tile, lane);
    transpose_matrix(p.w_pg, 1024, 1024, p.wpg_t, 0, gw, nw, tile, lane);
    if (bid == 0 && tid == 0) p.lam[0] = lambda_full(p);
    for (int i = bid * 512 + tid; i < T; i += nblk * 512) p.rstd_e[i] = 0.f;
    for (int row = (bid * 8 + wid) * 2; row < T; row += nblk * 16) {
        const float4* xr0 = (const float4*)(p.x + (size_t)row * DM); const float4* xr1 = xr0 + DM / 4;
        float4 v0[4], v1[4]; float s0 = 0.f, s1 = 0.f;
#pragma unroll
        for (int i = 0; i < 4; ++i) { v0[i] = xr0[lane + 64 * i]; v1[i] = xr1[lane + 64 * i]; }
#pragma unroll
        for (int i = 0; i < 4; ++i) { s0 += v0[i].x * v0[i].x + v0[i].y * v0[i].y + v0[i].z * v0[i].z + v0[i].w * v0[i].w; s1 += v1[i].x * v1[i].x + v1[i].y * v1[i].y + v1[i].z * v1[i].z + v1[i].w * v1[i].w; }
        s0 = wave_sum(s0); s1 = wave_sum(s1);
        const float r0 = 1.0f / sqrtf(s0 * (1.0f / 1024.0f) + 1e-6f), r1 = 1.0f / sqrtf(s1 * (1.0f / 1024.0f) + 1e-6f);
#pragma unroll
        for (int i = 0; i < 4; ++i) {
            const float4 g = ((const float4*)p.g_mix)[lane + 64 * i];
            u32x2 w0, w1; w0.x = pk2(v0[i].x * r0 * g.x, v0[i].y * r0 * g.y); w0.y = pk2(v0[i].z * r0 * g.z, v0[i].w * r0 * g.w);
            w1.x = pk2(v1[i].x * r1 * g.x, v1[i].y * r1 * g.y); w1.y = pk2(v1[i].z * r1 * g.z, v1[i].w * r1 * g.w);
            *(u32x2*)(p.xn + (size_t)row * DM + (lane + 64 * i) * 4) = w0;
            *(u32x2*)(p.xn + (size_t)(row + 1) * DM + (lane + 64 * i) * 4) = w1;
        }
    }
    for (int idx = bid * 512 + tid; idx < SEQ * 32; idx += nblk * 512) {
        const int s = idx >> 5, f = idx & 31;
        const float inv = exp2f(-(float)f * (13.287712379549449f / 32.0f));
        const float ang = (float)s * inv;
        p.rope[idx] = make_float2(cosf(ang), sinf(ang));
    }
    {
        float* zs = (float*)smem;
        float* ha = zs + 16 * 36;
        float* hb = ha + 16 * 64;
        float* h3t = hb + 16 * 64;
        for (int blk = bid; blk < SEQ / 16; blk += nblk) {
            const int l0 = blk * 16;
            __syncthreads();
            for (int idx = tid; idx < 16 * 33; idx += 512) {
                const int ps = idx / 33, i = idx % 33, l = l0 + ps;
                float zi;
                if (i == 0) zi = (float)l / 4095.0f;
                else {
                    const int fi = (i - 1) & 15;
                    const float f = 1e-4f + (float)fi * ((15.0f - 1e-4f) / 15.0f);
                    const float w = (float)(2.0 * 3.14159265358979323846 / 4096.0) * (float)l;
                    const float fw = w * f;
                    zi = i <= 16 ? cosf(fw) : -sinf(fw);
                }
                zs[ps * 36 + i] = zi;
            }
            __syncthreads();
            const int j = tid & 63;
#pragma unroll
            for (int r = 0; r < 2; ++r) { const int ps = (tid >> 6) + 8 * r; float s = p.flt_b1[j];
#pragma unroll 4
                for (int i = 0; i < 33; ++i) s += zs[ps * 36 + i] * p.flt_w1[i * 64 + j];
                ha[ps * 64 + j] = sinf(p.flt_freq[j] * s); }
            __syncthreads();
#pragma unroll
            for (int r = 0; r < 2; ++r) { const int ps = (tid >> 6) + 8 * r; float s = p.flt_bi[j];
#pragma unroll 4
                for (int i = 0; i < 64; ++i) s += ha[ps * 64 + i] * p.flt_wi[i * 64 + j];
                hb[ps * 64 + j] = sinf(p.flt_freq[64 + j] * s); }
            __syncthreads();
#pragma unroll
            for (int r = 0; r < 2; ++r) { const int ps = (tid >> 6) + 8 * r; float s = p.flt_bi[64 + j];
#pragma unroll 4
                for (int i = 0; i < 64; ++i) s += hb[ps * 64 + i] * p.flt_wi[(64 + i) * 64 + j];
                h3t[j * 16 + ps] = sinf(p.flt_freq[128 + j] * s); }
            __syncthreads();
            float of[16], ob[16];
#pragma unroll
            for (int q = 0; q < 16; ++q) { of[q] = 0.f; ob[q] = 0.f; }
#pragma unroll 2
            for (int i = 0; i < 64; ++i) {
                const float wf = p.flt_wo[i * 1024 + tid], wb = p.flt_wo[i * 1024 + 512 + tid];
#pragma unroll
                for (int q4 = 0; q4 < 4; ++q4) { const float4 h = *(const float4*)(h3t + i * 16 + q4 * 4);
                    of[q4 * 4] += h.x * wf; of[q4 * 4 + 1] += h.y * wf; of[q4 * 4 + 2] += h.z * wf; of[q4 * 4 + 3] += h.w * wf;
                    ob[q4 * 4] += h.x * wb; ob[q4 * 4 + 1] += h.y * wb; ob[q4 * 4 + 2] += h.z * wb; ob[q4 * 4 + 3] += h.w * wb; }
            }
            const float mind = -4.605170185988091f / 1.5f, maxd = -4.605170185988091f / 0.3f;
            const float delta = fabsf(mind + (float)tid * ((maxd - mind) / 511.0f));
            float* kr = p.kt + (size_t)tid * 8192;
#pragma unroll
            for (int q = 0; q < 16; ++q) {
                const int l = l0 + q;
                const float dec = expf(-((float)l / 4095.0f) * delta);
                const float hf = of[q] * dec, hbk = ob[q] * dec;
                if (l == 0) { kr[4096] = hf + hbk; kr[0] = 0.f; }
                else { kr[4096 + l] = hf; kr[4096 - l] = hbk; }
            }
        }
    }
}

__device__ __forceinline__ void inproj_store(const Params& p, int row, int col, f32x4 v) {
    const int b = row >> 12, s = row & 4095;
    if (col < 1024) {
        const int j = col & 63, f = j >> 1;
        const float2 c0 = p.rope[s * 32 + f], c1 = p.rope[s * 32 + f + 1];
        const float o0 = v[0] * c0.x - v[1] * c0.y, o1 = v[1] * c0.x + v[0] * c0.y;
        const float o2 = v[2] * c1.x - v[3] * c1.y, o3 = v[3] * c1.x + v[2] * c1.y;
        const int hh = (col & 511) >> 7, dd = col & 127;
        bf16_t* dst = (col < 512 ? p.q : p.k) + ((size_t)((b * NH + hh) * SEQ + s)) * 128 + dd;
        u32x2 w; w.x = pk2(o0, o1); w.y = pk2(o2, o3);
        *(u32x2*)dst = w;
    } else if (col < 1536) {
        const int hh = (col - 1024) >> 7, dd = col & 127;
        bf16_t* dst = p.v + ((size_t)((b * NH + hh) * SEQ + s)) * 128 + dd;
        u32x2 w; w.x = pk2(v[0], v[1]); w.y = pk2(v[2], v[3]);
        *(u32x2*)dst = w;
    } else {
        u32x2 w; w.x = pk2(v[0], v[1]); w.y = pk2(v[2], v[3]);
        *(u32x2*)(p.hy + (size_t)row * 1536 + (col - 1536)) = w;
    }
}
__device__ __forceinline__ u32x4 pk8(f32x4 a, f32x4 b) { u32x4 w; w.x = pk2(a[0], a[1]); w.y = pk2(a[2], a[3]); w.z = pk2(b[0], b[1]); w.w = pk2(b[2], b[3]); return w; }
struct EpiNone {};
struct EpiInproj {
    const Params& p;
    static constexpr int BATCH = 8;
    typedef EpiNone ColPre; struct RowPre { f32x4 a, b; }; typedef EpiNone Pre;
    __device__ __forceinline__ ColPre colpre(const pg8::DenseUnit&, int) const { return ColPre{}; }
    __device__ __forceinline__ RowPre rowpre(const pg8::DenseUnit& u, int r, int cb) const {
        RowPre x; x.a = (f32x4){1.f, 0.f, 1.f, 0.f}; x.b = x.a;
        if (u.pn < 4) { const int s = (u.pm * 256 + r) & 4095; const f32x4* rp = (const f32x4*)(p.rope + s * 32 + ((cb & 63) >> 1)); x.a = rp[0]; x.b = rp[1]; }
        return x;
    }
    __device__ __forceinline__ Pre pre(const pg8::DenseUnit&, int, int, const RowPre&, const ColPre&) const { return Pre{}; }
    __device__ __forceinline__ void store(const pg8::DenseUnit& u, int r, int cb, f32x4 v00, f32x4 v01, f32x4 v10, f32x4 v11, const RowPre& rp, const ColPre&, const Pre&) const {
        const int row = u.pm * 256 + r, b = row >> 12, s = row & 4095;
#pragma unroll
        for (int bj = 0; bj < 2; ++bj) {
            f32x4 v0 = bj ? v10 : v00, v1 = bj ? v11 : v01;
            const int col = u.pn * 256 + bj * 128 + cb;
            if (u.pn < 4) {
                f32x4 o0, o1;
                o0[0] = v0[0] * rp.a[0] - v0[1] * rp.a[1]; o0[1] = v0[1] * rp.a[0] + v0[0] * rp.a[1];
                o0[2] = v0[2] * rp.a[2] - v0[3] * rp.a[3]; o0[3] = v0[3] * rp.a[2] + v0[2] * rp.a[3];
                o1[0] = v1[0] * rp.b[0] - v1[1] * rp.b[1]; o1[1] = v1[1] * rp.b[0] + v1[0] * rp.b[1];
                o1[2] = v1[2] * rp.b[2] - v1[3] * rp.b[3]; o1[3] = v1[3] * rp.b[2] + v1[2] * rp.b[3];
                const int hh = (col & 511) >> 7, dd = col & 127;
                if (col < 512) { o0 = o0 * (0.125f * 1.4426950408889634f); o1 = o1 * (0.125f * 1.4426950408889634f); }
                *(u32x4*)((col < 512 ? p.q : p.k) + ((size_t)((b * NH + hh) * SEQ + s)) * 128 + dd) = pk8(o0, o1);
            } else if (u.pn < 6) {
                const int hh = (col - 1024) >> 7, dd = col & 127;
                *(u32x4*)(p.v + ((size_t)((b * NH + hh) * SEQ + s)) * 128 + dd) = pk8(v0, v1);
            } else {
                *(u32x4*)(p.hy + (size_t)row * 1536 + (col - 1536)) = pk8(v0, v1);
            }
        }
    }
};
__device__ __forceinline__ void phase_inproj(const Params& p, int bid, int nblk, char* smem, int wv) {
    pg8::DenseOrder S; S.init(T, 3072, 1024, p.win_t, nblk, bid);
    pg8::gemm_phase((LAS unsigned char*)smem, (const char*)p.xn, 1024, S, EpiInproj{p}, wv);
}

__device__ __forceinline__ void phase_hyprep(const Params& p, int bid, int nblk, char* smem, int wv) {
    bf16_t* tu = (bf16_t*)smem;
    bf16_t* tx = tu + 64 * 72;
    const int tid = opaque_tid(wv);
    for (int u = bid; u < 8 * 64 * 8; u += nblk) {
        const int ct = u & 7, st = (u >> 3) & 63, b = u >> 9;
        const int s0 = st * 64, c0 = ct * 64;
        const int sl = tid >> 3, c8 = (tid & 7) * 8, s = s0 + sl;
        float hyv[3][8];
#pragma unroll
        for (int part = 0; part < 3; ++part) {
            const int ch = part * 512 + c0 + c8;
            float xm[8], xc[8], xp[8];
            const bf16_t* base = p.hy + (size_t)(b * SEQ + s) * 1536 + ch;
            const bf16x8 vc = *(const bf16x8*)base;
            bf16x8 vm = (bf16x8){0, 0, 0, 0, 0, 0, 0, 0}, vp = (bf16x8){0, 0, 0, 0, 0, 0, 0, 0};
            if (s > 0) vm = *(const bf16x8*)(base - 1536);
            if (s < SEQ - 1) vp = *(const bf16x8*)(base + 1536);
#pragma unroll
            for (int i = 0; i < 8; ++i) { xm[i] = bf2f((bf16_t)vm[i]); xc[i] = bf2f((bf16_t)vc[i]); xp[i] = bf2f((bf16_t)vp[i]); }
#pragma unroll
            for (int i = 0; i < 8; ++i)
                hyv[part][i] = p.conv_b[ch + i] + xm[i] * p.conv_w[ch + i] + xc[i] * p.conv_w[1536 + ch + i] + xp[i] * p.conv_w[3072 + ch + i];
        }
#pragma unroll
        for (int i = 0; i < 8; ++i) {
            tu[(c8 + i) * 72 + sl] = f2bf(hyv[0][i] * hyv[2][i]);
            tx[(c8 + i) * 72 + sl] = f2bf(hyv[1][i]);
        }
        __syncthreads();
        {
            const int c = tid >> 3, s8 = (tid & 7) * 8;
            const size_t off = ((size_t)(c0 + c) * NBATCH + b) * SEQ + s0 + s8;
            *(u32x4*)(p.ut + off) = *(const u32x4*)(tu + c * 72 + s8);
            *(u32x4*)(p.hx0t + off) = *(const u32x4*)(tx + c * 72 + s8);
        }
        __syncthreads();
    }
    for (int item = bid * 512 + tid; item < NBATCH * NH * 2 * SEQ; item += nblk * 512) {
        const int key = item & 4095, grp = item >> 12, map = grp & 1, bh = grp >> 1;
        const bf16_t* kp = p.k + ((size_t)bh * SEQ + key) * 128 + map * 64;
        float ss = 0.f;
#pragma unroll
        for (int i = 0; i < 8; ++i) { const bf16x8 v = *(const bf16x8*)(kp + i * 8);
#pragma unroll
            for (int jj = 0; jj < 8; ++jj) { const float f = bf2f((bf16_t)v[jj]); ss += f * f; } }
#pragma unroll
        for (int o = 32; o >= 1; o >>= 1) ss = fmaxf(ss, __shfl_xor(ss, o));
        if ((tid & 63) == 0) atomicMax(p.kmax + grp, (int)__float_as_uint(sqrtf(ss)));
    }
}

typedef float f32x16 __attribute__((ext_vector_type(16)));
typedef short s16x4 __attribute__((ext_vector_type(4)));
constexpr float AT_SCALE = 0.125f, AT_THR = 8.f;
constexpr int AT_SHM_V = 64 * 128 * 2, AT_SHM_K = 64 * 128 * 2;
#define KSWZ(row, colB) ((row) * 256 + ((colB) ^ (((row) & 7) << 4)))
#define SBAR() __builtin_amdgcn_sched_barrier(0)
__device__ __forceinline__ int crow(int r, int hi) { return (r & 3) + 8 * (r >> 2) + 4 * hi; }
__device__ __forceinline__ unsigned cvtpk(float lo, float hi) { unsigned r; asm volatile("v_cvt_pk_bf16_f32 %0, %1, %2" : "=v"(r) : "v"(lo), "v"(hi)); return r; }
__device__ __forceinline__ void partialSM(f32x16& p0, f32x16& p1, float) {
#pragma unroll
    for (int r = 0; r < 16; ++r) p0[r] = __builtin_amdgcn_exp2f(p0[r]);
}
__device__ __forceinline__ void finishSM(f32x16& p0, f32x16& p1, float& l_reg, bf16x8& pa0, bf16x8& pa1, bf16x8& pa2, bf16x8& pa3) {
#pragma unroll
    for (int r = 0; r < 16; ++r) p1[r] = __builtin_amdgcn_exp2f(p1[r]);
    float ps = 0;
#pragma unroll
    for (int r = 0; r < 16; ++r) ps += p0[r];
#pragma unroll
    for (int r = 0; r < 16; ++r) ps += p1[r];
    l_reg += ps;
#define PK4(P, BASE, OUT) do { unsigned a0 = cvtpk(P[BASE + 0], P[BASE + 1]), a1 = cvtpk(P[BASE + 2], P[BASE + 3]);   \
    unsigned b0 = cvtpk(P[BASE + 4], P[BASE + 5]), b1 = cvtpk(P[BASE + 6], P[BASE + 7]);                              \
    auto r0 = __builtin_amdgcn_permlane32_swap(a0, b0, false, false); auto r1 = __builtin_amdgcn_permlane32_swap(a1, b1, false, false); \
    u32x4 w = {r0[0], r1[0], r0[1], r1[1]}; OUT = *reinterpret_cast<bf16x8*>(&w); } while (0)
    PK4(p0, 0, pa0); PK4(p0, 8, pa1); PK4(p1, 0, pa2); PK4(p1, 8, pa3);
#undef PK4
}
__device__ __forceinline__ void qkt(f32x16& p0, f32x16& p1, const char* Ks, const bf16x8* qr, int r32, int hi, int mb, float mC) {
#pragma unroll
    for (int r = 0; r < 16; ++r) { p0[r] = -mC; p1[r] = -mC; }
#pragma unroll
    for (int d0 = 0; d0 < 4; ++d0) { const int cb = mb + (d0 * 16 + hi * 8) * 2;
        const bf16x8 b0 = *reinterpret_cast<const bf16x8*>(Ks + KSWZ(r32, cb));
        const bf16x8 b1 = *reinterpret_cast<const bf16x8*>(Ks + KSWZ(32 + r32, cb));
        p0 = __builtin_amdgcn_mfma_f32_32x32x16_bf16(b0, qr[d0], p0, 0, 0, 0);
        p1 = __builtin_amdgcn_mfma_f32_32x32x16_bf16(b1, qr[d0], p1, 0, 0, 0); }
}
__device__ __forceinline__ int v_st(int k, int c) { const int kk = (k & ~0xC) | ((k & 4) << 1) | ((k & 8) >> 1); return ((kk >> 3) * 4 + (c >> 5)) * 512 + ((kk & 7) * 32 + (c & 31)) * 2; }
__device__ __forceinline__ int v_rd_base(int lane) { return ((lane & 3) << 3) | (((lane >> 2) & 3) << 6) | (((lane >> 4) & 1) << 5) | (((lane >> 5) & 1) << 8); }
constexpr int v_rd_off(int d0, int ks, int half) { return d0 * 512 + ks * 4096 + half * 2048; }
template <int OFF> __device__ __forceinline__ s16x4 tr_read(int vb) {
    s16x4 r; asm volatile("ds_read_b64_tr_b16 %0, %1 offset:%2" : "=&v"(r) : "v"(vb), "i"(OFF) : "memory"); return r;
}
template <int D0> __device__ __forceinline__ void pv_one(f32x16& od, int vb, bf16x8 pa0, bf16x8 pa1, bf16x8 pa2, bf16x8 pa3) {
    const s16x4 l0 = tr_read<v_rd_off(D0, 0, 0)>(vb), h0 = tr_read<v_rd_off(D0, 0, 1)>(vb), l1 = tr_read<v_rd_off(D0, 1, 0)>(vb), h1 = tr_read<v_rd_off(D0, 1, 1)>(vb);
    const s16x4 l2 = tr_read<v_rd_off(D0, 2, 0)>(vb), h2 = tr_read<v_rd_off(D0, 2, 1)>(vb), l3 = tr_read<v_rd_off(D0, 3, 0)>(vb), h3 = tr_read<v_rd_off(D0, 3, 1)>(vb);
    asm volatile("s_waitcnt lgkmcnt(0)" ::: "memory"); SBAR();
#define PKV(L, H) (bf16x8){L[0], L[1], L[2], L[3], H[0], H[1], H[2], H[3]}
    od = __builtin_amdgcn_mfma_f32_32x32x16_bf16(pa0, PKV(l0, h0), od, 0, 0, 0);
    od = __builtin_amdgcn_mfma_f32_32x32x16_bf16(pa1, PKV(l1, h1), od, 0, 0, 0);
    od = __builtin_amdgcn_mfma_f32_32x32x16_bf16(pa2, PKV(l2, h2), od, 0, 0, 0);
    od = __builtin_amdgcn_mfma_f32_32x32x16_bf16(pa3, PKV(l3, h3), od, 0, 0, 0);
#undef PKV
}
__device__ __forceinline__ void pv_d0(f32x16* o, int vb, bf16x8 pa0, bf16x8 pa1, bf16x8 pa2, bf16x8 pa3) {
    pv_one<0>(o[0], vb, pa0, pa1, pa2, pa3); pv_one<1>(o[1], vb, pa0, pa1, pa2, pa3); pv_one<2>(o[2], vb, pa0, pa1, pa2, pa3); pv_one<3>(o[3], vb, pa0, pa1, pa2, pa3);
}
__device__ __forceinline__ void attn_unit(const Params& p, int unit, char* lds, int wv) {
    const int qb = unit & 31, h = (unit >> 5) & 3, b = unit >> 7;
    const int tid = opaque_tid(wv);
    const int wid = tid >> 6, lane = tid & 63, r32 = lane & 31, hi = lane >> 5, map = wid >> 2, wq = wid & 3;
    const size_t hb = (size_t)(b * NH + h) * SEQ;
    const bf16_t* Kh = p.k + hb * 128; const bf16_t* Vh = p.v + hb * 128;
    char* V_lds = lds; char* K_lds = lds + 2 * AT_SHM_V;
    float* wsl = (float*)(lds + 2 * AT_SHM_V + 2 * AT_SHM_K) + wid * 64; float* li_l = wsl; float* al_l = wsl + 32;
    float l_reg = 0; f32x16 o[4] = {}; bf16x8 qr[4];
    const int mb = map * 128;
    __syncthreads();
    float mC;
    {
        const bf16_t* Qw = p.q + (hb + qb * 128 + wq * 32 + r32) * 128 + map * 64 + hi * 8;
        float qs = 0.f;
#pragma unroll
        for (int d0 = 0; d0 < 4; ++d0) { qr[d0] = *(const bf16x8*)(Qw + d0 * 16);
#pragma unroll
            for (int jj = 0; jj < 8; ++jj) { const float f = bf2f((bf16_t)qr[d0][jj]); qs += f * f; } }
        qs += __shfl_xor(qs, 32);
        const float kmx = __uint_as_float((unsigned)p.kmax[(b * NH + h) * 2 + map]);
        mC = sqrtf(qs) * kmx;
    }
    const int sr = tid >> 4, sc = (tid & 15) * 8, vst0 = v_st(sr, sc), vst1 = v_st(32 + sr, sc);
    const int vb0 = (int)(uintptr_t)(LAS char*)V_lds + v_rd_base(lane);
    struct { bf16x8 vs0, vs1, ks0, ks1; } sr_[1];
#define SLOAD(i, k0) do { sr_[i].vs0 = *(const bf16x8*)(&Vh[(size_t)((k0) + sr) * 128 + sc]); sr_[i].vs1 = *(const bf16x8*)(&Vh[(size_t)((k0) + 32 + sr) * 128 + sc]); \
    sr_[i].ks0 = *(const bf16x8*)(&Kh[(size_t)((k0) + sr) * 128 + sc]); sr_[i].ks1 = *(const bf16x8*)(&Kh[(size_t)((k0) + 32 + sr) * 128 + sc]); } while (0)
#define SWRITE(bb, i) do { *(bf16x8*)(V_lds + (bb) * AT_SHM_V + vst0) = sr_[i].vs0;          \
    *(bf16x8*)(V_lds + (bb) * AT_SHM_V + vst1) = sr_[i].vs1; const int kc = sc * 2;               \
    *(bf16x8*)(K_lds + (bb) * AT_SHM_K + KSWZ(sr, kc)) = sr_[i].ks0;                       \
    *(bf16x8*)(K_lds + (bb) * AT_SHM_K + KSWZ(32 + sr, kc)) = sr_[i].ks1; } while (0)
#define SWAIT() asm volatile("s_waitcnt vmcnt(0)" ::: "memory")
    f32x16 pA0, pA1, pB0, pB1; bf16x8 pa0, pa1, pa2, pa3; constexpr int NT = SEQ / 64;
    SLOAD(0, 0); SWAIT(); SWRITE(0, 0); __syncthreads();
    qkt(pA0, pA1, K_lds, qr, r32, hi, mb, mC); partialSM(pA0, pA1, mC);
    SLOAD(0, 64);
    SWAIT(); SWRITE(1, 0); __syncthreads();
    for (int j = 1; j + 1 < NT; j += 2) {
        SBAR(); qkt(pB0, pB1, K_lds + AT_SHM_K, qr, r32, hi, mb, mC);
        finishSM(pA0, pA1, l_reg, pa0, pa1, pa2, pa3); SBAR();
        SLOAD(0, (j + 1) * 64); SBAR();
        pv_d0(o, vb0, pa0, pa1, pa2, pa3); partialSM(pB0, pB1, mC);
        __syncthreads(); SWAIT(); SWRITE(0, 0);
        __syncthreads();
        SBAR(); qkt(pA0, pA1, K_lds, qr, r32, hi, mb, mC);
        finishSM(pB0, pB1, l_reg, pa0, pa1, pa2, pa3); SBAR();
        SLOAD(0, (j + 2) * 64); SBAR();
        pv_d0(o, vb0 + AT_SHM_V, pa0, pa1, pa2, pa3); partialSM(pA0, pA1, mC);
        __syncthreads(); SWAIT(); SWRITE(1, 0);
        __syncthreads();
    }
    SBAR(); qkt(pB0, pB1, K_lds + AT_SHM_K, qr, r32, hi, mb, mC);
    finishSM(pA0, pA1, l_reg, pa0, pa1, pa2, pa3); SBAR();
    pv_d0(o, vb0, pa0, pa1, pa2, pa3); partialSM(pB0, pB1, mC);
    __syncthreads();
    finishSM(pB0, pB1, l_reg, pa0, pa1, pa2, pa3); SBAR();
    pv_d0(o, vb0 + AT_SHM_V, pa0, pa1, pa2, pa3);
    l_reg += __shfl_xor(l_reg, 32);
    if (hi == 0) li_l[r32] = l_reg;
    asm volatile("s_waitcnt lgkmcnt(0)" ::: "memory");
    float rli[16];
#pragma unroll
    for (int r = 0; r < 16; ++r) rli[r] = 1.0f / li_l[crow(r, hi)];
    __syncthreads();
    float* X = (float*)lds;
    bf16_t* Ob = (bf16_t*)(lds + 65536 + 2048) + wq * 4096;
    if (map == 1) {
        const float lam = p.lam[0];
#pragma unroll
        for (int r = 0; r < 16; ++r)
#pragma unroll
            for (int d0 = 0; d0 < 4; ++d0) X[(wq * 32 + crow(r, hi)) * 128 + d0 * 32 + r32] = o[d0][r] * rli[r] * lam;
    }
    __syncthreads();
    if (map == 0) {
        float ss[16];
#pragma unroll
        for (int r = 0; r < 16; ++r) { ss[r] = 0.f;
#pragma unroll
            for (int d0 = 0; d0 < 4; ++d0) { const float f = o[d0][r] * rli[r] - X[(wq * 32 + crow(r, hi)) * 128 + d0 * 32 + r32]; o[d0][r] = f; ss[r] += f * f; } }
#pragma unroll
        for (int r = 0; r < 16; ++r) {
#pragma unroll
            for (int off = 16; off >= 1; off >>= 1) ss[r] += __shfl_xor(ss[r], off);
            ss[r] = 0.8f / sqrtf(ss[r] * (1.0f / 128.0f) + 1e-5f);
        }
#pragma unroll
        for (int d0 = 0; d0 < 4; ++d0) { const float g = p.subln[d0 * 32 + r32];
#pragma unroll
            for (int r = 0; r < 16; ++r) Ob[crow(r, hi) * 128 + d0 * 32 + r32] = f2bf(o[d0][r] * ss[r] * g); }
        asm volatile("s_waitcnt lgkmcnt(0)" ::: "memory");
        bf16_t* dst = p.mixin + (size_t)(b * SEQ + qb * 128 + wq * 32) * DM + h * 128;
#pragma unroll
        for (int i = 0; i < 8; ++i) { const int id = lane + 64 * i, row = id >> 4, c8 = (id & 15) * 8;
            *(u32x4*)(dst + (size_t)row * DM + c8) = *(const u32x4*)(Ob + row * 128 + c8); }
    }
#undef SLOAD
#undef SWRITE
#undef SWAIT
}

constexpr int CV_UPITCH = 144;
constexpr int CV_UBYTES = 8 * 64 * CV_UPITCH;
constexpr int CV_CPITCH = 8200 * 2 + 64;
__device__ __forceinline__ void conv_unit(const Params& p, int c, char* smem, int wv) {
    const int tid = opaque_tid(wv);
    const int lane = tid & 63, b = __builtin_amdgcn_readfirstlane(tid >> 6), fr = lane & 15, fq = lane >> 4;
    LAS char* lds = (LAS char*)smem;
    LAS char* Us = lds;
    LAS char* Cs = lds + CV_UBYTES;
    __syncthreads();
    {
        const u32x4* src = (const u32x4*)(p.ut + (size_t)c * NBATCH * SEQ);
#pragma unroll
        for (int i = 0; i < 8; ++i) { const int id = tid + i * 512, row = id >> 3, ch = id & 7; *(LAS u32x4*)(Us + row * CV_UPITCH + ch * 16) = src[id]; }
    }
    {
        const float* kt = p.kt + (size_t)c * 8192;
#pragma unroll 11
        for (int id = tid; id < 4 * 4100; id += 512) {
            const int r = id / 4100, pos = (id % 4100) * 2;
            const int i0 = 8192 + r - pos, i1 = i0 - 1;
            const float v0 = (i0 >= 1 && i0 <= 8191) ? kt[i0] : 0.f, v1 = (i1 >= 1 && i1 <= 8191) ? kt[i1] : 0.f;
            *(LAS unsigned*)(Cs + r * CV_CPITCH + pos * 2) = pk2(v0, v1);
        }
    }
    __syncthreads();
    f32x4 acc[4][4];
#pragma unroll
    for (int mi = 0; mi < 4; ++mi)
#pragma unroll
        for (int ni = 0; ni < 4; ++ni) acc[mi][ni] = (f32x4){0.f, 0.f, 0.f, 0.f};
    LAS char* Ub = Us + b * 64 * CV_UPITCH;
    const int r4 = fr & 3;
    LAS char* lb = Cs + r4 * CV_CPITCH + (8 * fq - fr + r4 + 4096 - 48) * 2;
    typedef short s16x4 __attribute__((ext_vector_type(4)));
#define CV_LOAD(D, BF, AF) do { LAS char* bD_ = lb - 128 * (D); \
        _Pragma("unroll") for (int ni = 0; ni < 4; ++ni) _Pragma("unroll") for (int kk = 0; kk < 2; ++kk) { const int off_ = (kk * 32 + (3 - ni) * 16) * 2; \
            const s16x4 lo_ = *(const LAS s16x4*)(bD_ + off_), hi_ = *(const LAS s16x4*)(bD_ + off_ + 8); \
            BF[ni][kk] = (bf16x8){lo_[0], lo_[1], lo_[2], lo_[3], hi_[0], hi_[1], hi_[2], hi_[3]}; } \
        _Pragma("unroll") for (int mi = 0; mi < 4; ++mi) { const int ru_ = 16 * mi + fr - (D); const int rc_ = ru_ < 0 ? 0 : (ru_ > 63 ? 63 : ru_); \
            AF[mi][0] = *(const LAS bf16x8*)(Ub + rc_ * CV_UPITCH + fq * 16); AF[mi][1] = *(const LAS bf16x8*)(Ub + rc_ * CV_UPITCH + 64 + fq * 16); \
            if ((unsigned)ru_ >= 64u) { AF[mi][0] = (bf16x8){0, 0, 0, 0, 0, 0, 0, 0}; AF[mi][1] = AF[mi][0]; } } } while (0)
#define CV_MMA(D, BF, AF) do { const int ilo_ = (D) > 0 ? (D) : 0, ihi_ = (D) < 0 ? 63 + (D) : 63; \
        _Pragma("unroll") for (int mi = 0; mi < 4; ++mi) { if (16 * mi + 15 >= ilo_ && 16 * mi <= ihi_) { \
            _Pragma("unroll") for (int ni = 0; ni < 4; ++ni) { \
                acc[mi][ni] = __builtin_amdgcn_mfma_f32_16x16x32_bf16(AF[mi][0], BF[ni][0], acc[mi][ni], 0, 0, 0); \
                acc[mi][ni] = __builtin_amdgcn_mfma_f32_16x16x32_bf16(AF[mi][1], BF[ni][1], acc[mi][ni], 0, 0, 0); } } } } while (0)
    {
        bf16x8 bA[4][2], aA[4][2], bB[4][2], aB[4][2];
        CV_LOAD(-63, bA, aA);
        for (int D = -63; D <= 61; D += 2) {
            CV_LOAD(D + 1, bB, aB);
            CV_MMA(D, bA, aA);
            CV_LOAD(D + 2, bA, aA);
            CV_MMA(D + 1, bB, aB);
        }
        CV_MMA(63, bA, aA);
    }
#undef CV_LOAD
#undef CV_MMA
    const float dsk = p.hy_d[c];
#pragma unroll
    for (int mi = 0; mi < 4; ++mi)
#pragma unroll
        for (int ni = 0; ni < 4; ++ni)
#pragma unroll
            for (int rg = 0; rg < 4; ++rg) {
                LAS bf16_t* up = (LAS bf16_t*)(Ub + (16 * mi + 4 * fq + rg) * CV_UPITCH + (16 * ni + fr) * 2);
                const float y = acc[mi][ni][rg] + dsk * bf2f(*up);
                *up = f2bf(y);
            }
    asm volatile("s_waitcnt lgkmcnt(0)" ::: "memory");
    {
        const size_t base = ((size_t)c * NBATCH + b) * SEQ;
        bf16x8 hvs[8];
#pragma unroll
        for (int i = 0; i < 8; ++i) { const int id = lane + 64 * i; hvs[i] = *(const bf16x8*)(p.hx0t + base + (id >> 3) * 64 + (id & 7) * 8); }
#pragma unroll
        for (int i = 0; i < 8; ++i) {
            const int id = lane + 64 * i, row = id >> 3, c8 = (id & 7) * 8;
            const bf16x8 yv = *(const LAS bf16x8*)(Ub + row * CV_UPITCH + c8 * 2);
            const bf16x8 hv = hvs[i];
            u32x4 w;
            w.x = pk2(bf2f((bf16_t)yv[0]) * bf2f((bf16_t)hv[0]), bf2f((bf16_t)yv[1]) * bf2f((bf16_t)hv[1]));
            w.y = pk2(bf2f((bf16_t)yv[2]) * bf2f((bf16_t)hv[2]), bf2f((bf16_t)yv[3]) * bf2f((bf16_t)hv[3]));
            w.z = pk2(bf2f((bf16_t)yv[4]) * bf2f((bf16_t)hv[4]), bf2f((bf16_t)yv[5]) * bf2f((bf16_t)hv[5]));
            w.w = pk2(bf2f((bf16_t)yv[6]) * bf2f((bf16_t)hv[6]), bf2f((bf16_t)yv[7]) * bf2f((bf16_t)hv[7]));
            *(u32x4*)(p.zt + base + row * 64 + c8) = w;
        }
    }
}
__device__ __forceinline__ void moew_unit(const Params& p, int tu, char* smem, int wv) {
    const int tid = opaque_tid(wv), lane = tid & 63, wid = tid >> 6;
    LAS char* lds = (LAS char*)smem;
    __syncthreads();
    f32x4 ld[16];
#define MW_SRC(t, SRC, DST, MODE, K0, N0) do { const int tile_ = tu * 6 + (t), mat_ = tile_ >> 5, tt_ = tile_ & 31, which_ = mat_ / 32, e_ = mat_ % 32; \
        SRC = (which_ == 0 ? p.w_gate : which_ == 1 ? p.w_up : p.w_down) + (size_t)e_ * 1048576; \
        DST = which_ == 2 ? p.wd_t + (size_t)e_ * 1048576 : p.wgu_t + (size_t)e_ * 2097152; MODE = which_ == 0 ? 2 : which_ == 1 ? 3 : 0; K0 = (tt_ >> 2) * 128; N0 = (tt_ & 3) * 256; } while (0)
    {
        const float* src; bf16_t* dst; int mode, k0, n0; MW_SRC(0, src, dst, mode, k0, n0);
#pragma unroll
        for (int i = 0; i < 16; ++i) ld[i] = *(const f32x4*)(src + (size_t)(k0 + 16 * wid + i) * 1024 + n0 + lane * 4);
    }
    for (int t = 0; t < 6; ++t) {
        LAS char* buf = lds + (t & 1) * 65536;
#pragma unroll
        for (int c = 0; c < 4; ++c) {
            u32x4 w0, w1;
            w0.x = pk2(ld[0][c], ld[1][c]); w0.y = pk2(ld[2][c], ld[3][c]); w0.z = pk2(ld[4][c], ld[5][c]); w0.w = pk2(ld[6][c], ld[7][c]);
            w1.x = pk2(ld[8][c], ld[9][c]); w1.y = pk2(ld[10][c], ld[11][c]); w1.z = pk2(ld[12][c], ld[13][c]); w1.w = pk2(ld[14][c], ld[15][c]);
            LAS char* row = buf + (4 * lane + c) * 256;
            *(LAS u32x4*)(row + (((2 * wid) ^ (lane & 15)) << 4)) = w0;
            *(LAS u32x4*)(row + (((2 * wid + 1) ^ (lane & 15)) << 4)) = w1;
        }
        const float* src; bf16_t* dst; int mode, k0, n0; MW_SRC(t, src, dst, mode, k0, n0);
        if (t + 1 < 6) {
            const float* src2; bf16_t* dst2; int mode2, k02, n02; MW_SRC(t + 1, src2, dst2, mode2, k02, n02);
#pragma unroll
            for (int i = 0; i < 16; ++i) ld[i] = *(const f32x4*)(src2 + (size_t)(k02 + 16 * wid + i) * 1024 + n02 + lane * 4);
        }
        __syncthreads();
#pragma unroll
        for (int i = 0; i < 8; ++i) {
            const int n = i * 32 + (tid >> 4), kc = tid & 15;
            const u32x4 w = *(const LAS u32x4*)(buf + n * 256 + ((kc ^ ((n >> 2) & 15)) << 4));
            *(u32x4*)(dst + (size_t)rowmap(mode, n0 + n) * 1024 + k0 + kc * 8) = w;
        }
    }
#undef MW_SRC
}
__device__ __forceinline__ void phase_mix(const Params& p, int bid, int nblk, char* smem, int wv) {
    const int nsteps = (2048 + nblk - 1) / nblk;
    for (int j = 0; j < nsteps; ++j) {
        const int u = j * nblk + (bid + j) % nblk;
        if (u >= 2048) continue;
        const int g = u >> 3, r = u & 7;
        if (r < 4) attn_unit(p, ((g >> 5) * 4 + r) * 32 + (g & 31), smem, wv);
        else if (r < 6) conv_unit(p, g * 2 + (r - 4), smem, wv);
        else moew_unit(p, g * 2 + (r - 6), smem, wv);
    }
}

__device__ __forceinline__ void phase_hypost(const Params& p, int bid, int nblk, char* smem, int wv) {
    float* tz = (float*)smem;
    const int tid = opaque_tid(wv);
    for (int u = bid; u < 8 * 64 * 8; u += nblk) {
        const int g = u & 7, st = (u >> 3) & 63, b = u >> 9, s0 = st * 64;
        {
            const int c = tid >> 3, s8 = (tid & 7) * 8;
            const bf16x8 v = *(const bf16x8*)(p.zt + ((size_t)(g * 64 + c) * NBATCH + b) * SEQ + s0 + s8);
#pragma unroll
            for (int i = 0; i < 8; ++i) tz[c * 65 + s8 + i] = bf2f((bf16_t)v[i]);
        }
        __syncthreads();
        {
            const int s = tid >> 3, c8 = (tid & 7) * 8;
            float z[8]; float ss = 0.f;
#pragma unroll
            for (int i = 0; i < 8; ++i) { z[i] = tz[(c8 + i) * 65 + s]; ss += z[i] * z[i]; }
            ss += __shfl_xor(ss, 1); ss += __shfl_xor(ss, 2); ss += __shfl_xor(ss, 4);
            const float rstd = 1.0f / sqrtf(ss * (1.0f / 64.0f) + 1e-6f);
            u32x4 w;
            const float* gn = p.hy_gn + g * 64 + c8;
            w.x = pk2(z[0] * rstd * gn[0], z[1] * rstd * gn[1]); w.y = pk2(z[2] * rstd * gn[2], z[3] * rstd * gn[3]);
            w.z = pk2(z[4] * rstd * gn[4], z[5] * rstd * gn[5]); w.w = pk2(z[6] * rstd * gn[6], z[7] * rstd * gn[7]);
            *(u32x4*)(p.mixin + (size_t)(b * SEQ + s0 + s) * DM + 512 + g * 64 + c8) = w;
        }
        __syncthreads();
    }
}

struct EpiOutproj {
    const Params& p;
    static constexpr int BATCH = 4;
    typedef EpiNone ColPre; typedef EpiNone RowPre; struct Pre { f32x4 x[2][2]; };
    __device__ __forceinline__ ColPre colpre(const pg8::DenseUnit&, int) const { return ColPre{}; }
    __device__ __forceinline__ RowPre rowpre(const pg8::DenseUnit&, int, int) const { return RowPre{}; }
    __device__ __forceinline__ Pre pre(const pg8::DenseUnit& u, int r, int cb, const RowPre&, const ColPre&) const {
        const float* xp = p.x + (size_t)(u.pm * 256 + r) * DM + u.pn * 256 + cb; Pre x;
        x.x[0][0] = *(const f32x4*)xp; x.x[0][1] = *(const f32x4*)(xp + 4); x.x[1][0] = *(const f32x4*)(xp + 128); x.x[1][1] = *(const f32x4*)(xp + 132); return x; }
    __device__ __forceinline__ void store(const pg8::DenseUnit& u, int r, int cb, f32x4 v00, f32x4 v01, f32x4 v10, f32x4 v11, const RowPre&, const ColPre&, const Pre& x) const {
        float* op = p.out + (size_t)(u.pm * 256 + r) * DM + u.pn * 256 + cb;
        *(f32x4*)op = x.x[0][0] + v00; *(f32x4*)(op + 4) = x.x[0][1] + v01; *(f32x4*)(op + 128) = x.x[1][0] + v10; *(f32x4*)(op + 132) = x.x[1][1] + v11; }
};
__device__ __forceinline__ void phase_outproj(const Params& p, int bid, int nblk, char* smem, int wv) {
    pg8::DenseOrder S; S.init(T, 1024, 1024, p.wout_t, nblk, bid);
    pg8::gemm_phase((LAS unsigned char*)smem, (const char*)p.mixin, 1024, S, EpiOutproj{p}, wv);
}

constexpr int RT_PITCH = 1032;
__device__ __forceinline__ void phase_router(const Params& p, int bid, int nblk, char* smem, int wv) {
    const int tid = opaque_tid(wv), lane = tid & 63, wid = tid >> 6, fr = lane & 15, fq = lane >> 4;
    bf16_t* rwh = (bf16_t*)smem;
    bf16_t* rwl = rwh + 32 * RT_PITCH;
    float* lgs = (float*)(smem + 2 * 32 * RT_PITCH * 2) + wid * 512;
#pragma unroll 8
    for (int i = tid; i < 1024 * 32; i += 512) {
        const int k = i >> 5, e = i & 31; const float w = p.router_w[i];
        const bf16_t h = f2bf(w); rwh[e * RT_PITCH + k] = h; rwl[e * RT_PITCH + k] = f2bf(w - bf2f(h));
    }
    __syncthreads();
    int* hist = (int*)(smem + 2 * 32 * RT_PITCH * 2 + 8 * 2048);
    for (int g0 = bid * 8; g0 < T / 16; g0 += nblk * 8) {
        const int grp = g0 + wid; const bool live = grp < T / 16;
        const int t0 = (live ? grp : 0) * 16;
        if (tid < 32) hist[tid] = 0;
        const float* hrow = p.out + (size_t)(t0 + fr) * DM + fq * 8;
        bf16_t* hnrow = p.hn + (size_t)(t0 + fr) * DM + fq * 8;
        f32x4 acc0 = (f32x4){0.f, 0.f, 0.f, 0.f}, acc1 = acc0; float ss = 0.f;
#pragma unroll 4
        for (int ks = 0; ks < 32; ++ks) {
            const f32x4 h0 = *(const f32x4*)(hrow + ks * 32), h1 = *(const f32x4*)(hrow + ks * 32 + 4);
            const f32x4 g0 = *(const f32x4*)(p.g_ffn + ks * 32 + fq * 8), g1 = *(const f32x4*)(p.g_ffn + ks * 32 + fq * 8 + 4);
            ss += h0[0] * h0[0] + h0[1] * h0[1] + h0[2] * h0[2] + h0[3] * h0[3] + h1[0] * h1[0] + h1[1] * h1[1] + h1[2] * h1[2] + h1[3] * h1[3];
            const f32x4 x0 = h0 * g0, x1 = h1 * g1;
            const u32x4 hi = pk8(x0, x1);
            f32x4 r0, r1;
            r0[0] = x0[0] - __uint_as_float(hi.x << 16); r0[1] = x0[1] - __uint_as_float(hi.x & 0xFFFF0000u); r0[2] = x0[2] - __uint_as_float(hi.y << 16); r0[3] = x0[3] - __uint_as_float(hi.y & 0xFFFF0000u);
            r1[0] = x1[0] - __uint_as_float(hi.z << 16); r1[1] = x1[1] - __uint_as_float(hi.z & 0xFFFF0000u); r1[2] = x1[2] - __uint_as_float(hi.w << 16); r1[3] = x1[3] - __uint_as_float(hi.w & 0xFFFF0000u);
            const u32x4 lo = pk8(r0, r1);
            if (live) *(u32x4*)(hnrow + ks * 32) = hi;
            const bf16x8 ah = *reinterpret_cast<const bf16x8*>(&hi), al = *reinterpret_cast<const bf16x8*>(&lo);
            const bf16x8 bh0 = *(const bf16x8*)(rwh + fr * RT_PITCH + ks * 32 + fq * 8), bh1 = *(const bf16x8*)(rwh + (16 + fr) * RT_PITCH + ks * 32 + fq * 8);
            const bf16x8 bl0 = *(const bf16x8*)(rwl + fr * RT_PITCH + ks * 32 + fq * 8), bl1 = *(const bf16x8*)(rwl + (16 + fr) * RT_PITCH + ks * 32 + fq * 8);
            acc0 = __builtin_amdgcn_mfma_f32_16x16x32_bf16(ah, bh0, acc0, 0, 0, 0); acc1 = __builtin_amdgcn_mfma_f32_16x16x32_bf16(ah, bh1, acc1, 0, 0, 0);
            acc0 = __builtin_amdgcn_mfma_f32_16x16x32_bf16(al, bh0, acc0, 0, 0, 0); acc1 = __builtin_amdgcn_mfma_f32_16x16x32_bf16(al, bh1, acc1, 0, 0, 0);
            acc0 = __builtin_amdgcn_mfma_f32_16x16x32_bf16(ah, bl0, acc0, 0, 0, 0); acc1 = __builtin_amdgcn_mfma_f32_16x16x32_bf16(ah, bl1, acc1, 0, 0, 0);
        }
        ss += __shfl_xor(ss, 16); ss += __shfl_xor(ss, 32);
#pragma unroll
        for (int rg = 0; rg < 4; ++rg) { lgs[(4 * fq + rg) * 32 + fr] = acc0[rg]; lgs[(4 * fq + rg) * 32 + 16 + fr] = acc1[rg]; }
        asm volatile("s_waitcnt lgkmcnt(0)" ::: "memory");
        const int tk = lane >> 2;
        const float rstd = 1.0f / sqrtf(__shfl(ss, tk) * (1.0f / 1024.0f) + 1e-6f);
        float lg[32];
#pragma unroll
        for (int e4 = 0; e4 < 8; ++e4) { const f32x4 v = *(const f32x4*)(lgs + tk * 32 + e4 * 4); const f32x4 bb = *(const f32x4*)(p.router_b + e4 * 4);
            lg[4 * e4] = v[0] * rstd + bb[0]; lg[4 * e4 + 1] = v[1] * rstd + bb[1]; lg[4 * e4 + 2] = v[2] * rstd + bb[2]; lg[4 * e4 + 3] = v[3] * rstd + bb[3]; }
        int te[4]; float tl[4];
#pragma unroll
        for (int k = 0; k < 4; ++k) {
            float best = -3.0e38f; int bi = 0;
#pragma unroll
            for (int e = 0; e < 32; ++e) { if (lg[e] > best) { best = lg[e]; bi = e; } }
            te[k] = bi; tl[k] = best;
#pragma unroll
            for (int e = 0; e < 32; ++e) if (e == bi) lg[e] = -3.0e38f;
        }
        const float e1 = expf(tl[1] - tl[0]), e2 = expf(tl[2] - tl[0]), e3 = expf(tl[3] - tl[0]);
        const float inv = 1.0f / (1.0f + e1 + e2 + e3);
        const int kk = lane & 3;
        const int my_e = kk == 0 ? te[0] : kk == 1 ? te[1] : kk == 2 ? te[2] : te[3];
        const float my_w = (kk == 0 ? 1.0f : kk == 1 ? e1 : kk == 2 ? e2 : e3) * inv;
        __syncthreads();
        int lp = 0;
        if (live) lp = atomicAdd(hist + my_e, 1);
        __syncthreads();
        if (tid < 32) { const int n = hist[tid]; hist[32 + tid] = n ? atomicAdd(p.cnt + tid, n) : 0; }
        __syncthreads();
        if (live) {
            const int asg = grp * 64 + lane;
            const int ps = hist[32 + my_e] + lp;
            p.list[my_e * T + ps] = asg; p.listw[my_e * T + ps] = my_w; p.listr[my_e * T + ps] = rstd;
            p.tope[asg] = my_e; p.topw[asg] = my_w; p.pos[asg] = ps;
        }
        __syncthreads();
    }
    for (int i = bid * 512 + tid; i < T * 256 / 4; i += 4 * nblk * 512) {
        float4 pv[4];
#pragma unroll
        for (int q = 0; q < 4; ++q) { const int ii = i + q * nblk * 512; pv[q] = ii < T * 256 / 4 ? ((const float4*)p.p)[ii] : make_float4(0.f, 0.f, 0.f, 0.f); }
#pragma unroll
        for (int q = 0; q < 4; ++q) { const int ii = i + q * nblk * 512; if (ii < T * 256 / 4) { u32x2 w; w.x = pk2(pv[q].x, pv[q].y); w.y = pk2(pv[q].z, pv[q].w); *(u32x2*)(p.pb + (size_t)ii * 4) = w; } }
    }
}

struct MoeTab { int tiles[33]; int start[33]; };
__device__ __forceinline__ void moe_setup(const Params& p, MoeTab* tab, int wv) {
    __syncthreads();
    if (xb_thread0(wv)) {
        int a = 0, b = 0;
        for (int e = 0; e < 32; ++e) { const int c = p.cnt[e]; tab->tiles[e] = a; tab->start[e] = b; a += (c + 255) >> 8; b += c; }
        tab->tiles[32] = a; tab->start[32] = b;
    }
    __syncthreads();
}
__device__ __forceinline__ int moe_find(const MoeTab* tab, int tile) {
    int e = 0;
#pragma unroll
    for (int i = 0; i < 32; ++i) if (tile >= tab->tiles[i + 1]) e = i + 1;
    return e;
}

struct MoeUnit1 {
    static constexpr bool GATHER = true;
    int e, tn, nvalid, slot0; const int* lst; const float* lstr; const char* bt;
    __device__ __forceinline__ const char* bbase() const { return bt; }
    __device__ __forceinline__ size_t abyte() const { return 0; }
    __device__ __forceinline__ unsigned arow_idx(int r) const { const int rr = r < nvalid ? r : nvalid - 1; return (unsigned)(lst[rr] >> 2); }
};
struct MoeUnit2 {
    static constexpr bool GATHER = false;
    int e, tn, nvalid, slot0; const int* lst; const float* lstw; const char* bt;
    __device__ __forceinline__ const char* bbase() const { return bt; }
    __device__ __forceinline__ size_t abyte() const { return (size_t)slot0 * 2048; }
    __device__ __forceinline__ unsigned arow_idx(int) const { return 0u; }
};
template <class U, int NT  > struct MoeOrder {
    typedef U Unit;
    const MoeTab* tab; const Params* p; int G, c;
    __device__ __forceinline__ unsigned rowbytes() const { return 2048u; }
    __device__ __forceinline__ bool next(int i, Unit& u) const {
        int tile, tn;
        if (G == 256) { const int x = c & 7, j = c >> 3; constexpr int TPX = 32 / NT; tile = i * (256 / NT) + x * TPX + j / NT; tn = j % NT; }
        else { const long L = (long)i * G + c; tile = (int)(L / NT); tn = (int)(L % NT); }
        if (tile >= __builtin_amdgcn_readfirstlane(tab->tiles[32])) return false;
        const int e = __builtin_amdgcn_readfirstlane(moe_find(tab, tile)), mt = tile - __builtin_amdgcn_readfirstlane(tab->tiles[e]);
        const int st0 = __builtin_amdgcn_readfirstlane(tab->start[e]), cnt = __builtin_amdgcn_readfirstlane(tab->start[e + 1]) - st0;
        u.e = e; u.tn = tn; u.nvalid = cnt - mt * 256 < 256 ? cnt - mt * 256 : 256; u.slot0 = st0 + mt * 256;
        u.lst = p->list + (size_t)e * T + mt * 256;
        fill(u, e, mt, tn);
        return true;
    }
    __device__ __forceinline__ void fill(MoeUnit1& u, int e, int mt, int tn) const { u.bt = (const char*)(p->wgu_t + (size_t)e * 2097152 + (size_t)tn * 256 * 1024); u.lstr = p->listr + (size_t)e * T + mt * 256; }
    __device__ __forceinline__ void fill(MoeUnit2& u, int e, int mt, int tn) const { u.bt = (const char*)(p->wd_t + (size_t)e * 1048576 + (size_t)tn * 256 * 1024); u.lstw = p->listw + (size_t)e * T + mt * 256; }
};
struct EpiMoe1 {
    const Params& p;
    static constexpr int BATCH = 8;
    struct ColPre { f32x4 bg[2], bu[2]; }; typedef float RowPre; typedef EpiNone Pre;
    __device__ __forceinline__ ColPre colpre(const MoeUnit1& u, int cb) const { const int j = u.e * 1024 + u.tn * 128 + cb; ColPre x;
        x.bg[0] = *(const f32x4*)(p.b_gate + j); x.bg[1] = *(const f32x4*)(p.b_gate + j + 4); x.bu[0] = *(const f32x4*)(p.b_up + j); x.bu[1] = *(const f32x4*)(p.b_up + j + 4); return x; }
    __device__ __forceinline__ RowPre rowpre(const MoeUnit1& u, int r, int) const { return r < u.nvalid ? u.lstr[r] : 0.f; }
    __device__ __forceinline__ Pre pre(const MoeUnit1&, int, int, const RowPre&, const ColPre&) const { return Pre{}; }
    __device__ __forceinline__ void store(const MoeUnit1& u, int r, int cb, f32x4 g0, f32x4 g1, f32x4 u0, f32x4 u1, const RowPre& rs, const ColPre& cp, const Pre&) const {
        if (r < u.nvalid) {
            f32x4 ga = g0 * rs + cp.bg[0], gb = g1 * rs + cp.bg[1], ua = u0 * rs + cp.bu[0], ub = u1 * rs + cp.bu[1];
#pragma unroll
            for (int i = 0; i < 4; ++i) { ga[i] = fminf(ga[i], 7.0f); gb[i] = fminf(gb[i], 7.0f); ua[i] = __builtin_amdgcn_fmed3f(ua[i], -7.0f, 7.0f); ub[i] = __builtin_amdgcn_fmed3f(ub[i], -7.0f, 7.0f); }
            f32x4 ea = ga * (-1.702f * 1.4426950408889634f), eb = gb * (-1.702f * 1.4426950408889634f);
#pragma unroll
            for (int i = 0; i < 4; ++i) { ea[i] = __builtin_amdgcn_exp2f(ea[i]); eb[i] = __builtin_amdgcn_exp2f(eb[i]); }
            ea = ea + 1.0f; eb = eb + 1.0f;
#pragma unroll
            for (int i = 0; i < 4; ++i) { ea[i] = __builtin_amdgcn_rcpf(ea[i]); eb[i] = __builtin_amdgcn_rcpf(eb[i]); }
            const f32x4 sa = ga * ea, sb = gb * eb;
            const f32x4 a0 = ua * sa + sa, a1 = ub * sb + sb;
            *(u32x4*)(p.act + (size_t)(u.slot0 + r) * DM + u.tn * 128 + cb) = pk8(a0, a1);
        }
    }
};
__device__ __forceinline__ void phase_moe1(const Params& p, int bid, int nblk, char* smem, int wv) {
    MoeTab* tab = (MoeTab*)(smem + 131072);
    moe_setup(p, tab, wv);
    MoeOrder<MoeUnit1, 8> S; S.tab = tab; S.p = &p; S.G = nblk; S.c = bid;
    pg8::gemm_phase((LAS unsigned char*)smem, (const char*)p.hn, 1024, S, EpiMoe1{p}, wv);
}
struct EpiMoe2 {
    const Params& p;
    static constexpr int BATCH = 1;
    struct ColPre { f32x4 bd[2][2]; }; struct RowPre { int asg; float w; }; struct Pre { f32x4 h[2][2]; };
    __device__ __forceinline__ ColPre colpre(const MoeUnit2& u, int cb) const { const float* bp = p.b_down + u.e * 1024 + u.tn * 256 + cb; ColPre x;
        x.bd[0][0] = *(const f32x4*)bp; x.bd[0][1] = *(const f32x4*)(bp + 4); x.bd[1][0] = *(const f32x4*)(bp + 128); x.bd[1][1] = *(const f32x4*)(bp + 132); return x; }
    __device__ __forceinline__ RowPre rowpre(const MoeUnit2& u, int r, int) const { RowPre x; x.asg = -1; x.w = 0.f; if (r < u.nvalid) { x.asg = u.lst[r]; x.w = u.lstw[r]; } return x; }
    __device__ __forceinline__ Pre pre(const MoeUnit2& u, int, int cb, const RowPre& rp, const ColPre&) const {
        Pre x; x.h[0][0] = (f32x4){0.f, 0.f, 0.f, 0.f}; x.h[0][1] = x.h[0][0]; x.h[1][0] = x.h[0][0]; x.h[1][1] = x.h[0][0];
        if (rp.asg >= 0 && (rp.asg & 3) == 0) { const float* hp = p.out + (size_t)(rp.asg >> 2) * DM + u.tn * 256 + cb;
            x.h[0][0] = *(const f32x4*)hp; x.h[0][1] = *(const f32x4*)(hp + 4); x.h[1][0] = *(const f32x4*)(hp + 128); x.h[1][1] = *(const f32x4*)(hp + 132); }
        return x; }
    __device__ __forceinline__ void store(const MoeUnit2& u, int, int cb, f32x4 v00, f32x4 v01, f32x4 v10, f32x4 v11, const RowPre& rp, const ColPre& cp, const Pre& x) const {
        if (rp.asg >= 0) {
            const int tok = rp.asg >> 2, k = rp.asg & 3, col = u.tn * 256 + cb;
            const f32x4 a = (v00 + cp.bd[0][0]) * rp.w, b = (v01 + cp.bd[0][1]) * rp.w, c = (v10 + cp.bd[1][0]) * rp.w, d = (v11 + cp.bd[1][1]) * rp.w;
            if (k == 0) { float* hp = p.out + (size_t)tok * DM + col;
                *(f32x4*)hp = x.h[0][0] + a; *(f32x4*)(hp + 4) = x.h[0][1] + b; *(f32x4*)(hp + 128) = x.h[1][0] + c; *(f32x4*)(hp + 132) = x.h[1][1] + d; }
            else { bf16_t* yp = p.y + ((size_t)tok * 3 + (k - 1)) * DM + col; *(u32x4*)yp = pk8(a, b); *(u32x4*)(yp + 128) = pk8(c, d); }
        }
    }
};
__device__ __forceinline__ void phase_moe2(const Params& p, int bid, int nblk, char* smem, int wv) {
    MoeTab* tab = (MoeTab*)(smem + 131072);
    moe_setup(p, tab, wv);
    MoeOrder<MoeUnit2, 4> S; S.tab = tab; S.p = &p; S.G = nblk; S.c = bid;
    pg8::gemm_phase((LAS unsigned char*)smem, (const char*)p.act, 1024, S, EpiMoe2{p}, wv);
}
struct EpiPle {
    const Params& p;
    static constexpr int BATCH = 8;
    typedef EpiNone ColPre; typedef EpiNone RowPre; typedef EpiNone Pre;
    __device__ __forceinline__ ColPre colpre(const pg8::DenseUnit&, int) const { return ColPre{}; }
    __device__ __forceinline__ RowPre rowpre(const pg8::DenseUnit&, int, int) const { return RowPre{}; }
    __device__ __forceinline__ Pre pre(const pg8::DenseUnit&, int, int, const RowPre&, const ColPre&) const { return Pre{}; }
    __device__ __forceinline__ void store(const pg8::DenseUnit& u, int r, int cb, f32x4 v00, f32x4 v01, f32x4 v10, f32x4 v11, const RowPre&, const ColPre&, const Pre&) const {
        const int row = u.pm * 256 + r;
        bf16_t* ep = p.epre + (size_t)row * DM + u.pn * 256 + cb;
        const u32x4 w0 = pk8(v00, v01), w1 = pk8(v10, v11);
        *(u32x4*)ep = w0; *(u32x4*)(ep + 128) = w1;
        float s = 0.f;
#pragma unroll
        for (int i = 0; i < 4; ++i) { const unsigned a = w0[i], b = w1[i];
            const float a0 = __uint_as_float(a << 16), a1 = __uint_as_float(a & 0xFFFF0000u), b0 = __uint_as_float(b << 16), b1 = __uint_as_float(b & 0xFFFF0000u);
            s += a0 * a0 + a1 * a1 + b0 * b0 + b1 * b1; }
        s += __shfl_xor(s, 16); s += __shfl_xor(s, 32);
        if (((cb >> 3) & 3) == 0) atomicAdd(p.rstd_e + row, s); }
};
__device__ __forceinline__ void phase_ple(const Params& p, int bid, int nblk, char* smem, int wv) {
    pg8::DenseOrder S; S.init(T, 1024, 256, p.wple_t, nblk, bid);
    pg8::gemm_phase((LAS unsigned char*)smem, (const char*)p.pb, 256, S, EpiPle{p}, wv);
}
__device__ __forceinline__ void phase_combine(const Params& p, int bid, int nblk, char* smem, int wv) {
    const int tid = opaque_tid(wv), lane = tid & 63, wid = tid >> 6;
    for (int t0 = (bid * 8 + wid) * 2; t0 < T; t0 += nblk * 16) {
        float4 h[2][4]; u32x2 yv[2][4][3];
#pragma unroll
        for (int rr = 0; rr < 2; ++rr)
#pragma unroll
            for (int i = 0; i < 4; ++i) { const int c4 = lane + 64 * i; h[rr][i] = ((const float4*)(p.out + (size_t)(t0 + rr) * DM))[c4];
#pragma unroll
                for (int k = 0; k < 3; ++k) yv[rr][i][k] = *(const u32x2*)(p.y + ((size_t)(t0 + rr) * 3 + k) * DM + c4 * 4); }
#pragma unroll
        for (int rr = 0; rr < 2; ++rr)
#pragma unroll
            for (int i = 0; i < 4; ++i) { const int c4 = lane + 64 * i; float4 hh = h[rr][i];
#pragma unroll
                for (int k = 0; k < 3; ++k) { const u32x2 y = yv[rr][i][k];
                    hh.x += __uint_as_float(y.x << 16); hh.y += __uint_as_float(y.x & 0xFFFF0000u); hh.z += __uint_as_float(y.y << 16); hh.w += __uint_as_float(y.y & 0xFFFF0000u); }
                ((float4*)(p.out + (size_t)(t0 + rr) * DM))[c4] = hh;
                u32x2 w; w.x = pk2(hh.x, hh.y); w.y = pk2(hh.z, hh.w);
                *(u32x2*)(p.h2b + (size_t)(t0 + rr) * DM + c4 * 4) = w; }
    }
}
struct EpiGate {
    const Params& p;
    static constexpr int BATCH = 2;
    struct ColPre { f32x4 bg[2][2], gp[2][2]; }; typedef float RowPre; struct Pre { f32x4 h[2][2]; u32x4 ev[2]; };
    __device__ __forceinline__ ColPre colpre(const pg8::DenseUnit& u, int cb) const { ColPre x;
#pragma unroll
        for (int bj = 0; bj < 2; ++bj)
#pragma unroll
            for (int n = 0; n < 2; ++n) { const int c = u.pn * 256 + bj * 128 + cb + 4 * n; x.bg[bj][n] = *(const f32x4*)(p.b_pg + c); x.gp[bj][n] = *(const f32x4*)(p.g_ple + c); }
        return x; }
    __device__ __forceinline__ RowPre rowpre(const pg8::DenseUnit& u, int r, int) const { return __builtin_amdgcn_rsqf(p.rstd_e[u.pm * 256 + r] * (1.0f / 1024.0f) + 1e-6f); }
    __device__ __forceinline__ Pre pre(const pg8::DenseUnit& u, int r, int cb, const RowPre&, const ColPre&) const {
        const size_t off = (size_t)(u.pm * 256 + r) * DM + u.pn * 256 + cb; Pre x;
        x.h[0][0] = *(const f32x4*)(p.out + off); x.h[0][1] = *(const f32x4*)(p.out + off + 4); x.h[1][0] = *(const f32x4*)(p.out + off + 128); x.h[1][1] = *(const f32x4*)(p.out + off + 132);
        x.ev[0] = *(const u32x4*)(p.epre + off); x.ev[1] = *(const u32x4*)(p.epre + off + 128); return x; }
    __device__ __forceinline__ void store(const pg8::DenseUnit& u, int r, int cb, f32x4 v00, f32x4 v01, f32x4 v10, f32x4 v11, const RowPre& rs, const ColPre& cp, const Pre& x) const {
        const size_t off = (size_t)(u.pm * 256 + r) * DM + u.pn * 256 + cb;
#pragma unroll
        for (int bj = 0; bj < 2; ++bj)
#pragma unroll
            for (int n = 0; n < 2; ++n) {
                const f32x4 v = bj ? (n ? v11 : v10) : (n ? v01 : v00);
                const unsigned w0 = n ? x.ev[bj].z : x.ev[bj].x, w1 = n ? x.ev[bj].w : x.ev[bj].y;
                f32x4 e; e[0] = __uint_as_float(w0 << 16); e[1] = __uint_as_float(w0 & 0xFFFF0000u); e[2] = __uint_as_float(w1 << 16); e[3] = __uint_as_float(w1 & 0xFFFF0000u);
                f32x4 h = x.h[bj][n];
#pragma unroll
                for (int i = 0; i < 4; ++i) h[i] += sigmoidf_(v[i] + cp.bg[bj][n][i]) * (e[i] * rs * cp.gp[bj][n][i]);
                *(f32x4*)(p.out + off + bj * 128 + n * 4) = h;
            }
    }
};
__device__ __forceinline__ void phase_gate(const Params& p, int bid, int nblk, char* smem, int wv) {
    pg8::DenseOrder S; S.init(T, 1024, 1024, p.wpg_t, nblk, bid);
    pg8::gemm_phase((LAS unsigned char*)smem, (const char*)p.h2b, 1024, S, EpiGate{p}, wv);
}
__device__ __forceinline__ void phase_final(const Params& p, int bid, int nblk, char* smem, int wv) {
    const int tid = opaque_tid(wv), lane = tid & 63, wid = tid >> 6;
    float4 g[4];
#pragma unroll
    for (int i = 0; i < 4; ++i) g[i] = ((const float4*)p.g_final)[lane + 64 * i];
    for (int t = (bid * 8 + wid) * 2; t < T; t += nblk * 16) {
        float4* hr0 = (float4*)(p.out + (size_t)t * DM); float4* hr1 = hr0 + DM / 4;
        float4 v0[4], v1[4]; float s0 = 0.f, s1 = 0.f;
#pragma unroll
        for (int i = 0; i < 4; ++i) { v0[i] = hr0[lane + 64 * i]; v1[i] = hr1[lane + 64 * i]; }
#pragma unroll
        for (int i = 0; i < 4; ++i) { s0 += v0[i].x * v0[i].x + v0[i].y * v0[i].y + v0[i].z * v0[i].z + v0[i].w * v0[i].w; s1 += v1[i].x * v1[i].x + v1[i].y * v1[i].y + v1[i].z * v1[i].z + v1[i].w * v1[i].w; }
        s0 = wave_sum(s0); s1 = wave_sum(s1);
        const float r0 = __builtin_amdgcn_rsqf(s0 * (1.0f / 1024.0f) + 1e-6f), r1 = __builtin_amdgcn_rsqf(s1 * (1.0f / 1024.0f) + 1e-6f);
#pragma unroll
        for (int i = 0; i < 4; ++i) {
            hr0[lane + 64 * i] = make_float4(v0[i].x * r0 * g[i].x, v0[i].y * r0 * g[i].y, v0[i].z * r0 * g[i].z, v0[i].w * r0 * g[i].w);
            hr1[lane + 64 * i] = make_float4(v1[i].x * r1 * g[i].x, v1[i].y * r1 * g[i].y, v1[i].z * r1 * g[i].z, v1[i].w * r1 * g[i].w);
        }
    }
}

template <int PH> __device__ __forceinline__ void run_phase(const Params& p, int bid, int nblk, char* smem, int wv) {
    if constexpr (PH == 0) phase_prologue(p, bid, nblk, smem, wv);
    else if constexpr (PH == 1) phase_inproj(p, bid, nblk, smem, wv);
    else if constexpr (PH == 2) phase_hyprep(p, bid, nblk, smem, wv);
    else if constexpr (PH == 3) phase_mix(p, bid, nblk, smem, wv);
    else if constexpr (PH == 4) phase_hypost(p, bid, nblk, smem, wv);
    else if constexpr (PH == 5) phase_outproj(p, bid, nblk, smem, wv);
    else if constexpr (PH == 6) phase_router(p, bid, nblk, smem, wv);
    else if constexpr (PH == 7) phase_moe1(p, bid, nblk, smem, wv);
    else if constexpr (PH == 8) phase_moe2(p, bid, nblk, smem, wv);
    else if constexpr (PH == 9) { phase_ple(p, bid, nblk, smem, wv); phase_combine(p, bid, nblk, smem, wv); }
    else if constexpr (PH == 10) {}
    else if constexpr (PH == 11) phase_gate(p, bid, nblk, smem, wv);
    else if constexpr (PH == 12) phase_final(p, bid, nblk, smem, wv);
}

template <int PH> __global__ void __launch_bounds__(512, 2) k_phase(Params p) {
    extern __shared__ __attribute__((aligned(16))) char smem[];
    run_phase<PH>(p, blockIdx.x, gridDim.x, smem, __builtin_amdgcn_readfirstlane(threadIdx.x >> 6));
}

__global__ void __launch_bounds__(512, 2) k_mega(Params p) {
    extern __shared__ __attribute__((aligned(16))) char smem[];
    const int bid = blockIdx.x, nblk = gridDim.x, wv = __builtin_amdgcn_readfirstlane(threadIdx.x >> 6);
    uint4* xbw = (uint4*)(smem + LDS_BYTES - 16);
    if (xb_thread0(wv)) *xbw = make_uint4(0u, 0u, 0u, 0u);
    __syncthreads();
    XcdBarrier bar = xcd_barrier_post(p.bar, (volatile LAS unsigned*)xbw, wv);
    run_phase<0>(p, bid, nblk, smem, wv); xcd_barrier(bar);
    run_phase<1>(p, bid, nblk, smem, wv); xcd_barrier(bar);
    run_phase<2>(p, bid, nblk, smem, wv); xcd_barrier(bar);
    run_phase<3>(p, bid, nblk, smem, wv); xcd_barrier(bar);
    run_phase<4>(p, bid, nblk, smem, wv); xcd_barrier(bar);
    run_phase<5>(p, bid, nblk, smem, wv); xcd_barrier(bar);
    run_phase<6>(p, bid, nblk, smem, wv); xcd_barrier(bar);
    run_phase<7>(p, bid, nblk, smem, wv); xcd_barrier(bar);
    run_phase<8>(p, bid, nblk, smem, wv); xcd_barrier(bar);
    run_phase<9>(p, bid, nblk, smem, wv); xcd_barrier(bar);
    run_phase<11>(p, bid, nblk, smem, wv); xcd_barrier(bar);
    run_phase<12>(p, bid, nblk, smem, wv);
}

template <int PH> static void launch_phase(const Params& p, int grid, hipStream_t stream) {
    static bool attr = false;
    if (!attr) { (void)hipFuncSetAttribute((const void*)k_phase<PH>, hipFuncAttributeMaxDynamicSharedMemorySize, LDS_BYTES); attr = true; }
    hipLaunchKernelGGL(k_phase<PH>, dim3(grid), dim3(512), LDS_BYTES, stream, p);
}

extern "C" void kernel_launch(void* const* d_in, const int* in_sizes, int n_in,
                              void* d_out, int out_size, void* d_ws, size_t ws_size,
                              hipStream_t stream) {
    constexpr size_t MiB = 1048576;
    char* ws = (char*)d_ws;
    size_t off = 0;
    auto take = [&](size_t bytes) { char* r = ws + off; off += (bytes + 255) & ~(size_t)255; return r; };
    Params p{};
    const float** in = (const float**)&p.x;
    for (int i = 0; i < 34; ++i) in[i] = (const float*)d_in[i];
    p.out = (float*)d_out;
    char* ctrl = take(65536);
    p.bar = (unsigned*)ctrl; p.cnt = (int*)(ctrl + 16384); p.lam = (float*)(ctrl + 32768); p.kmax = (int*)(ctrl + 20480);
    p.rope = (float2*)take(1 * MiB);
    p.kt = (float*)take(16 * MiB);
    p.pb = (bf16_t*)p.kt;
    p.win_t = (bf16_t*)take(6 * MiB); p.wout_t = (bf16_t*)take(2 * MiB); p.wple_t = (bf16_t*)take(MiB / 2); p.wpg_t = (bf16_t*)take(2 * MiB);
    p.tope = (int*)take(MiB / 2); p.topw = (float*)take(MiB / 2); p.pos = (int*)take(MiB / 2); p.list = (int*)take(4 * MiB); p.listw = (float*)take(4 * MiB); p.listr = (float*)take(4 * MiB); p.rstd_e = (float*)take(MiB / 8);
    p.wd_t = (bf16_t*)take(64 * MiB);
    p.wgu_t = (bf16_t*)take(128 * MiB);
    char* dyn = ws + off;
    p.xn = (bf16_t*)dyn; p.ut = (bf16_t*)dyn; p.hx0t = (bf16_t*)(dyn + 32 * MiB);
    p.q = (bf16_t*)(dyn + 64 * MiB); p.k = (bf16_t*)(dyn + 96 * MiB); p.v = (bf16_t*)(dyn + 128 * MiB);
    p.hy = (bf16_t*)(dyn + 160 * MiB); p.zt = (bf16_t*)(dyn + 160 * MiB); p.mixin = (bf16_t*)(dyn + 192 * MiB);
    p.hn = (bf16_t*)dyn; p.act = (bf16_t*)(dyn + 64 * MiB);
    p.y = p.wgu_t;
    p.h2b = (bf16_t*)(dyn + 64 * MiB); p.epre = (bf16_t*)(dyn + 128 * MiB);
    const size_t need = off + 64 * MiB + (size_t)(131072 + 256) * 2048;
    if (ws_size < need || n_in != 34 || out_size != T * DM) { fprintf(stderr, "kernel_launch: bad sizes ws %zu need %zu\n", ws_size, need); return; }

    (void)hipMemsetAsync(ctrl, 0, 32768, stream);
#if MK_ONE_LAUNCH
    static int grid = 0;
    if (!grid) {
        int dev = 0, cus = 0, per_cu = 0;
        (void)hipGetDevice(&dev);
        (void)hipDeviceGetAttribute(&cus, hipDeviceAttributeMultiprocessorCount, dev);
        (void)hipFuncSetAttribute((const void*)k_mega, hipFuncAttributeMaxDynamicSharedMemorySize, LDS_BYTES);
        (void)hipOccupancyMaxActiveBlocksPerMultiprocessor(&per_cu, (const void*)k_mega, 512, LDS_BYTES);
        grid = cus * (per_cu < 1 ? per_cu : 1);
    }
    if (grid > 0) hipLaunchKernelGGL(k_mega, dim3(grid), dim3(512), LDS_BYTES, stream, p);
#else
    const int grid = 256;
    launch_phase<0>(p, grid, stream); launch_phase<1>(p, grid, stream); launch_phase<2>(p, grid, stream); launch_phase<3>(p, grid, stream);
    launch_phase<4>(p, grid, stream); launch_phase<5>(p, grid, stream); launch_phase<6>(p, grid, stream); launch_phase<7>(p, grid, stream);
    launch_phase<8>(p, grid, stream); launch_phase<9>(p, grid, stream); launch_phase<10>(p, grid, stream); launch_phase<11>(p, grid, stream);
    launch_phase<12>(p, grid, stream);
#endif
}
```

```cpp
#include <hip/hip_runtime.h>
#include <stdint.h>
#include <stdio.h>

#ifndef MK_ONE_LAUNCH
#define MK_ONE_LAUNCH 1
#endif

#define LAS __attribute__((address_space(3)))
typedef unsigned short bf16_t;
typedef short bf16x8 __attribute__((ext_vector_type(8)));
typedef float f32x4 __attribute__((ext_vector_type(4)));
typedef unsigned u32x4 __attribute__((ext_vector_type(4)));
typedef unsigned u32x2 __attribute__((ext_vector_type(2)));

constexpr int T = 32768, DM = 1024, SEQ = 4096, NBATCH = 8, NH = 4, NEXP = 32, HW = 512;
constexpr int LDS_BYTES = 163840;

#define XB_TMO      128
#define XB_XCNT(j)  (256  + 64 * (j))
#define XB_XSUB(j)  (1280 + 64 * (j))
#define XB_XGEN(j)  (2304 + 64 * (j))
#define XB_TOP      3328
#define XB_TOPGEN   3392
#define XCD_BAR_WORDS 3456
#define XB_SPIN_CAP (1u << 18)

__device__ __forceinline__ unsigned xb_ld(unsigned* p)              { return __hip_atomic_load(p, __ATOMIC_RELAXED, __HIP_MEMORY_SCOPE_AGENT); }
__device__ __forceinline__ unsigned xb_add(unsigned* p, unsigned v) { return __hip_atomic_fetch_add(p, v, __ATOMIC_RELAXED, __HIP_MEMORY_SCOPE_AGENT); }
__device__ __forceinline__ unsigned xb_xcc_id() { return (unsigned)__builtin_amdgcn_s_getreg((3 << 11) | 20) & 0xFu; }
#define XB_SPIN(cond, bar) do { unsigned _sp = 0; while (cond) { __builtin_amdgcn_s_sleep(1); \
    if ((++_sp & 255u) == 0u) { if (xb_ld(&(bar)[XB_TMO])) break; if (_sp > XB_SPIN_CAP) { atomicAdd(&(bar)[XB_TMO], 1u); break; } } } } while (0)

struct XcdBarrier { unsigned* bar; unsigned x; volatile LAS unsigned* st; int wv; };
__device__ __forceinline__ unsigned lane_id_volatile() { unsigned l; asm volatile("v_mbcnt_lo_u32_b32 %0, -1, 0\n\tv_mbcnt_hi_u32_b32 %0, -1, %0" : "=v"(l)); return l; }
__device__ __forceinline__ bool xb_thread0(int wv) { return wv == 0 && lane_id_volatile() == 0u; }

__device__ __forceinline__ XcdBarrier xcd_barrier_post(unsigned* bar, volatile LAS unsigned* st, int wv) {
    XcdBarrier b; b.bar = bar; b.x = xb_xcc_id(); b.st = st; b.wv = wv;
    if (xb_thread0(wv)) (void)xb_add(&bar[XB_XCNT(b.x)], 1u);
    return b;
}
__device__ __forceinline__ void xcd_barrier_complete(unsigned* bar, unsigned x, unsigned& nloc, unsigned& nx) {
    const unsigned G = gridDim.x * gridDim.y * gridDim.z;
    unsigned sum, cnt, mine, sp = 0u;
    for (;;) {
        sum = 0u; cnt = 0u; mine = 0u;
#pragma unroll
        for (unsigned j = 0; j < 16; ++j) { const unsigned c = xb_ld(&bar[XB_XCNT(j)]); sum += c; cnt += (c > 0u) ? 1u : 0u; mine = (j == x) ? c : mine; }
        if (sum == G) break;
        __builtin_amdgcn_s_sleep(1);
        if ((++sp & 255u) == 0u) { if (xb_ld(&bar[XB_TMO])) break; if (sp > XB_SPIN_CAP) { atomicAdd(&bar[XB_TMO], 1u); break; } }
    }
    nloc = mine > 0u ? mine : 1u; nx = cnt > 0u ? cnt : 1u;
}
__device__ __forceinline__ void xcd_barrier(const XcdBarrier& b) {
    asm volatile("s_waitcnt vmcnt(0)" ::: "memory");
    __syncthreads();
    if (xb_thread0(b.wv)) {
        unsigned* bar = b.bar;
        __builtin_amdgcn_s_waitcnt(0);
        unsigned nloc = b.st[0], nx = b.st[1];
        if (nloc == 0u) { xcd_barrier_complete(bar, b.x, nloc, nx); b.st[0] = nloc; b.st[1] = nx; }
        const unsigned old = xb_add(&bar[XB_XSUB(b.x)], 1u);
        const unsigned gen = old / nloc;
        if (old + 1u == (gen + 1u) * nloc) {
            __builtin_amdgcn_fence(__ATOMIC_RELEASE, "agent");
            asm volatile("s_waitcnt vmcnt(0)" ::: "memory");
            const unsigned og = xb_add(&bar[XB_TOP], 1u);
            const unsigned tg = og / nx;
            if (og + 1u == (tg + 1u) * nx) xb_add(&bar[XB_TOPGEN], 1u);
            else XB_SPIN(xb_ld(&bar[XB_TOPGEN]) == tg, bar);
            __builtin_amdgcn_fence(__ATOMIC_ACQUIRE, "agent");
            xb_add(&bar[XB_XGEN(b.x)], 1u);
            asm volatile("s_waitcnt vmcnt(0)" ::: "memory");
        } else {
            XB_SPIN(xb_ld(&bar[XB_XGEN(b.x)]) == gen, bar);
            __builtin_amdgcn_fence(__ATOMIC_ACQUIRE, "agent");
            asm volatile("s_waitcnt vmcnt(0)" ::: "memory");
        }
    }
    __syncthreads();
}

__device__ __forceinline__ float bf2f(bf16_t b) { return __uint_as_float(((unsigned)b) << 16); }
typedef float f32x2_t __attribute__((ext_vector_type(2)));
typedef __bf16 bf16x2_t __attribute__((ext_vector_type(2)));
__device__ __forceinline__ unsigned pk2(float lo, float hi) { const f32x2_t v = {lo, hi}; bf16x2_t b = __builtin_convertvector(v, bf16x2_t); return *reinterpret_cast<unsigned*>(&b); }
__device__ __forceinline__ bf16_t f2bf(float f) { return (bf16_t)(pk2(f, 0.f) & 0xFFFFu); }
__device__ __forceinline__ float wave_sum(float v) {
#pragma unroll
    for (int o = 32; o >= 1; o >>= 1) v += __shfl_xor(v, o);
    return v;
}
__device__ __forceinline__ int opaque_tid(int wv) { int t = wv * 64 + (int)lane_id_volatile(); return t; }
__device__ __forceinline__ float sigmoidf_(float x) { return __builtin_amdgcn_rcpf(1.0f + __builtin_amdgcn_exp2f(-1.4426950408889634f * x)); }

struct Params {
    const float *x, *p, *g_mix, *w_in, *conv_w, *conv_b, *flt_w1, *flt_b1, *flt_wi, *flt_bi, *flt_freq, *flt_wo, *hy_d, *hy_gn,
                *lq1, *lk1, *lq2, *lk2, *subln, *w_out, *g_ffn, *router_w, *router_b, *w_gate, *b_gate, *w_up, *b_up, *w_down, *b_down,
                *w_ple, *g_ple, *w_pg, *b_pg, *g_final;
    float* out;
    unsigned* bar; int* cnt; float* lam; int* kmax;
    float2* rope; float* kt;
    bf16_t *win_t, *wout_t, *wple_t, *wpg_t, *wgu_t, *wd_t;
    int *tope, *pos, *list; float *topw, *rstd_e, *listw, *listr;
    bf16_t *xn, *q, *k, *v, *hy, *ut, *hx0t, *zt, *mixin, *hn, *act, *y, *pb, *h2b, *epre;
};

__device__ __forceinline__ float lambda_full(const Params& p) {
    float s1 = 0.f, s2 = 0.f;
    for (int i = 0; i < 64; ++i) { s1 += p.lq1[i] * p.lk1[i]; s2 += p.lq2[i] * p.lk2[i]; }
    return expf(s1) - expf(s2) + 0.2f;
}

template <class ARow, class Epi>
__device__ __forceinline__ void gemm_tile_simple(int K, ARow arow, const bf16_t* __restrict__ Bt, Epi epi) {
    const int lane = threadIdx.x & 63, wid = threadIdx.x >> 6, wm = wid & 3, wn = wid >> 2, fr = lane & 15, fq = lane >> 4;
    f32x4 acc[4][4];
#pragma unroll
    for (int i = 0; i < 4; ++i)
#pragma unroll
        for (int j = 0; j < 4; ++j) acc[i][j] = (f32x4){0.f, 0.f, 0.f, 0.f};
    const bf16_t* ap[4]; const bf16_t* bp[4];
#pragma unroll
    for (int i = 0; i < 4; ++i) ap[i] = arow(wm * 64 + i * 16 + fr) + fq * 8;
#pragma unroll
    for (int j = 0; j < 4; ++j) bp[j] = Bt + (size_t)(wn * 64 + j * 16 + fr) * K + fq * 8;
    for (int k = 0; k < K; k += 32) {
        bf16x8 a[4], b[4];
#pragma unroll
        for (int i = 0; i < 4; ++i) a[i] = *(const bf16x8*)(ap[i] + k);
#pragma unroll
        for (int j = 0; j < 4; ++j) b[j] = *(const bf16x8*)(bp[j] + k);
#pragma unroll
        for (int i = 0; i < 4; ++i)
#pragma unroll
            for (int j = 0; j < 4; ++j) acc[i][j] = __builtin_amdgcn_mfma_f32_16x16x32_bf16(b[j], a[i], acc[i][j], 0, 0, 0);
    }
#pragma unroll
    for (int i = 0; i < 4; ++i)
#pragma unroll
        for (int j = 0; j < 4; ++j) epi(wm * 64 + i * 16 + fr, wn * 64 + j * 16 + fq * 4, acc[i][j]);
}


namespace pg8 {
constexpr int BM = 256, BK = 64, HALF = 128, HTB = HALF * BK * 2, STAGE_BYTES = 8 * HTB;
__device__ __forceinline__ int lds_byte(int r, int c) { const int st = (r >> 4) * 2 + (c >> 5), rr = r & 15, cc = c & 31, ob = rr * 64 + cc * 2; return st * 1024 + (ob ^ (((ob >> 9) & 1) << 5)); }
__device__ __forceinline__ int perm32(int rho) { const int n = rho >> 4, i = rho & 15; return 8 * (i >> 2) + 4 * n + (i & 3); }
__device__ __forceinline__ void stage_rc(int b, int& R, int& C) { const int st = b / 1024, sb = b % 1024, swz = sb ^ (((sb >> 9) & 1) << 5); R = (st >> 1) * 16 + swz / 64; C = (st & 1) * 32 + (swz % 64) / 2; }

template <class Sched, class Epi>
__device__ __forceinline__ void gemm_phase(LAS unsigned char* lds, const char* Abase, int K_, const Sched& S, const Epi& E, int wv) {
    int K = K_;
    typedef typename Sched::Unit Unit;
    const int tid = opaque_tid(wv);
    const int wid = __builtin_amdgcn_readfirstlane(tid >> 6), lane = tid & 63, wr = wid >> 2, wc = wid & 3, fr = lane & 15, fq = lane >> 4;
    asm volatile("" : "+s"(K));
    const int nt = K / BK;
    int sR[2], sC[2]; unsigned voffB[2];
#pragma unroll
    for (int i = 0; i < 2; ++i) { stage_rc(tid * 16 + i * 8192, sR[i], sC[i]); const int Rb = (sR[i] & ~31) + perm32(sR[i] & 31); voffB[i] = (unsigned)(Rb * K + sC[i]) * 2u; }
    const size_t kstep = (size_t)(BK * 2);
    const size_t hstep = (size_t)HALF * K * 2;
    const unsigned ldsw = (unsigned)wid * 1024u;
    const int aoff = lds_byte(wr * 64 + fr, fq * 8), boff = lds_byte(wc * 32 + fr, fq * 8);
#define PG8_SA(b, h) (((b) * 2 + (h)) * HTB)
#define PG8_SB(b, h) ((4 + (b) * 2 + (h)) * HTB)
#define PG8_STAGEB(bufoff, gbase) do { _Pragma("unroll") for (int _i = 0; _i < 2; ++_i) \
        __builtin_amdgcn_global_load_lds((const unsigned*)((const char*)(gbase) + voffB[_i]), (LAS unsigned*)(lds + (bufoff) + ldsw + _i * 8192), 16, 0, 0); } while (0)
#define PG8_STAGEA(bufoff, gbase, o0, o1) do { \
        __builtin_amdgcn_global_load_lds((const unsigned*)((const char*)(gbase) + (o0)), (LAS unsigned*)(lds + (bufoff) + ldsw), 16, 0, 0); \
        __builtin_amdgcn_global_load_lds((const unsigned*)((const char*)(gbase) + (o1)), (LAS unsigned*)(lds + (bufoff) + ldsw + 8192), 16, 0, 0); } while (0)
#define PG8_LDA(dst, b, h) do { _Pragma("unroll") for (int m = 0; m < 4; ++m) _Pragma("unroll") for (int k = 0; k < 2; ++k) dst[m][k] = *(const LAS bf16x8*)(lds + PG8_SA(b, h) + aoff + m * 2048 + k * 1024); } while (0)
#define PG8_LDB(dst, b, h) do { _Pragma("unroll") for (int n = 0; n < 2; ++n) _Pragma("unroll") for (int k = 0; k < 2; ++k) dst[n][k] = *(const LAS bf16x8*)(lds + PG8_SB(b, h) + boff + n * 2048 + k * 1024); } while (0)
#define PG8_MMA(ai, bj, At, Bt) do { __builtin_amdgcn_s_setprio(1); _Pragma("unroll") for (int m = 0; m < 4; ++m) _Pragma("unroll") for (int n = 0; n < 2; ++n) _Pragma("unroll") for (int k = 0; k < 2; ++k) \
        acc[ai][bj][m][n] = __builtin_amdgcn_mfma_f32_16x16x32_bf16(Bt[n][k], At[m][k], acc[ai][bj][m][n], 0, 0, 0); __builtin_amdgcn_s_setprio(0); } while (0)
#define PG8_WAIT_V(n) asm volatile("s_waitcnt vmcnt(" #n ")" ::: "memory")
#define PG8_WAIT_L(n) asm volatile("s_waitcnt lgkmcnt(" #n ")" ::: "memory")
#define PG8_BAR __builtin_amdgcn_s_barrier()
#define PG8_SCHED __builtin_amdgcn_sched_barrier(0)
    Unit cur, nxt; int ui = 0;
    if (!S.next(0, cur)) return;
    f32x4 acc[2][2][4][2];
#pragma unroll
    for (int a = 0; a < 2; ++a)
#pragma unroll
        for (int b = 0; b < 2; ++b)
#pragma unroll
            for (int m = 0; m < 4; ++m)
#pragma unroll
                for (int n = 0; n < 2; ++n) acc[a][b][m][n] = (f32x4){0.f, 0.f, 0.f, 0.f};
    bf16x8 At[4][2], B0[2][2], B1[2][2];
    constexpr bool GATHER = Unit::GATHER;
    unsigned pa0 = 0, pa1 = 0, pn0 = 0, pn1 = 0;
    const unsigned rowb = S.rowbytes();
    const unsigned voffA0 = (unsigned)sR[0] * rowb + sC[0] * 2, voffA1 = (unsigned)sR[1] * rowb + sC[1] * 2;
    const unsigned cbyte = (unsigned)sC[0] * 2u;
    const size_t hstepA = (size_t)HALF * rowb;
    const char* cA = Abase; const char* nA = Abase;
    if constexpr (GATHER) {
        pa0 = cur.arow_idx(sR[0]) | (cur.arow_idx(sR[0] + 64) << 16); pa1 = cur.arow_idx(HALF + sR[0]) | (cur.arow_idx(HALF + sR[0] + 64) << 16);
    } else { cA = Abase + cur.abyte(); }
#define PG8_GLO(pk) ((((pk) & 0xFFFFu) << 11) + cbyte)
#define PG8_GHI(pk) ((((pk) >> 16) << 11) + cbyte)
#define PG8_STAGEA0(bufoff, gbase, pk) do { if constexpr (GATHER) PG8_STAGEA(bufoff, gbase, PG8_GLO(pk), PG8_GHI(pk)); else PG8_STAGEA(bufoff, gbase, voffA0, voffA1); } while (0)
#define PG8_STAGEA1(bufoff, gbase, pk) do { if constexpr (GATHER) PG8_STAGEA(bufoff, gbase, PG8_GLO(pk), PG8_GHI(pk)); else PG8_STAGEA(bufoff, (gbase) + hstepA, voffA0, voffA1); } while (0)
    const char* cB = cur.bbase();
    PG8_STAGEB(PG8_SB(0, 0), cB); PG8_STAGEA0(PG8_SA(0, 0), cA, pa0); PG8_STAGEB(PG8_SB(0, 1), cB + hstep); PG8_STAGEA1(PG8_SA(0, 1), cA, pa1);
    if (wr == 1) PG8_BAR;
    PG8_WAIT_V(4); PG8_BAR;
    PG8_STAGEB(PG8_SB(1, 0), cB + kstep); PG8_STAGEA0(PG8_SA(1, 0), cA + kstep, pa0); PG8_STAGEB(PG8_SB(1, 1), cB + hstep + kstep);
    PG8_WAIT_V(6); PG8_BAR;
    for (;;) {
        const bool has_next = S.next(ui + 1, nxt);
        const char* nB = has_next ? nxt.bbase() : cB;
        if constexpr (!GATHER) nA = has_next ? Abase + nxt.abyte() : cA;
        for (int t = 0; t < nt; t += 2) {
            const bool last = (t == nt - 2);
            if constexpr (GATHER) {
                if (t == nt - 4) {
                    int R0, C0; stage_rc(tid * 16, R0, C0);
                    if (has_next) { pn0 = nxt.arow_idx(R0) | (nxt.arow_idx(R0 + 64) << 16); pn1 = nxt.arow_idx(HALF + R0) | (nxt.arow_idx(HALF + R0 + 64) << 16); }
                    else { pn0 = pa0; pn1 = pa1; }
                }
            }
            const char* a1 = cA + (size_t)(t + 1) * kstep;
            const char* a2 = last ? nA : cA + (size_t)(t + 2) * kstep; const char* a3 = a2 + kstep;
            unsigned q0 = pa0, q1 = pa1;
            if constexpr (GATHER) { q0 = last ? pn0 : pa0; q1 = last ? pn1 : pa1; }
            const char* b2 = last ? nB : cB + (size_t)(t + 2) * kstep; const char* b3 = b2 + kstep;
            PG8_LDB(B0, 0, 0); PG8_SCHED; PG8_LDA(At, 0, 0); PG8_STAGEA1(PG8_SA(1, 1), a1, pa1);
            PG8_WAIT_L(8); PG8_BAR; PG8_WAIT_L(0); PG8_MMA(0, 0, At, B0); PG8_BAR; PG8_SCHED;
            PG8_LDB(B1, 0, 1); PG8_STAGEB(PG8_SB(0, 0), b2);
            PG8_BAR; PG8_WAIT_L(0); PG8_MMA(0, 1, At, B1); PG8_BAR;
            PG8_LDA(At, 0, 1); PG8_STAGEA0(PG8_SA(0, 0), a2, q0);
            PG8_BAR; PG8_WAIT_L(0); PG8_MMA(1, 0, At, B0); PG8_BAR; PG8_SCHED;
            PG8_STAGEB(PG8_SB(0, 1), b2 + hstep);
            PG8_WAIT_V(6); PG8_BAR; PG8_MMA(1, 1, At, B1); PG8_BAR;
            PG8_LDB(B0, 1, 0); PG8_SCHED; PG8_LDA(At, 1, 0); PG8_STAGEA1(PG8_SA(0, 1), a2, q1);
            PG8_WAIT_L(8); PG8_BAR; PG8_WAIT_L(0); PG8_MMA(0, 0, At, B0); PG8_BAR; PG8_SCHED;
            PG8_LDB(B1, 1, 1); PG8_STAGEB(PG8_SB(1, 0), b3);
            PG8_BAR; PG8_WAIT_L(0); PG8_MMA(0, 1, At, B1); PG8_BAR;
            PG8_LDA(At, 1, 1); PG8_STAGEA0(PG8_SA(1, 0), a3, q0);
            PG8_BAR; PG8_WAIT_L(0); PG8_MMA(1, 0, At, B0); PG8_BAR; PG8_SCHED;
            PG8_STAGEB(PG8_SB(1, 1), b3 + hstep);
            PG8_WAIT_V(6); PG8_BAR; PG8_MMA(1, 1, At, B1); PG8_BAR;
        }
        if (wr == 0) PG8_BAR;
        {
            int fr_e = fr, cb = wc * 32 + fq * 8; asm volatile("" : "+v"(fr_e), "+v"(cb));
#define PG8_ROW(g) (((g) >> 2) * HALF + wr * 64 + ((g) & 3) * 16 + fr_e)
            const typename Epi::ColPre cp = E.colpre(cur, cb);
            typename Epi::RowPre rp[8];
#pragma unroll
            for (int g = 0; g < 8; ++g) rp[g] = E.rowpre(cur, PG8_ROW(g), cb);
            constexpr int GB = Epi::BATCH;
#pragma unroll
            for (int b0 = 0; b0 < 8; b0 += GB) {
                typename Epi::Pre pr[GB];
#pragma unroll
                for (int gg = 0; gg < GB; ++gg) pr[gg] = E.pre(cur, PG8_ROW(b0 + gg), cb, rp[b0 + gg], cp);
#pragma unroll
                for (int gg = 0; gg < GB; ++gg) { const int g = b0 + gg;
                    E.store(cur, PG8_ROW(g), cb, acc[g >> 2][0][g & 3][0], acc[g >> 2][0][g & 3][1], acc[g >> 2][1][g & 3][0], acc[g >> 2][1][g & 3][1], rp[g], cp, pr[gg]); }
            }
#undef PG8_ROW
        }
        if (!has_next) break;
#pragma unroll
        for (int a = 0; a < 2; ++a)
#pragma unroll
            for (int b = 0; b < 2; ++b)
#pragma unroll
                for (int m = 0; m < 4; ++m)
#pragma unroll
                    for (int n = 0; n < 2; ++n) acc[a][b][m][n] = (f32x4){0.f, 0.f, 0.f, 0.f};
        cur = nxt; cB = nB; cA = nA; if constexpr (GATHER) { pa0 = pn0; pa1 = pn1; } ++ui;
        if (wr == 1) PG8_BAR;
    }
    PG8_WAIT_V(0);
    PG8_BAR;
#undef PG8_SA
#undef PG8_SB
#undef PG8_GLO
#undef PG8_GHI
#undef PG8_STAGEA0
#undef PG8_STAGEA1
#undef PG8_STAGEA
#undef PG8_STAGEB
#undef PG8_LDA
#undef PG8_LDB
#undef PG8_MMA
#undef PG8_WAIT_V
#undef PG8_WAIT_L
#undef PG8_BAR
#undef PG8_SCHED
}

struct DenseUnit {
    static constexpr bool GATHER = false;
    int pm, pn; const char* bt; unsigned rowb;
    __device__ __forceinline__ const char* bbase() const { return bt; }
    __device__ __forceinline__ size_t abyte() const { return (size_t)pm * BM * rowb; }
    __device__ __forceinline__ unsigned arow_idx(int) const { return 0u; }
};
struct DenseOrder {
    typedef DenseUnit Unit;
    int nM, nN, nwg, G, c, K; const bf16_t* Bt;
    __device__ __forceinline__ unsigned rowbytes() const { return (unsigned)K * 2u; }
    __device__ __forceinline__ void init(int M, int N, int K_, const bf16_t* Bt_, int G_, int c_) { nM = M / BM; nN = N / BM; nwg = nM * nN; G = G_; c = c_; K = K_; Bt = Bt_; }
    __device__ __forceinline__ bool next(int i, Unit& u) const {
        const long L = (long)i * G + c; if (L >= nwg) return false;
        int wgid = (int)L; { const int q = nwg / 8, r = nwg % 8, xcd = wgid % 8, off = wgid / 8; wgid = (xcd < r ? xcd * (q + 1) : r * (q + 1) + (xcd - r) * q) + off; }
        const int nig = 8 * nN, gid = wgid / nig, fm = gid * 8, gsz = (nM - fm) < 8 ? (nM - fm) : 8;
        u.pm = fm + ((wgid % nig) % gsz); u.pn = (wgid % nig) / gsz;
        u.bt = (const char*)Bt + (size_t)u.pn * BM * K * 2; u.rowb = (unsigned)K * 2u;
        return true;
    }
};
}

__device__ __forceinline__ int rowmap(int mode, int n) {
    if (mode == 1) { if (n < 1024) { const int d = n & 63; return (n & ~63) + 2 * (d & 31) + (d >> 5); } return n; }
    if (mode == 2) return (n >> 7) * 256 + (n & 127);
    if (mode == 3) return (n >> 7) * 256 + 128 + (n & 127);
    return n;
}
__device__ __forceinline__ void transpose_tile(const float* __restrict__ src, int N, bf16_t* __restrict__ dst, int K, int k0, int n0, int mode, float* tile, int lane) {
    float4 v[16];
#pragma unroll
    for (int it = 0; it < 16; ++it) v[it] = *(const float4*)(src + (size_t)(k0 + it * 4 + (lane >> 4)) * N + n0 + (lane & 15) * 4);
#pragma unroll
    for (int it = 0; it < 16; ++it) { float* t = tile + (it * 4 + (lane >> 4)) * 65 + (lane & 15) * 4; t[0] = v[it].x; t[1] = v[it].y; t[2] = v[it].z; t[3] = v[it].w; }
    asm volatile("s_waitcnt lgkmcnt(0)" ::: "memory");
#pragma unroll
    for (int it = 0; it < 8; ++it) {
        const int n = it * 8 + (lane >> 3), k8 = (lane & 7) * 8;
        u32x4 w;
        w.x = pk2(tile[(k8 + 0) * 65 + n], tile[(k8 + 1) * 65 + n]);
        w.y = pk2(tile[(k8 + 2) * 65 + n], tile[(k8 + 3) * 65 + n]);
        w.z = pk2(tile[(k8 + 4) * 65 + n], tile[(k8 + 5) * 65 + n]);
        w.w = pk2(tile[(k8 + 6) * 65 + n], tile[(k8 + 7) * 65 + n]);
        *(u32x4*)(dst + (size_t)rowmap(mode, n0 + n) * K + k0 + k8) = w;
    }
    asm volatile("s_waitcnt lgkmcnt(0)" ::: "memory");
}
__device__ __forceinline__ void transpose_matrix(const float* src, int Ksrc, int N, bf16_t* dst, int mode, int gw, int nw, float* tile, int lane) {
    const int tk = Ksrc / 64, tn = N / 64;
    for (int u = gw; u < tk * tn; u += nw) transpose_tile(src, N, dst, Ksrc, (u / tn) * 64, (u % tn) * 64, mode, tile, lane);
}

__device__ __forceinline__ void phase_prologue(const Params& p, int bid, int nblk, char* smem, int wv) {
    const int tid = opaque_tid(wv), lane = tid & 63, wid = tid >> 6;
    float* tile = (float*)smem + wid * (64 * 65);
    const int gw = bid * 8 + wid, nw = nblk * 8;
    transpose_matrix(p.w_in, 1024, 3072, p.win_t, 1, gw, nw, tile, lane);
    transpose_matrix(p.w_out, 1024, 1024, p.wout_t, 0, gw, nw, tile, lane);
    transpose_matrix(p.w_ple, 256, 1024, p.wple_t, 0, gw, nw, tile, lane);
    transpose_matrix(p.w_pg, 1024, 1024, p.wpg_t, 0, gw, nw, tile, lane);
    if (bid == 0 && tid == 0) p.lam[0] = lambda_full(p);
    for (int i = bid * 512 + tid; i < T; i += nblk * 512) p.rstd_e[i] = 0.f;
    for (int row = (bid * 8 + wid) * 2; row < T; row += nblk * 16) {
        const float4* xr0 = (const float4*)(p.x + (size_t)row * DM); const float4* xr1 = xr0 + DM / 4;
        float4 v0[4], v1[4]; float s0 = 0.f, s1 = 0.f;
#pragma unroll
        for (int i = 0; i < 4; ++i) { v0[i] = xr0[lane + 64 * i]; v1[i] = xr1[lane + 64 * i]; }
#pragma unroll
        for (int i = 0; i < 4; ++i) { s0 += v0[i].x * v0[i].x + v0[i].y * v0[i].y + v0[i].z * v0[i].z + v0[i].w * v0[i].w; s1 += v1[i].x * v1[i].x + v1[i].y * v1[i].y + v1[i].z * v1[i].z + v1[i].w * v1[i].w; }
        s0 = wave_sum(s0); s1 = wave_sum(s1);
        const float r0 = 1.0f / sqrtf(s0 * (1.0f / 1024.0f) + 1e-6f), r1 = 1.0f / sqrtf(s1 * (1.0f / 1024.0f) + 1e-6f);
#pragma unroll
        for (int i = 0; i < 4; ++i) {
            const float4 g = ((const float4*)p.g_mix)[lane + 64 * i];
            u32x2 w0, w1; w0.x = pk2(v0[i].x * r0 * g.x, v0[i].y * r0 * g.y); w0.y = pk2(v0[i].z * r0 * g.z, v0[i].w * r0 * g.w);
            w1.x = pk2(v1[i].x * r1 * g.x, v1[i].y * r1 * g.y); w1.y = pk2(v1[i].z * r1 * g.z, v1[i].w * r1 * g.w);
            *(u32x2*)(p.xn + (size_t)row * DM + (lane + 64 * i) * 4) = w0;
            *(u32x2*)(p.xn + (size_t)(row + 1) * DM + (lane + 64 * i) * 4) = w1;
        }
    }
    for (int idx = bid * 512 + tid; idx < SEQ * 32; idx += nblk * 512) {
        const int s = idx >> 5, f = idx & 31;
        const float inv = exp2f(-(float)f * (13.287712379549449f / 32.0f));
        const float ang = (float)s * inv;
        p.rope[idx] = make_float2(cosf(ang), sinf(ang));
    }
    {
        float* zs = (float*)smem;
        float* ha = zs + 16 * 36;
        float* hb = ha + 16 * 64;
        float* h3t = hb + 16 * 64;
        for (int blk = bid; blk < SEQ / 16; blk += nblk) {
            const int l0 = blk * 16;
            __syncthreads();
            for (int idx = tid; idx < 16 * 33; idx += 512) {
                const int ps = idx / 33, i = idx % 33, l = l0 + ps;
                float zi;
                if (i == 0) zi = (float)l / 4095.0f;
                else {
                    const int fi = (i - 1) & 15;
                    const float f = 1e-4f + (float)fi * ((15.0f - 1e-4f) / 15.0f);
                    const float w = (float)(2.0 * 3.14159265358979323846 / 4096.0) * (float)l;
                    const float fw = w * f;
                    zi = i <= 16 ? cosf(fw) : -sinf(fw);
                }
                zs[ps * 36 + i] = zi;
            }
            __syncthreads();
            const int j = tid & 63;
#pragma unroll
            for (int r = 0; r < 2; ++r) { const int ps = (tid >> 6) + 8 * r; float s = p.flt_b1[j];
#pragma unroll 4
                for (int i = 0; i < 33; ++i) s += zs[ps * 36 + i] * p.flt_w1[i * 64 + j];
                ha[ps * 64 + j] = sinf(p.flt_freq[j] * s); }
            __syncthreads();
#pragma unroll
            for (int r = 0; r < 2; ++r) { const int ps = (tid >> 6) + 8 * r; float s = p.flt_bi[j];
#pragma unroll 4
                for (int i = 0; i < 64; ++i) s += ha[ps * 64 + i] * p.flt_wi[i * 64 + j];
                hb[ps * 64 + j] = sinf(p.flt_freq[64 + j] * s); }
            __syncthreads();
#pragma unroll
            for (int r = 0; r < 2; ++r) { const int ps = (tid >> 6) + 8 * r; float s = p.flt_bi[64 + j];
#pragma unroll 4
                for (int i = 0; i < 64; ++i) s += hb[ps * 64 + i] * p.flt_wi[(64 + i) * 64 + j];
                h3t[j * 16 + ps] = sinf(p.flt_freq[128 + j] * s); }
            __syncthreads();
            float of[16], ob[16];
#pragma unroll
            for (int q = 0; q < 16; ++q) { of[q] = 0.f; ob[q] = 0.f; }
#pragma unroll 2
            for (int i = 0; i < 64; ++i) {
                const float wf = p.flt_wo[i * 1024 + tid], wb = p.flt_wo[i * 1024 + 512 + tid];
#pragma unroll
                for (int q4 = 0; q4 < 4; ++q4) { const float4 h = *(const float4*)(h3t + i * 16 + q4 * 4);
                    of[q4 * 4] += h.x * wf; of[q4 * 4 + 1] += h.y * wf; of[q4 * 4 + 2] += h.z * wf; of[q4 * 4 + 3] += h.w * wf;
                    ob[q4 * 4] += h.x * wb; ob[q4 * 4 + 1] += h.y * wb; ob[q4 * 4 + 2] += h.z * wb; ob[q4 * 4 + 3] += h.w * wb; }
            }
            const float mind = -4.605170185988091f / 1.5f, maxd = -4.605170185988091f / 0.3f;
            const float delta = fabsf(mind + (float)tid * ((maxd - mind) / 511.0f));
            float* kr = p.kt + (size_t)tid * 8192;
#pragma unroll
            for (int q = 0; q < 16; ++q) {
                const int l = l0 + q;
                const float dec = expf(-((float)l / 4095.0f) * delta);
                const float hf = of[q] * dec, hbk = ob[q] * dec;
                if (l == 0) { kr[4096] = hf + hbk; kr[0] = 0.f; }
                else { kr[4096 + l] = hf; kr[4096 - l] = hbk; }
            }
        }
    }
}

__device__ __forceinline__ void inproj_store(const Params& p, int row, int col, f32x4 v) {
    const int b = row >> 12, s = row & 4095;
    if (col < 1024) {
        const int j = col & 63, f = j >> 1;
        const float2 c0 = p.rope[s * 32 + f], c1 = p.rope[s * 32 + f + 1];
        const float o0 = v[0] * c0.x - v[1] * c0.y, o1 = v[1] * c0.x + v[0] * c0.y;
        const float o2 = v[2] * c1.x - v[3] * c1.y, o3 = v[3] * c1.x + v[2] * c1.y;
        const int hh = (col & 511) >> 7, dd = col & 127;
        bf16_t* dst = (col < 512 ? p.q : p.k) + ((size_t)((b * NH + hh) * SEQ + s)) * 128 + dd;
        u32x2 w; w.x = pk2(o0, o1); w.y = pk2(o2, o3);
        *(u32x2*)dst = w;
    } else if (col < 1536) {
        const int hh = (col - 1024) >> 7, dd = col & 127;
        bf16_t* dst = p.v + ((size_t)((b * NH + hh) * SEQ + s)) * 128 + dd;
        u32x2 w; w.x = pk2(v[0], v[1]); w.y = pk2(v[2], v[3]);
        *(u32x2*)dst = w;
    } else {
        u32x2 w; w.x = pk2(v[0], v[1]); w.y = pk2(v[2], v[3]);
        *(u32x2*)(p.hy + (size_t)row * 1536 + (col - 1536)) = w;
    }
}
__device__ __forceinline__ u32x4 pk8(f32x4 a, f32x4 b) { u32x4 w; w.x = pk2(a[0], a[1]); w.y = pk2(a[2], a[3]); w.z = pk2(b[0], b[1]); w.w = pk2(b[2], b[3]); return w; }
struct EpiNone {};
struct EpiInproj {
    const Params& p;
    static constexpr int BATCH = 8;
    typedef EpiNone ColPre; struct RowPre { f32x4 a, b; }; typedef EpiNone Pre;
    __device__ __forceinline__ ColPre colpre(const pg8::DenseUnit&, int) const { return ColPre{}; }
    __device__ __forceinline__ RowPre rowpre(const pg8::DenseUnit& u, int r, int cb) const {
        RowPre x; x.a = (f32x4){1.f, 0.f, 1.f, 0.f}; x.b = x.a;
        if (u.pn < 4) { const int s = (u.pm * 256 + r) & 4095; const f32x4* rp = (const f32x4*)(p.rope + s * 32 + ((cb & 63) >> 1)); x.a = rp[0]; x.b = rp[1]; }
        return x;
    }
    __device__ __forceinline__ Pre pre(const pg8::DenseUnit&, int, int, const RowPre&, const ColPre&) const { return Pre{}; }
    __device__ __forceinline__ void store(const pg8::DenseUnit& u, int r, int cb, f32x4 v00, f32x4 v01, f32x4 v10, f32x4 v11, const RowPre& rp, const ColPre&, const Pre&) const {
        const int row = u.pm * 256 + r, b = row >> 12, s = row & 4095;
#pragma unroll
        for (int bj = 0; bj < 2; ++bj) {
            f32x4 v0 = bj ? v10 : v00, v1 = bj ? v11 : v01;
            const int col = u.pn * 256 + bj * 128 + cb;
            if (u.pn < 4) {
                f32x4 o0, o1;
                o0[0] = v0[0] * rp.a[0] - v0[1] * rp.a[1]; o0[1] = v0[1] * rp.a[0] + v0[0] * rp.a[1];
                o0[2] = v0[2] * rp.a[2] - v0[3] * rp.a[3]; o0[3] = v0[3] * rp.a[2] + v0[2] * rp.a[3];
                o1[0] = v1[0] * rp.b[0] - v1[1] * rp.b[1]; o1[1] = v1[1] * rp.b[0] + v1[0] * rp.b[1];
                o1[2] = v1[2] * rp.b[2] - v1[3] * rp.b[3]; o1[3] = v1[3] * rp.b[2] + v1[2] * rp.b[3];
                const int hh = (col & 511) >> 7, dd = col & 127;
                if (col < 512) { o0 = o0 * (0.125f * 1.4426950408889634f); o1 = o1 * (0.125f * 1.4426950408889634f); }
                *(u32x4*)((col < 512 ? p.q : p.k) + ((size_t)((b * NH + hh) * SEQ + s)) * 128 + dd) = pk8(o0, o1);
            } else if (u.pn < 6) {
                const int hh = (col - 1024) >> 7, dd = col & 127;
                *(u32x4*)(p.v + ((size_t)((b * NH + hh) * SEQ + s)) * 128 + dd) = pk8(v0, v1);
            } else {
                *(u32x4*)(p.hy + (size_t)row * 1536 + (col - 1536)) = pk8(v0, v1);
            }
        }
    }
};
__device__ __forceinline__ void phase_inproj(const Params& p, int bid, int nblk, char* smem, int wv) {
    pg8::DenseOrder S; S.init(T, 3072, 1024, p.win_t, nblk, bid);
    pg8::gemm_phase((LAS unsigned char*)smem, (const char*)p.xn, 1024, S, EpiInproj{p}, wv);
}

__device__ __forceinline__ void phase_hyprep(const Params& p, int bid, int nblk, char* smem, int wv) {
    bf16_t* tu = (bf16_t*)smem;
    const int tid = opaque_tid(wv);
    constexpr int NU = 8 * 64 * 8;
    for (int u0 = bid; u0 < NU; u0 += 2 * nblk) {
        bf16x8 vm[2][3], vc[2][3], vp[2][3];
#pragma unroll
        for (int q = 0; q < 2; ++q) { const int u = u0 + q * nblk < NU ? u0 + q * nblk : u0;
            const int ct = u & 7, st = (u >> 3) & 63, b = u >> 9, s = st * 64 + (tid >> 3), c8 = (tid & 7) * 8;
#pragma unroll
            for (int part = 0; part < 3; ++part) {
                const bf16_t* base = p.hy + (size_t)(b * SEQ + s) * 1536 + part * 512 + ct * 64 + c8;
                vc[q][part] = *(const bf16x8*)base;
                vm[q][part] = (bf16x8){0, 0, 0, 0, 0, 0, 0, 0}; vp[q][part] = vm[q][part];
                if (s > 0) vm[q][part] = *(const bf16x8*)(base - 1536);
                if (s < SEQ - 1) vp[q][part] = *(const bf16x8*)(base + 1536);
            } }
#pragma unroll
        for (int q = 0; q < 2; ++q) { const int u = u0 + q * nblk < NU ? u0 + q * nblk : u0;
            const int ct = u & 7, sl = tid >> 3, c8 = (tid & 7) * 8;
            float hyv[3][8];
#pragma unroll
            for (int part = 0; part < 3; ++part) { const int ch = part * 512 + ct * 64 + c8;
#pragma unroll
                for (int i = 0; i < 8; ++i)
                    hyv[part][i] = p.conv_b[ch + i] + bf2f((bf16_t)vm[q][part][i]) * p.conv_w[ch + i] + bf2f((bf16_t)vc[q][part][i]) * p.conv_w[1536 + ch + i] + bf2f((bf16_t)vp[q][part][i]) * p.conv_w[3072 + ch + i]; }
#pragma unroll
            for (int i = 0; i < 8; ++i) {
                tu[q * (2 * 64 * 72) + (c8 + i) * 72 + sl] = f2bf(hyv[0][i] * hyv[2][i]);
                tu[q * (2 * 64 * 72) + 64 * 72 + (c8 + i) * 72 + sl] = f2bf(hyv[1][i]);
            } }
        __syncthreads();
#pragma unroll
        for (int q = 0; q < 2; ++q) { const int u = u0 + q * nblk;
            if (u < NU) {
                const int ct = u & 7, st = (u >> 3) & 63, b = u >> 9, c = tid >> 3, s8 = (tid & 7) * 8;
                const size_t off = ((size_t)(ct * 64 + c) * NBATCH + b) * SEQ + st * 64 + s8;
                *(u32x4*)(p.ut + off) = *(const u32x4*)(tu + q * (2 * 64 * 72) + c * 72 + s8);
                *(u32x4*)(p.hx0t + off) = *(const u32x4*)(tu + q * (2 * 64 * 72) + 64 * 72 + c * 72 + s8);
            } }
        __syncthreads();
    }
    for (int item = bid * 512 + tid; item < NBATCH * NH * 2 * SEQ; item += nblk * 512) {
        const int key = item & 4095, grp = item >> 12, map = grp & 1, bh = grp >> 1;
        const bf16_t* kp = p.k + ((size_t)bh * SEQ + key) * 128 + map * 64;
        float ss = 0.f;
#pragma unroll
        for (int i = 0; i < 8; ++i) { const bf16x8 v = *(const bf16x8*)(kp + i * 8);
#pragma unroll
            for (int jj = 0; jj < 8; ++jj) { const float f = bf2f((bf16_t)v[jj]); ss += f * f; } }
#pragma unroll
        for (int o = 32; o >= 1; o >>= 1) ss = fmaxf(ss, __shfl_xor(ss, o));
        if ((tid & 63) == 0) atomicMax(p.kmax + grp, (int)__float_as_uint(sqrtf(ss)));
    }
}

typedef float f32x16 __attribute__((ext_vector_type(16)));
typedef short s16x4 __attribute__((ext_vector_type(4)));
constexpr float AT_SCALE = 0.125f, AT_THR = 8.f;
constexpr int AT_SHM_V = 64 * 128 * 2, AT_SHM_K = 64 * 128 * 2;
#define KSWZ(row, colB) ((row) * 256 + ((colB) ^ (((row) & 7) << 4)))
#define SBAR() __builtin_amdgcn_sched_barrier(0)
__device__ __forceinline__ int crow(int r, int hi) { return (r & 3) + 8 * (r >> 2) + 4 * hi; }
__device__ __forceinline__ unsigned cvtpk(float lo, float hi) { unsigned r; asm volatile("v_cvt_pk_bf16_f32 %0, %1, %2" : "=v"(r) : "v"(lo), "v"(hi)); return r; }
__device__ __forceinline__ void partialSM(f32x16& p0, f32x16& p1, float) {
#pragma unroll
    for (int r = 0; r < 16; ++r) p0[r] = __builtin_amdgcn_exp2f(p0[r]);
}
__device__ __forceinline__ void finishSM(f32x16& p0, f32x16& p1, float& l_reg, bf16x8& pa0, bf16x8& pa1, bf16x8& pa2, bf16x8& pa3) {
#pragma unroll
    for (int r = 0; r < 16; ++r) p1[r] = __builtin_amdgcn_exp2f(p1[r]);
    float ps = 0;
#pragma unroll
    for (int r = 0; r < 16; ++r) ps += p0[r];
#pragma unroll
    for (int r = 0; r < 16; ++r) ps += p1[r];
    l_reg += ps;
#define PK4(P, BASE, OUT) do { unsigned a0 = cvtpk(P[BASE + 0], P[BASE + 1]), a1 = cvtpk(P[BASE + 2], P[BASE + 3]);   \
    unsigned b0 = cvtpk(P[BASE + 4], P[BASE + 5]), b1 = cvtpk(P[BASE + 6], P[BASE + 7]);                              \
    auto r0 = __builtin_amdgcn_permlane32_swap(a0, b0, false, false); auto r1 = __builtin_amdgcn_permlane32_swap(a1, b1, false, false); \
    u32x4 w = {r0[0], r1[0], r0[1], r1[1]}; OUT = *reinterpret_cast<bf16x8*>(&w); } while (0)
    PK4(p0, 0, pa0); PK4(p0, 8, pa1); PK4(p1, 0, pa2); PK4(p1, 8, pa3);
#undef PK4
}
__device__ __forceinline__ void qkt(f32x16& p0, f32x16& p1, const char* Ks, const bf16x8* qr, int r32, int hi, int mb, float mC) {
#pragma unroll
    for (int r = 0; r < 16; ++r) { p0[r] = -mC; p1[r] = -mC; }
#pragma unroll
    for (int d0 = 0; d0 < 4; ++d0) { const int cb = mb + (d0 * 16 + hi * 8) * 2;
        const bf16x8 b0 = *reinterpret_cast<const bf16x8*>(Ks + KSWZ(r32, cb));
        const bf16x8 b1 = *reinterpret_cast<const bf16x8*>(Ks + KSWZ(32 + r32, cb));
        p0 = __builtin_amdgcn_mfma_f32_32x32x16_bf16(b0, qr[d0], p0, 0, 0, 0);
        p1 = __builtin_amdgcn_mfma_f32_32x32x16_bf16(b1, qr[d0], p1, 0, 0, 0); }
}
__device__ __forceinline__ int v_st(int k, int c) { const int kk = (k & ~0xC) | ((k & 4) << 1) | ((k & 8) >> 1); return ((kk >> 3) * 4 + (c >> 5)) * 512 + ((kk & 7) * 32 + (c & 31)) * 2; }
__device__ __forceinline__ int v_rd_base(int lane) { return ((lane & 3) << 3) | (((lane >> 2) & 3) << 6) | (((lane >> 4) & 1) << 5) | (((lane >> 5) & 1) << 8); }
constexpr int v_rd_off(int d0, int ks, int half) { return d0 * 512 + ks * 4096 + half * 2048; }
template <int OFF> __device__ __forceinline__ s16x4 tr_read(int vb) {
    s16x4 r; asm volatile("ds_read_b64_tr_b16 %0, %1 offset:%2" : "=&v"(r) : "v"(vb), "i"(OFF) : "memory"); return r;
}
template <int D0> __device__ __forceinline__ void pv_one(f32x16& od, int vb, bf16x8 pa0, bf16x8 pa1, bf16x8 pa2, bf16x8 pa3) {
    const s16x4 l0 = tr_read<v_rd_off(D0, 0, 0)>(vb), h0 = tr_read<v_rd_off(D0, 0, 1)>(vb), l1 = tr_read<v_rd_off(D0, 1, 0)>(vb), h1 = tr_read<v_rd_off(D0, 1, 1)>(vb);
    const s16x4 l2 = tr_read<v_rd_off(D0, 2, 0)>(vb), h2 = tr_read<v_rd_off(D0, 2, 1)>(vb), l3 = tr_read<v_rd_off(D0, 3, 0)>(vb), h3 = tr_read<v_rd_off(D0, 3, 1)>(vb);
    asm volatile("s_waitcnt lgkmcnt(0)" ::: "memory"); SBAR();
#define PKV(L, H) (bf16x8){L[0], L[1], L[2], L[3], H[0], H[1], H[2], H[3]}
    od = __builtin_amdgcn_mfma_f32_32x32x16_bf16(pa0, PKV(l0, h0), od, 0, 0, 0);
    od = __builtin_amdgcn_mfma_f32_32x32x16_bf16(pa1, PKV(l1, h1), od, 0, 0, 0);
    od = __builtin_amdgcn_mfma_f32_32x32x16_bf16(pa2, PKV(l2, h2), od, 0, 0, 0);
    od = __builtin_amdgcn_mfma_f32_32x32x16_bf16(pa3, PKV(l3, h3), od, 0, 0, 0);
#undef PKV
}
__device__ __forceinline__ void pv_d0(f32x16* o, int vb, bf16x8 pa0, bf16x8 pa1, bf16x8 pa2, bf16x8 pa3) {
    pv_one<0>(o[0], vb, pa0, pa1, pa2, pa3); pv_one<1>(o[1], vb, pa0, pa1, pa2, pa3); pv_one<2>(o[2], vb, pa0, pa1, pa2, pa3); pv_one<3>(o[3], vb, pa0, pa1, pa2, pa3);
}
__device__ __forceinline__ void attn_unit(const Params& p, int unit, char* lds, int wv) {
    const int qb = unit & 31, h = (unit >> 5) & 3, b = unit >> 7;
    const int tid = opaque_tid(wv);
    const int wid = tid >> 6, lane = tid & 63, r32 = lane & 31, hi = lane >> 5, map = wid >> 2, wq = wid & 3;
    const size_t hb = (size_t)(b * NH + h) * SEQ;
    const bf16_t* Kh = p.k + hb * 128; const bf16_t* Vh = p.v + hb * 128;
    char* V_lds = lds; char* K_lds = lds + 2 * AT_SHM_V;
    float* wsl = (float*)(lds + 2 * AT_SHM_V + 2 * AT_SHM_K) + wid * 64; float* li_l = wsl; float* al_l = wsl + 32;
    float l_reg = 0; f32x16 o[4] = {}; bf16x8 qr[4];
    const int mb = map * 128;
    __syncthreads();
    float mC;
    {
        const bf16_t* Qw = p.q + (hb + qb * 128 + wq * 32 + r32) * 128 + map * 64 + hi * 8;
        float qs = 0.f;
#pragma unroll
        for (int d0 = 0; d0 < 4; ++d0) { qr[d0] = *(const bf16x8*)(Qw + d0 * 16);
#pragma unroll
            for (int jj = 0; jj < 8; ++jj) { const float f = bf2f((bf16_t)qr[d0][jj]); qs += f * f; } }
        qs += __shfl_xor(qs, 32);
        const float kmx = __uint_as_float((unsigned)p.kmax[(b * NH + h) * 2 + map]);
        mC = sqrtf(qs) * kmx;
    }
    const int sr = tid >> 4, sc = (tid & 15) * 8, vst0 = v_st(sr, sc), vst1 = v_st(32 + sr, sc);
    const int vb0 = (int)(uintptr_t)(LAS char*)V_lds + v_rd_base(lane);
    struct { bf16x8 vs0, vs1, ks0, ks1; } sr_[1];
#define SLOAD(i, k0) do { sr_[i].vs0 = *(const bf16x8*)(&Vh[(size_t)((k0) + sr) * 128 + sc]); sr_[i].vs1 = *(const bf16x8*)(&Vh[(size_t)((k0) + 32 + sr) * 128 + sc]); \
    sr_[i].ks0 = *(const bf16x8*)(&Kh[(size_t)((k0) + sr) * 128 + sc]); sr_[i].ks1 = *(const bf16x8*)(&Kh[(size_t)((k0) + 32 + sr) * 128 + sc]); } while (0)
#define SWRITE(bb, i) do { *(bf16x8*)(V_lds + (bb) * AT_SHM_V + vst0) = sr_[i].vs0;          \
    *(bf16x8*)(V_lds + (bb) * AT_SHM_V + vst1) = sr_[i].vs1; const int kc = sc * 2;               \
    *(bf16x8*)(K_lds + (bb) * AT_SHM_K + KSWZ(sr, kc)) = sr_[i].ks0;                       \
    *(bf16x8*)(K_lds + (bb) * AT_SHM_K + KSWZ(32 + sr, kc)) = sr_[i].ks1; } while (0)
#define SWAIT() asm volatile("s_waitcnt vmcnt(0)" ::: "memory")
    f32x16 pA0, pA1, pB0, pB1; bf16x8 pa0, pa1, pa2, pa3; constexpr int NT = SEQ / 64;
    SLOAD(0, 0); SWAIT(); SWRITE(0, 0); __syncthreads();
    qkt(pA0, pA1, K_lds, qr, r32, hi, mb, mC); partialSM(pA0, pA1, mC);
    SLOAD(0, 64);
    SWAIT(); SWRITE(1, 0); __syncthreads();
    for (int j = 1; j + 1 < NT; j += 2) {
        SBAR(); qkt(pB0, pB1, K_lds + AT_SHM_K, qr, r32, hi, mb, mC);
        finishSM(pA0, pA1, l_reg, pa0, pa1, pa2, pa3); SBAR();
        SLOAD(0, (j + 1) * 64); SBAR();
        pv_d0(o, vb0, pa0, pa1, pa2, pa3); partialSM(pB0, pB1, mC);
        __syncthreads(); SWAIT(); SWRITE(0, 0);
        __syncthreads();
        SBAR(); qkt(pA0, pA1, K_lds, qr, r32, hi, mb, mC);
        finishSM(pB0, pB1, l_reg, pa0, pa1, pa2, pa3); SBAR();
        SLOAD(0, (j + 2) * 64); SBAR();
        pv_d0(o, vb0 + AT_SHM_V, pa0, pa1, pa2, pa3); partialSM(pA0, pA1, mC);
        __syncthreads(); SWAIT(); SWRITE(1, 0);
        __syncthreads();
    }
    SBAR(); qkt(pB0, pB1, K_lds + AT_SHM_K, qr, r32, hi, mb, mC);
    finishSM(pA0, pA1, l_reg, pa0, pa1, pa2, pa3); SBAR();
    pv_d0(o, vb0, pa0, pa1, pa2, pa3); partialSM(pB0, pB1, mC);
    __syncthreads();
    finishSM(pB0, pB1, l_reg, pa0, pa1, pa2, pa3); SBAR();
    pv_d0(o, vb0 + AT_SHM_V, pa0, pa1, pa2, pa3);
    l_reg += __shfl_xor(l_reg, 32);
    if (hi == 0) li_l[r32] = l_reg;
    asm volatile("s_waitcnt lgkmcnt(0)" ::: "memory");
    float rli[16];
#pragma unroll
    for (int r = 0; r < 16; ++r) rli[r] = 1.0f / li_l[crow(r, hi)];
    __syncthreads();
    float* X = (float*)lds;
    bf16_t* Ob = (bf16_t*)(lds + 65536 + 2048) + wq * 4096;
    if (map == 1) {
        const float lam = p.lam[0];
#pragma unroll
        for (int r = 0; r < 16; ++r)
#pragma unroll
            for (int d0 = 0; d0 < 4; ++d0) X[(wq * 32 + crow(r, hi)) * 128 + d0 * 32 + r32] = o[d0][r] * rli[r] * lam;
    }
    __syncthreads();
    if (map == 0) {
        float ss[16];
#pragma unroll
        for (int r = 0; r < 16; ++r) { ss[r] = 0.f;
#pragma unroll
            for (int d0 = 0; d0 < 4; ++d0) { const float f = o[d0][r] * rli[r] - X[(wq * 32 + crow(r, hi)) * 128 + d0 * 32 + r32]; o[d0][r] = f; ss[r] += f * f; } }
#pragma unroll
        for (int r = 0; r < 16; ++r) {
#pragma unroll
            for (int off = 16; off >= 1; off >>= 1) ss[r] += __shfl_xor(ss[r], off);
            ss[r] = 0.8f / sqrtf(ss[r] * (1.0f / 128.0f) + 1e-5f);
        }
#pragma unroll
        for (int d0 = 0; d0 < 4; ++d0) { const float g = p.subln[d0 * 32 + r32];
#pragma unroll
            for (int r = 0; r < 16; ++r) Ob[crow(r, hi) * 128 + d0 * 32 + r32] = f2bf(o[d0][r] * ss[r] * g); }
        asm volatile("s_waitcnt lgkmcnt(0)" ::: "memory");
        bf16_t* dst = p.mixin + (size_t)(b * SEQ + qb * 128 + wq * 32) * DM + h * 128;
#pragma unroll
        for (int i = 0; i < 8; ++i) { const int id = lane + 64 * i, row = id >> 4, c8 = (id & 15) * 8;
            *(u32x4*)(dst + (size_t)row * DM + c8) = *(const u32x4*)(Ob + row * 128 + c8); }
    }
#undef SLOAD
#undef SWRITE
#undef SWAIT
}

constexpr int CV_UPITCH = 144;
constexpr int CV_UBYTES = 8 * 64 * CV_UPITCH;
constexpr int CV_CPITCH = 8200 * 2 + 64;
__device__ __forceinline__ void conv_unit(const Params& p, int c, char* smem, int wv) {
    const int tid = opaque_tid(wv);
    const int lane = tid & 63, b = __builtin_amdgcn_readfirstlane(tid >> 6), fr = lane & 15, fq = lane >> 4;
    LAS char* lds = (LAS char*)smem;
    LAS char* Us = lds;
    LAS char* Cs = lds + CV_UBYTES;
    __syncthreads();
    {
        const u32x4* src = (const u32x4*)(p.ut + (size_t)c * NBATCH * SEQ);
#pragma unroll
        for (int i = 0; i < 8; ++i) { const int id = tid + i * 512, row = id >> 3, ch = id & 7; *(LAS u32x4*)(Us + row * CV_UPITCH + ch * 16) = src[id]; }
    }
    {
        const float* kt = p.kt + (size_t)c * 8192;
#pragma unroll 11
        for (int id = tid; id < 4 * 4100; id += 512) {
            const int r = id / 4100, pos = (id % 4100) * 2;
            const int i0 = 8192 + r - pos, i1 = i0 - 1;
            const float v0 = (i0 >= 1 && i0 <= 8191) ? kt[i0] : 0.f, v1 = (i1 >= 1 && i1 <= 8191) ? kt[i1] : 0.f;
            *(LAS unsigned*)(Cs + r * CV_CPITCH + pos * 2) = pk2(v0, v1);
        }
    }
    __syncthreads();
    f32x4 acc[4][4];
#pragma unroll
    for (int mi = 0; mi < 4; ++mi)
#pragma unroll
        for (int ni = 0; ni < 4; ++ni) acc[mi][ni] = (f32x4){0.f, 0.f, 0.f, 0.f};
    LAS char* Ub = Us + b * 64 * CV_UPITCH;
    const int r4 = fr & 3;
    LAS char* lb = Cs + r4 * CV_CPITCH + (8 * fq - fr + r4 + 4096 - 48) * 2;
    typedef short s16x4 __attribute__((ext_vector_type(4)));
#define CV_LOAD(D, BF, AF) do { LAS char* bD_ = lb - 128 * (D); \
        _Pragma("unroll") for (int ni = 0; ni < 4; ++ni) _Pragma("unroll") for (int kk = 0; kk < 2; ++kk) { const int off_ = (kk * 32 + (3 - ni) * 16) * 2; \
            const s16x4 lo_ = *(const LAS s16x4*)(bD_ + off_), hi_ = *(const LAS s16x4*)(bD_ + off_ + 8); \
            BF[ni][kk] = (bf16x8){lo_[0], lo_[1], lo_[2], lo_[3], hi_[0], hi_[1], hi_[2], hi_[3]}; } \
        _Pragma("unroll") for (int mi = 0; mi < 4; ++mi) { const int ru_ = 16 * mi + fr - (D); const int rc_ = ru_ < 0 ? 0 : (ru_ > 63 ? 63 : ru_); \
            AF[mi][0] = *(const LAS bf16x8*)(Ub + rc_ * CV_UPITCH + fq * 16); AF[mi][1] = *(const LAS bf16x8*)(Ub + rc_ * CV_UPITCH + 64 + fq * 16); \
            if ((unsigned)ru_ >= 64u) { AF[mi][0] = (bf16x8){0, 0, 0, 0, 0, 0, 0, 0}; AF[mi][1] = AF[mi][0]; } } } while (0)
#define CV_MMA(D, BF, AF) do { const int ilo_ = (D) > 0 ? (D) : 0, ihi_ = (D) < 0 ? 63 + (D) : 63; \
        _Pragma("unroll") for (int mi = 0; mi < 4; ++mi) { if (16 * mi + 15 >= ilo_ && 16 * mi <= ihi_) { \
            _Pragma("unroll") for (int ni = 0; ni < 4; ++ni) { \
                acc[mi][ni] = __builtin_amdgcn_mfma_f32_16x16x32_bf16(AF[mi][0], BF[ni][0], acc[mi][ni], 0, 0, 0); \
                acc[mi][ni] = __builtin_amdgcn_mfma_f32_16x16x32_bf16(AF[mi][1], BF[ni][1], acc[mi][ni], 0, 0, 0); } } } } while (0)
    {
        bf16x8 bA[4][2], aA[4][2], bB[4][2], aB[4][2];
        CV_LOAD(-63, bA, aA);
        for (int D = -63; D <= 61; D += 2) {
            CV_LOAD(D + 1, bB, aB);
            CV_MMA(D, bA, aA);
            CV_LOAD(D + 2, bA, aA);
            CV_MMA(D + 1, bB, aB);
        }
        CV_MMA(63, bA, aA);
    }
#undef CV_LOAD
#undef CV_MMA
    const float dsk = p.hy_d[c];
#pragma unroll
    for (int mi = 0; mi < 4; ++mi)
#pragma unroll
        for (int ni = 0; ni < 4; ++ni)
#pragma unroll
            for (int rg = 0; rg < 4; ++rg) {
                LAS bf16_t* up = (LAS bf16_t*)(Ub + (16 * mi + 4 * fq + rg) * CV_UPITCH + (16 * ni + fr) * 2);
                const float y = acc[mi][ni][rg] + dsk * bf2f(*up);
                *up = f2bf(y);
            }
    asm volatile("s_waitcnt lgkmcnt(0)" ::: "memory");
    {
        const size_t base = ((size_t)c * NBATCH + b) * SEQ;
        bf16x8 hvs[8];
#pragma unroll
        for (int i = 0; i < 8; ++i) { const int id = lane + 64 * i; hvs[i] = *(const bf16x8*)(p.hx0t + base + (id >> 3) * 64 + (id & 7) * 8); }
#pragma unroll
        for (int i = 0; i < 8; ++i) {
            const int id = lane + 64 * i, row = id >> 3, c8 = (id & 7) * 8;
            const bf16x8 yv = *(const LAS bf16x8*)(Ub + row * CV_UPITCH + c8 * 2);
            const bf16x8 hv = hvs[i];
            u32x4 w;
            w.x = pk2(bf2f((bf16_t)yv[0]) * bf2f((bf16_t)hv[0]), bf2f((bf16_t)yv[1]) * bf2f((bf16_t)hv[1]));
            w.y = pk2(bf2f((bf16_t)yv[2]) * bf2f((bf16_t)hv[2]), bf2f((bf16_t)yv[3]) * bf2f((bf16_t)hv[3]));
            w.z = pk2(bf2f((bf16_t)yv[4]) * bf2f((bf16_t)hv[4]), bf2f((bf16_t)yv[5]) * bf2f((bf16_t)hv[5]));
            w.w = pk2(bf2f((bf16_t)yv[6]) * bf2f((bf16_t)hv[6]), bf2f((bf16_t)yv[7]) * bf2f((bf16_t)hv[7]));
            *(u32x4*)(p.zt + base + row * 64 + c8) = w;
        }
    }
}
__device__ __forceinline__ void moew_unit(const Params& p, int tu, char* smem, int wv) {
    const int tid = opaque_tid(wv), lane = tid & 63, wid = tid >> 6;
    LAS char* lds = (LAS char*)smem;
    __syncthreads();
    f32x4 ld[16];
#define MW_SRC(t, SRC, DST, MODE, K0, N0) do { const int tile_ = tu * 6 + (t), mat_ = tile_ >> 5, tt_ = tile_ & 31, which_ = mat_ / 32, e_ = mat_ % 32; \
        SRC = (which_ == 0 ? p.w_gate : which_ == 1 ? p.w_up : p.w_down) + (size_t)e_ * 1048576; \
        DST = which_ == 2 ? p.wd_t + (size_t)e_ * 1048576 : p.wgu_t + (size_t)e_ * 2097152; MODE = which_ == 0 ? 2 : which_ == 1 ? 3 : 0; K0 = (tt_ >> 2) * 128; N0 = (tt_ & 3) * 256; } while (0)
    {
        const float* src; bf16_t* dst; int mode, k0, n0; MW_SRC(0, src, dst, mode, k0, n0);
#pragma unroll
        for (int i = 0; i < 16; ++i) ld[i] = *(const f32x4*)(src + (size_t)(k0 + 16 * wid + i) * 1024 + n0 + lane * 4);
    }
    for (int t = 0; t < 6; ++t) {
        LAS char* buf = lds + (t & 1) * 65536;
#pragma unroll
        for (int c = 0; c < 4; ++c) {
            u32x4 w0, w1;
            w0.x = pk2(ld[0][c], ld[1][c]); w0.y = pk2(ld[2][c], ld[3][c]); w0.z = pk2(ld[4][c], ld[5][c]); w0.w = pk2(ld[6][c], ld[7][c]);
            w1.x = pk2(ld[8][c], ld[9][c]); w1.y = pk2(ld[10][c], ld[11][c]); w1.z = pk2(ld[12][c], ld[13][c]); w1.w = pk2(ld[14][c], ld[15][c]);
            LAS char* row = buf + (4 * lane + c) * 256;
            *(LAS u32x4*)(row + (((2 * wid) ^ (lane & 15)) << 4)) = w0;
            *(LAS u32x4*)(row + (((2 * wid + 1) ^ (lane & 15)) << 4)) = w1;
        }
        const float* src; bf16_t* dst; int mode, k0, n0; MW_SRC(t, src, dst, mode, k0, n0);
        if (t + 1 < 6) {
            const float* src2; bf16_t* dst2; int mode2, k02, n02; MW_SRC(t + 1, src2, dst2, mode2, k02, n02);
#pragma unroll
            for (int i = 0; i < 16; ++i) ld[i] = *(const f32x4*)(src2 + (size_t)(k02 + 16 * wid + i) * 1024 + n02 + lane * 4);
        }
        __syncthreads();
#pragma unroll
        for (int i = 0; i < 8; ++i) {
            const int n = i * 32 + (tid >> 4), kc = tid & 15;
            const u32x4 w = *(const LAS u32x4*)(buf + n * 256 + ((kc ^ ((n >> 2) & 15)) << 4));
            *(u32x4*)(dst + (size_t)rowmap(mode, n0 + n) * 1024 + k0 + kc * 8) = w;
        }
    }
#undef MW_SRC
}
__device__ __forceinline__ void phase_mix(const Params& p, int bid, int nblk, char* smem, int wv) {
    const int nsteps = (2048 + nblk - 1) / nblk;
    for (int j = 0; j < nsteps; ++j) {
        const int u = j * nblk + (bid + j) % nblk;
        if (u >= 2048) continue;
        const int g = u >> 3, r = u & 7;
        if (r < 4) attn_unit(p, ((g >> 5) * 4 + r) * 32 + (g & 31), smem, wv);
        else if (r < 6) conv_unit(p, g * 2 + (r - 4), smem, wv);
        else moew_unit(p, g * 2 + (r - 6), smem, wv);
    }
}

__device__ __forceinline__ void phase_hypost(const Params& p, int bid, int nblk, char* smem, int wv) {
    float* tz = (float*)smem;
    const int tid = opaque_tid(wv);
    constexpr int NU = 8 * 64 * 8;
    for (int u0 = bid; u0 < NU; u0 += 4 * nblk) {
        bf16x8 v[4];
#pragma unroll
        for (int q = 0; q < 4; ++q) { const int u = u0 + q * nblk; v[q] = (bf16x8){0, 0, 0, 0, 0, 0, 0, 0};
            if (u < NU) { const int g = u & 7, st = (u >> 3) & 63, b = u >> 9, s0 = st * 64, c = tid >> 3, s8 = (tid & 7) * 8;
                v[q] = *(const bf16x8*)(p.zt + ((size_t)(g * 64 + c) * NBATCH + b) * SEQ + s0 + s8); } }
#pragma unroll
        for (int q = 0; q < 4; ++q) { const int c = tid >> 3, s8 = (tid & 7) * 8;
#pragma unroll
            for (int i = 0; i < 8; ++i) tz[q * (64 * 65) + c * 65 + s8 + i] = bf2f((bf16_t)v[q][i]); }
        __syncthreads();
#pragma unroll
        for (int q = 0; q < 4; ++q) { const int u = u0 + q * nblk;
            if (u < NU) {
                const int g = u & 7, st = (u >> 3) & 63, b = u >> 9, s0 = st * 64;
                const int s = tid >> 3, c8 = (tid & 7) * 8;
                float z[8]; float ss = 0.f;
#pragma unroll
                for (int i = 0; i < 8; ++i) { z[i] = tz[q * (64 * 65) + (c8 + i) * 65 + s]; ss += z[i] * z[i]; }
                ss += __shfl_xor(ss, 1); ss += __shfl_xor(ss, 2); ss += __shfl_xor(ss, 4);
                const float rstd = 1.0f / sqrtf(ss * (1.0f / 64.0f) + 1e-6f);
                u32x4 w;
                const float* gn = p.hy_gn + g * 64 + c8;
                w.x = pk2(z[0] * rstd * gn[0], z[1] * rstd * gn[1]); w.y = pk2(z[2] * rstd * gn[2], z[3] * rstd * gn[3]);
                w.z = pk2(z[4] * rstd * gn[4], z[5] * rstd * gn[5]); w.w = pk2(z[6] * rstd * gn[6], z[7] * rstd * gn[7]);
                *(u32x4*)(p.mixin + (size_t)(b * SEQ + s0 + s) * DM + 512 + g * 64 + c8) = w;
            } }
        __syncthreads();
    }
}

struct EpiOutproj {
    const Params& p;
    static constexpr int BATCH = 4;
    typedef EpiNone ColPre; typedef EpiNone RowPre; struct Pre { f32x4 x[2][2]; };
    __device__ __forceinline__ ColPre colpre(const pg8::DenseUnit&, int) const { return ColPre{}; }
    __device__ __forceinline__ RowPre rowpre(const pg8::DenseUnit&, int, int) const { return RowPre{}; }
    __device__ __forceinline__ Pre pre(const pg8::DenseUnit& u, int r, int cb, const RowPre&, const ColPre&) const {
        const float* xp = p.x + (size_t)(u.pm * 256 + r) * DM + u.pn * 256 + cb; Pre x;
        x.x[0][0] = *(const f32x4*)xp; x.x[0][1] = *(const f32x4*)(xp + 4); x.x[1][0] = *(const f32x4*)(xp + 128); x.x[1][1] = *(const f32x4*)(xp + 132); return x; }
    __device__ __forceinline__ void store(const pg8::DenseUnit& u, int r, int cb, f32x4 v00, f32x4 v01, f32x4 v10, f32x4 v11, const RowPre&, const ColPre&, const Pre& x) const {
        float* op = p.out + (size_t)(u.pm * 256 + r) * DM + u.pn * 256 + cb;
        *(f32x4*)op = x.x[0][0] + v00; *(f32x4*)(op + 4) = x.x[0][1] + v01; *(f32x4*)(op + 128) = x.x[1][0] + v10; *(f32x4*)(op + 132) = x.x[1][1] + v11; }
};
__device__ __forceinline__ void phase_outproj(const Params& p, int bid, int nblk, char* smem, int wv) {
    pg8::DenseOrder S; S.init(T, 1024, 1024, p.wout_t, nblk, bid);
    pg8::gemm_phase((LAS unsigned char*)smem, (const char*)p.mixin, 1024, S, EpiOutproj{p}, wv);
}

constexpr int RT_PITCH = 1032;
__device__ __forceinline__ void phase_router(const Params& p, int bid, int nblk, char* smem, int wv) {
    const int tid = opaque_tid(wv), lane = tid & 63, wid = tid >> 6, fr = lane & 15, fq = lane >> 4;
    bf16_t* rwh = (bf16_t*)smem;
    bf16_t* rwl = rwh + 32 * RT_PITCH;
    float* lgs = (float*)(smem + 2 * 32 * RT_PITCH * 2) + wid * 512;
#pragma unroll 8
    for (int i = tid; i < 1024 * 32; i += 512) {
        const int k = i >> 5, e = i & 31; const float w = p.router_w[i];
        const bf16_t h = f2bf(w); rwh[e * RT_PITCH + k] = h; rwl[e * RT_PITCH + k] = f2bf(w - bf2f(h));
    }
    __syncthreads();
    int* hist = (int*)(smem + 2 * 32 * RT_PITCH * 2 + 8 * 2048);
    for (int g0 = bid * 8; g0 < T / 16; g0 += nblk * 8) {
        const int grp = g0 + wid; const bool live = grp < T / 16;
        const int t0 = (live ? grp : 0) * 16;
        if (tid < 32) hist[tid] = 0;
        const float* hrow = p.out + (size_t)(t0 + fr) * DM + fq * 8;
        bf16_t* hnrow = p.hn + (size_t)(t0 + fr) * DM + fq * 8;
        f32x4 acc0 = (f32x4){0.f, 0.f, 0.f, 0.f}, acc1 = acc0; float ss = 0.f;
#pragma unroll 4
        for (int ks = 0; ks < 32; ++ks) {
            const f32x4 h0 = *(const f32x4*)(hrow + ks * 32), h1 = *(const f32x4*)(hrow + ks * 32 + 4);
            const f32x4 g0 = *(const f32x4*)(p.g_ffn + ks * 32 + fq * 8), g1 = *(const f32x4*)(p.g_ffn + ks * 32 + fq * 8 + 4);
            ss += h0[0] * h0[0] + h0[1] * h0[1] + h0[2] * h0[2] + h0[3] * h0[3] + h1[0] * h1[0] + h1[1] * h1[1] + h1[2] * h1[2] + h1[3] * h1[3];
            const f32x4 x0 = h0 * g0, x1 = h1 * g1;
            const u32x4 hi = pk8(x0, x1);
            f32x4 r0, r1;
            r0[0] = x0[0] - __uint_as_float(hi.x << 16); r0[1] = x0[1] - __uint_as_float(hi.x & 0xFFFF0000u); r0[2] = x0[2] - __uint_as_float(hi.y << 16); r0[3] = x0[3] - __uint_as_float(hi.y & 0xFFFF0000u);
            r1[0] = x1[0] - __uint_as_float(hi.z << 16); r1[1] = x1[1] - __uint_as_float(hi.z & 0xFFFF0000u); r1[2] = x1[2] - __uint_as_float(hi.w << 16); r1[3] = x1[3] - __uint_as_float(hi.w & 0xFFFF0000u);
            const u32x4 lo = pk8(r0, r1);
            if (live) *(u32x4*)(hnrow + ks * 32) = hi;
            const bf16x8 ah = *reinterpret_cast<const bf16x8*>(&hi), al = *reinterpret_cast<const bf16x8*>(&lo);
            const bf16x8 bh0 = *(const bf16x8*)(rwh + fr * RT_PITCH + ks * 32 + fq * 8), bh1 = *(const bf16x8*)(rwh + (16 + fr) * RT_PITCH + ks * 32 + fq * 8);
            const bf16x8 bl0 = *(const bf16x8*)(rwl + fr * RT_PITCH + ks * 32 + fq * 8), bl1 = *(const bf16x8*)(rwl + (16 + fr) * RT_PITCH + ks * 32 + fq * 8);
            acc0 = __builtin_amdgcn_mfma_f32_16x16x32_bf16(ah, bh0, acc0, 0, 0, 0); acc1 = __builtin_amdgcn_mfma_f32_16x16x32_bf16(ah, bh1, acc1, 0, 0, 0);
            acc0 = __builtin_amdgcn_mfma_f32_16x16x32_bf16(al, bh0, acc0, 0, 0, 0); acc1 = __builtin_amdgcn_mfma_f32_16x16x32_bf16(al, bh1, acc1, 0, 0, 0);
            acc0 = __builtin_amdgcn_mfma_f32_16x16x32_bf16(ah, bl0, acc0, 0, 0, 0); acc1 = __builtin_amdgcn_mfma_f32_16x16x32_bf16(ah, bl1, acc1, 0, 0, 0);
        }
        ss += __shfl_xor(ss, 16); ss += __shfl_xor(ss, 32);
#pragma unroll
        for (int rg = 0; rg < 4; ++rg) { lgs[(4 * fq + rg) * 32 + fr] = acc0[rg]; lgs[(4 * fq + rg) * 32 + 16 + fr] = acc1[rg]; }
        asm volatile("s_waitcnt lgkmcnt(0)" ::: "memory");
        const int tk = lane >> 2;
        const float rstd = 1.0f / sqrtf(__shfl(ss, tk) * (1.0f / 1024.0f) + 1e-6f);
        float lg[32];
#pragma unroll
        for (int e4 = 0; e4 < 8; ++e4) { const f32x4 v = *(const f32x4*)(lgs + tk * 32 + e4 * 4); const f32x4 bb = *(const f32x4*)(p.router_b + e4 * 4);
            lg[4 * e4] = v[0] * rstd + bb[0]; lg[4 * e4 + 1] = v[1] * rstd + bb[1]; lg[4 * e4 + 2] = v[2] * rstd + bb[2]; lg[4 * e4 + 3] = v[3] * rstd + bb[3]; }
        int te[4]; float tl[4];
#pragma unroll
        for (int k = 0; k < 4; ++k) {
            float best = -3.0e38f; int bi = 0;
#pragma unroll
            for (int e = 0; e < 32; ++e) { if (lg[e] > best) { best = lg[e]; bi = e; } }
            te[k] = bi; tl[k] = best;
#pragma unroll
            for (int e = 0; e < 32; ++e) if (e == bi) lg[e] = -3.0e38f;
        }
        const float e1 = expf(tl[1] - tl[0]), e2 = expf(tl[2] - tl[0]), e3 = expf(tl[3] - tl[0]);
        const float inv = 1.0f / (1.0f + e1 + e2 + e3);
        const int kk = lane & 3;
        const int my_e = kk == 0 ? te[0] : kk == 1 ? te[1] : kk == 2 ? te[2] : te[3];
        const float my_w = (kk == 0 ? 1.0f : kk == 1 ? e1 : kk == 2 ? e2 : e3) * inv;
        __syncthreads();
        int lp = 0;
        if (live) lp = atomicAdd(hist + my_e, 1);
        __syncthreads();
        if (tid < 32) { const int n = hist[tid]; hist[32 + tid] = n ? atomicAdd(p.cnt + tid, n) : 0; }
        __syncthreads();
        if (live) {
            const int asg = grp * 64 + lane;
            const int ps = hist[32 + my_e] + lp;
            p.list[my_e * T + ps] = asg; p.listw[my_e * T + ps] = my_w; p.listr[my_e * T + ps] = rstd;
            p.tope[asg] = my_e; p.topw[asg] = my_w; p.pos[asg] = ps;
        }
        __syncthreads();
    }
    for (int i = bid * 512 + tid; i < T * 256 / 4; i += 4 * nblk * 512) {
        float4 pv[4];
#pragma unroll
        for (int q = 0; q < 4; ++q) { const int ii = i + q * nblk * 512; pv[q] = ii < T * 256 / 4 ? ((const float4*)p.p)[ii] : make_float4(0.f, 0.f, 0.f, 0.f); }
#pragma unroll
        for (int q = 0; q < 4; ++q) { const int ii = i + q * nblk * 512; if (ii < T * 256 / 4) { u32x2 w; w.x = pk2(pv[q].x, pv[q].y); w.y = pk2(pv[q].z, pv[q].w); *(u32x2*)(p.pb + (size_t)ii * 4) = w; } }
    }
}

struct MoeTab { int tiles[33]; int start[33]; };
__device__ __forceinline__ void moe_setup(const Params& p, MoeTab* tab, int wv) {
    __syncthreads();
    if (xb_thread0(wv)) {
        int a = 0, b = 0;
        for (int e = 0; e < 32; ++e) { const int c = p.cnt[e]; tab->tiles[e] = a; tab->start[e] = b; a += (c + 255) >> 8; b += c; }
        tab->tiles[32] = a; tab->start[32] = b;
    }
    __syncthreads();
}
__device__ __forceinline__ int moe_find(const MoeTab* tab, int tile) {
    int e = 0;
#pragma unroll
    for (int i = 0; i < 32; ++i) if (tile >= tab->tiles[i + 1]) e = i + 1;
    return e;
}

struct MoeUnit1 {
    static constexpr bool GATHER = true;
    int e, tn, nvalid, slot0; const int* lst; const float* lstr; const char* bt;
    __device__ __forceinline__ const char* bbase() const { return bt; }
    __device__ __forceinline__ size_t abyte() const { return 0; }
    __device__ __forceinline__ unsigned arow_idx(int r) const { const int rr = r < nvalid ? r : nvalid - 1; return (unsigned)(lst[rr] >> 2); }
};
struct MoeUnit2 {
    static constexpr bool GATHER = false;
    int e, tn, nvalid, slot0; const int* lst; const float* lstw; const char* bt;
    __device__ __forceinline__ const char* bbase() const { return bt; }
    __device__ __forceinline__ size_t abyte() const { return (size_t)slot0 * 2048; }
    __device__ __forceinline__ unsigned arow_idx(int) const { return 0u; }
};
template <class U, int NT  > struct MoeOrder {
    typedef U Unit;
    const MoeTab* tab; const Params* p; int G, c;
    __device__ __forceinline__ unsigned rowbytes() const { return 2048u; }
    __device__ __forceinline__ bool next(int i, Unit& u) const {
        int tile, tn;
        if (G == 256) { const int x = c & 7, j = c >> 3; constexpr int TPX = 32 / NT; tile = i * (256 / NT) + x * TPX + j / NT; tn = j % NT; }
        else { const long L = (long)i * G + c; tile = (int)(L / NT); tn = (int)(L % NT); }
        if (tile >= __builtin_amdgcn_readfirstlane(tab->tiles[32])) return false;
        const int e = __builtin_amdgcn_readfirstlane(moe_find(tab, tile)), mt = tile - __builtin_amdgcn_readfirstlane(tab->tiles[e]);
        const int st0 = __builtin_amdgcn_readfirstlane(tab->start[e]), cnt = __builtin_amdgcn_readfirstlane(tab->start[e + 1]) - st0;
        u.e = e; u.tn = tn; u.nvalid = cnt - mt * 256 < 256 ? cnt - mt * 256 : 256; u.slot0 = st0 + mt * 256;
        u.lst = p->list + (size_t)e * T + mt * 256;
        fill(u, e, mt, tn);
        return true;
    }
    __device__ __forceinline__ void fill(MoeUnit1& u, int e, int mt, int tn) const { u.bt = (const char*)(p->wgu_t + (size_t)e * 2097152 + (size_t)tn * 256 * 1024); u.lstr = p->listr + (size_t)e * T + mt * 256; }
    __device__ __forceinline__ void fill(MoeUnit2& u, int e, int mt, int tn) const { u.bt = (const char*)(p->wd_t + (size_t)e * 1048576 + (size_t)tn * 256 * 1024); u.lstw = p->listw + (size_t)e * T + mt * 256; }
};
struct EpiMoe1 {
    const Params& p;
    static constexpr int BATCH = 8;
    struct ColPre { f32x4 bg[2], bu[2]; }; typedef float RowPre; typedef EpiNone Pre;
    __device__ __forceinline__ ColPre colpre(const MoeUnit1& u, int cb) const { const int j = u.e * 1024 + u.tn * 128 + cb; ColPre x;
        x.bg[0] = *(const f32x4*)(p.b_gate + j); x.bg[1] = *(const f32x4*)(p.b_gate + j + 4); x.bu[0] = *(const f32x4*)(p.b_up + j); x.bu[1] = *(const f32x4*)(p.b_up + j + 4); return x; }
    __device__ __forceinline__ RowPre rowpre(const MoeUnit1& u, int r, int) const { return r < u.nvalid ? u.lstr[r] : 0.f; }
    __device__ __forceinline__ Pre pre(const MoeUnit1&, int, int, const RowPre&, const ColPre&) const { return Pre{}; }
    __device__ __forceinline__ void store(const MoeUnit1& u, int r, int cb, f32x4 g0, f32x4 g1, f32x4 u0, f32x4 u1, const RowPre& rs, const ColPre& cp, const Pre&) const {
        if (r < u.nvalid) {
            f32x4 ga = g0 * rs + cp.bg[0], gb = g1 * rs + cp.bg[1], ua = u0 * rs + cp.bu[0], ub = u1 * rs + cp.bu[1];
#pragma unroll
            for (int i = 0; i < 4; ++i) { ga[i] = fminf(ga[i], 7.0f); gb[i] = fminf(gb[i], 7.0f); ua[i] = __builtin_amdgcn_fmed3f(ua[i], -7.0f, 7.0f); ub[i] = __builtin_amdgcn_fmed3f(ub[i], -7.0f, 7.0f); }
            f32x4 ea = ga * (-1.702f * 1.4426950408889634f), eb = gb * (-1.702f * 1.4426950408889634f);
#pragma unroll
            for (int i = 0; i < 4; ++i) { ea[i] = __builtin_amdgcn_exp2f(ea[i]); eb[i] = __builtin_amdgcn_exp2f(eb[i]); }
            ea = ea + 1.0f; eb = eb + 1.0f;
#pragma unroll
            for (int i = 0; i < 4; ++i) { ea[i] = __builtin_amdgcn_rcpf(ea[i]); eb[i] = __builtin_amdgcn_rcpf(eb[i]); }
            const f32x4 sa = ga * ea, sb = gb * eb;
            const f32x4 a0 = ua * sa + sa, a1 = ub * sb + sb;
            *(u32x4*)(p.act + (size_t)(u.slot0 + r) * DM + u.tn * 128 + cb) = pk8(a0, a1);
        }
    }
};
__device__ __forceinline__ void phase_moe1(const Params& p, int bid, int nblk, char* smem, int wv) {
    MoeTab* tab = (MoeTab*)(smem + 131072);
    moe_setup(p, tab, wv);
    MoeOrder<MoeUnit1, 8> S; S.tab = tab; S.p = &p; S.G = nblk; S.c = bid;
    pg8::gemm_phase((LAS unsigned char*)smem, (const char*)p.hn, 1024, S, EpiMoe1{p}, wv);
}
struct EpiMoe2 {
    const Params& p;
    static constexpr int BATCH = 1;
    struct ColPre { f32x4 bd[2][2]; }; struct RowPre { int asg; float w; }; struct Pre { f32x4 h[2][2]; };
    __device__ __forceinline__ ColPre colpre(const MoeUnit2& u, int cb) const { const float* bp = p.b_down + u.e * 1024 + u.tn * 256 + cb; ColPre x;
        x.bd[0][0] = *(const f32x4*)bp; x.bd[0][1] = *(const f32x4*)(bp + 4); x.bd[1][0] = *(const f32x4*)(bp + 128); x.bd[1][1] = *(const f32x4*)(bp + 132); return x; }
    __device__ __forceinline__ RowPre rowpre(const MoeUnit2& u, int r, int) const { RowPre x; x.asg = -1; x.w = 0.f; if (r < u.nvalid) { x.asg = u.lst[r]; x.w = u.lstw[r]; } return x; }
    __device__ __forceinline__ Pre pre(const MoeUnit2& u, int, int cb, const RowPre& rp, const ColPre&) const {
        Pre x; x.h[0][0] = (f32x4){0.f, 0.f, 0.f, 0.f}; x.h[0][1] = x.h[0][0]; x.h[1][0] = x.h[0][0]; x.h[1][1] = x.h[0][0];
        if (rp.asg >= 0 && (rp.asg & 3) == 0) { const float* hp = p.out + (size_t)(rp.asg >> 2) * DM + u.tn * 256 + cb;
            x.h[0][0] = *(const f32x4*)hp; x.h[0][1] = *(const f32x4*)(hp + 4); x.h[1][0] = *(const f32x4*)(hp + 128); x.h[1][1] = *(const f32x4*)(hp + 132); }
        return x; }
    __device__ __forceinline__ void store(const MoeUnit2& u, int, int cb, f32x4 v00, f32x4 v01, f32x4 v10, f32x4 v11, const RowPre& rp, const ColPre& cp, const Pre& x) const {
        if (rp.asg >= 0) {
            const int tok = rp.asg >> 2, k = rp.asg & 3, col = u.tn * 256 + cb;
            const f32x4 a = (v00 + cp.bd[0][0]) * rp.w, b = (v01 + cp.bd[0][1]) * rp.w, c = (v10 + cp.bd[1][0]) * rp.w, d = (v11 + cp.bd[1][1]) * rp.w;
            if (k == 0) { float* hp = p.out + (size_t)tok * DM + col;
                *(f32x4*)hp = x.h[0][0] + a; *(f32x4*)(hp + 4) = x.h[0][1] + b; *(f32x4*)(hp + 128) = x.h[1][0] + c; *(f32x4*)(hp + 132) = x.h[1][1] + d; }
            else { bf16_t* yp = p.y + ((size_t)tok * 3 + (k - 1)) * DM + col; *(u32x4*)yp = pk8(a, b); *(u32x4*)(yp + 128) = pk8(c, d); }
        }
    }
};
__device__ __forceinline__ void phase_moe2(const Params& p, int bid, int nblk, char* smem, int wv) {
    MoeTab* tab = (MoeTab*)(smem + 131072);
    moe_setup(p, tab, wv);
    MoeOrder<MoeUnit2, 4> S; S.tab = tab; S.p = &p; S.G = nblk; S.c = bid;
    pg8::gemm_phase((LAS unsigned char*)smem, (const char*)p.act, 1024, S, EpiMoe2{p}, wv);
}
struct EpiPle {
    const Params& p;
    static constexpr int BATCH = 8;
    typedef EpiNone ColPre; typedef EpiNone RowPre; typedef EpiNone Pre;
    __device__ __forceinline__ ColPre colpre(const pg8::DenseUnit&, int) const { return ColPre{}; }
    __device__ __forceinline__ RowPre rowpre(const pg8::DenseUnit&, int, int) const { return RowPre{}; }
    __device__ __forceinline__ Pre pre(const pg8::DenseUnit&, int, int, const RowPre&, const ColPre&) const { return Pre{}; }
    __device__ __forceinline__ void store(const pg8::DenseUnit& u, int r, int cb, f32x4 v00, f32x4 v01, f32x4 v10, f32x4 v11, const RowPre&, const ColPre&, const Pre&) const {
        const int row = u.pm * 256 + r;
        bf16_t* ep = p.epre + (size_t)row * DM + u.pn * 256 + cb;
        const u32x4 w0 = pk8(v00, v01), w1 = pk8(v10, v11);
        *(u32x4*)ep = w0; *(u32x4*)(ep + 128) = w1;
        float s = 0.f;
#pragma unroll
        for (int i = 0; i < 4; ++i) { const unsigned a = w0[i], b = w1[i];
            const float a0 = __uint_as_float(a << 16), a1 = __uint_as_float(a & 0xFFFF0000u), b0 = __uint_as_float(b << 16), b1 = __uint_as_float(b & 0xFFFF0000u);
            s += a0 * a0 + a1 * a1 + b0 * b0 + b1 * b1; }
        s += __shfl_xor(s, 16); s += __shfl_xor(s, 32);
        if (((cb >> 3) & 3) == 0) atomicAdd(p.rstd_e + row, s); }
};
__device__ __forceinline__ void phase_ple(const Params& p, int bid, int nblk, char* smem, int wv) {
    pg8::DenseOrder S; S.init(T, 1024, 256, p.wple_t, nblk, bid);
    pg8::gemm_phase((LAS unsigned char*)smem, (const char*)p.pb, 256, S, EpiPle{p}, wv);
}
__device__ __forceinline__ void phase_combine(const Params& p, int bid, int nblk, char* smem, int wv) {
    const int tid = opaque_tid(wv), lane = tid & 63, wid = tid >> 6;
    for (int t0 = (bid * 8 + wid) * 2; t0 < T; t0 += nblk * 16) {
        float4 h[2][4]; u32x2 yv[2][4][3];
#pragma unroll
        for (int rr = 0; rr < 2; ++rr)
#pragma unroll
            for (int i = 0; i < 4; ++i) { const int c4 = lane + 64 * i; h[rr][i] = ((const float4*)(p.out + (size_t)(t0 + rr) * DM))[c4];
#pragma unroll
                for (int k = 0; k < 3; ++k) yv[rr][i][k] = *(const u32x2*)(p.y + ((size_t)(t0 + rr) * 3 + k) * DM + c4 * 4); }
#pragma unroll
        for (int rr = 0; rr < 2; ++rr)
#pragma unroll
            for (int i = 0; i < 4; ++i) { const int c4 = lane + 64 * i; float4 hh = h[rr][i];
#pragma unroll
                for (int k = 0; k < 3; ++k) { const u32x2 y = yv[rr][i][k];
                    hh.x += __uint_as_float(y.x << 16); hh.y += __uint_as_float(y.x & 0xFFFF0000u); hh.z += __uint_as_float(y.y << 16); hh.w += __uint_as_float(y.y & 0xFFFF0000u); }
                ((float4*)(p.out + (size_t)(t0 + rr) * DM))[c4] = hh;
                u32x2 w; w.x = pk2(hh.x, hh.y); w.y = pk2(hh.z, hh.w);
                *(u32x2*)(p.h2b + (size_t)(t0 + rr) * DM + c4 * 4) = w; }
    }
}
struct EpiGate {
    const Params& p;
    static constexpr int BATCH = 2;
    struct ColPre { f32x4 bg[2][2], gp[2][2]; }; typedef float RowPre; struct Pre { f32x4 h[2][2]; u32x4 ev[2]; };
    __device__ __forceinline__ ColPre colpre(const pg8::DenseUnit& u, int cb) const { ColPre x;
#pragma unroll
        for (int bj = 0; bj < 2; ++bj)
#pragma unroll
            for (int n = 0; n < 2; ++n) { const int c = u.pn * 256 + bj * 128 + cb + 4 * n; x.bg[bj][n] = *(const f32x4*)(p.b_pg + c); x.gp[bj][n] = *(const f32x4*)(p.g_ple + c); }
        return x; }
    __device__ __forceinline__ RowPre rowpre(const pg8::DenseUnit& u, int r, int) const { return __builtin_amdgcn_rsqf(p.rstd_e[u.pm * 256 + r] * (1.0f / 1024.0f) + 1e-6f); }
    __device__ __forceinline__ Pre pre(const pg8::DenseUnit& u, int r, int cb, const RowPre&, const ColPre&) const {
        const size_t off = (size_t)(u.pm * 256 + r) * DM + u.pn * 256 + cb; Pre x;
        x.h[0][0] = *(const f32x4*)(p.out + off); x.h[0][1] = *(const f32x4*)(p.out + off + 4); x.h[1][0] = *(const f32x4*)(p.out + off + 128); x.h[1][1] = *(const f32x4*)(p.out + off + 132);
        x.ev[0] = *(const u32x4*)(p.epre + off); x.ev[1] = *(const u32x4*)(p.epre + off + 128); return x; }
    __device__ __forceinline__ void store(const pg8::DenseUnit& u, int r, int cb, f32x4 v00, f32x4 v01, f32x4 v10, f32x4 v11, const RowPre& rs, const ColPre& cp, const Pre& x) const {
        const size_t off = (size_t)(u.pm * 256 + r) * DM + u.pn * 256 + cb;
#pragma unroll
        for (int bj = 0; bj < 2; ++bj)
#pragma unroll
            for (int n = 0; n < 2; ++n) {
                const f32x4 v = bj ? (n ? v11 : v10) : (n ? v01 : v00);
                const unsigned w0 = n ? x.ev[bj].z : x.ev[bj].x, w1 = n ? x.ev[bj].w : x.ev[bj].y;
                f32x4 e; e[0] = __uint_as_float(w0 << 16); e[1] = __uint_as_float(w0 & 0xFFFF0000u); e[2] = __uint_as_float(w1 << 16); e[3] = __uint_as_float(w1 & 0xFFFF0000u);
                f32x4 h = x.h[bj][n];
#pragma unroll
                for (int i = 0; i < 4; ++i) h[i] += sigmoidf_(v[i] + cp.bg[bj][n][i]) * (e[i] * rs * cp.gp[bj][n][i]);
                *(f32x4*)(p.out + off + bj * 128 + n * 4) = h;
            }
    }
};
__device__ __forceinline__ void phase_gate(const Params& p, int bid, int nblk, char* smem, int wv) {
    pg8::DenseOrder S; S.init(T, 1024, 1024, p.wpg_t, nblk, bid);
    pg8::gemm_phase((LAS unsigned char*)smem, (const char*)p.h2b, 1024, S, EpiGate{p}, wv);
}
__device__ __forceinline__ void phase_final(const Params& p, int bid, int nblk, char* smem, int wv) {
    const int tid = opaque_tid(wv), lane = tid & 63, wid = tid >> 6;
    float4 g[4];
#pragma unroll
    for (int i = 0; i < 4; ++i) g[i] = ((const float4*)p.g_final)[lane + 64 * i];
    for (int t = (bid * 8 + wid) * 2; t < T; t += nblk * 16) {
        float4* hr0 = (float4*)(p.out + (size_t)t * DM); float4* hr1 = hr0 + DM / 4;
        float4 v0[4], v1[4]; float s0 = 0.f, s1 = 0.f;
#pragma unroll
        for (int i = 0; i < 4; ++i) { v0[i] = hr0[lane + 64 * i]; v1[i] = hr1[lane + 64 * i]; }
#pragma unroll
        for (int i = 0; i < 4; ++i) { s0 += v0[i].x * v0[i].x + v0[i].y * v0[i].y + v0[i].z * v0[i].z + v0[i].w * v0[i].w; s1 += v1[i].x * v1[i].x + v1[i].y * v1[i].y + v1[i].z * v1[i].z + v1[i].w * v1[i].w; }
        s0 = wave_sum(s0); s1 = wave_sum(s1);
        const float r0 = __builtin_amdgcn_rsqf(s0 * (1.0f / 1024.0f) + 1e-6f), r1 = __builtin_amdgcn_rsqf(s1 * (1.0f / 1024.0f) + 1e-6f);
#pragma unroll
        for (int i = 0; i < 4; ++i) {
            hr0[lane + 64 * i] = make_float4(v0[i].x * r0 * g[i].x, v0[i].y * r0 * g[i].y, v0[i].z * r0 * g[i].z, v0[i].w * r0 * g[i].w);
            hr1[lane + 64 * i] = make_float4(v1[i].x * r1 * g[i].x, v1[i].y * r1 * g[i].y, v1[i].z * r1 * g[i].z, v1[i].w * r1 * g[i].w);
        }
    }
}

template <int PH> __device__ __forceinline__ void run_phase(const Params& p, int bid, int nblk, char* smem, int wv) {
    if constexpr (PH == 0) phase_prologue(p, bid, nblk, smem, wv);
    else if constexpr (PH == 1) phase_inproj(p, bid, nblk, smem, wv);
    else if constexpr (PH == 2) phase_hyprep(p, bid, nblk, smem, wv);
    else if constexpr (PH == 3) phase_mix(p, bid, nblk, smem, wv);
    else if constexpr (PH == 4) phase_hypost(p, bid, nblk, smem, wv);
    else if constexpr (PH == 5) phase_outproj(p, bid, nblk, smem, wv);
    else if constexpr (PH == 6) phase_router(p, bid, nblk, smem, wv);
    else if constexpr (PH == 7) phase_moe1(p, bid, nblk, smem, wv);
    else if constexpr (PH == 8) phase_moe2(p, bid, nblk, smem, wv);
    else if constexpr (PH == 9) { phase_ple(p, bid, nblk, smem, wv); phase_combine(p, bid, nblk, smem, wv); }
    else if constexpr (PH == 10) {}
    else if constexpr (PH == 11) phase_gate(p, bid, nblk, smem, wv);
    else if constexpr (PH == 12) phase_final(p, bid, nblk, smem, wv);
}

template <int PH> __global__ void __launch_bounds__(512, 2) k_phase(Params p) {
    extern __shared__ __attribute__((aligned(16))) char smem[];
    run_phase<PH>(p, blockIdx.x, gridDim.x, smem, __builtin_amdgcn_readfirstlane(threadIdx.x >> 6));
}

__global__ void __launch_bounds__(512, 2) k_mega(Params p) {
    extern __shared__ __attribute__((aligned(16))) char smem[];
    const int bid = blockIdx.x, nblk = gridDim.x, wv = __builtin_amdgcn_readfirstlane(threadIdx.x >> 6);
    uint4* xbw = (uint4*)(smem + LDS_BYTES - 16);
    if (xb_thread0(wv)) *xbw = make_uint4(0u, 0u, 0u, 0u);
    __syncthreads();
    XcdBarrier bar = xcd_barrier_post(p.bar, (volatile LAS unsigned*)xbw, wv);
    run_phase<0>(p, bid, nblk, smem, wv); xcd_barrier(bar);
    run_phase<1>(p, bid, nblk, smem, wv); xcd_barrier(bar);
    run_phase<2>(p, bid, nblk, smem, wv); xcd_barrier(bar);
    run_phase<3>(p, bid, nblk, smem, wv); xcd_barrier(bar);
    run_phase<4>(p, bid, nblk, smem, wv); xcd_barrier(bar);
    run_phase<5>(p, bid, nblk, smem, wv); xcd_barrier(bar);
    run_phase<6>(p, bid, nblk, smem, wv); xcd_barrier(bar);
    run_phase<7>(p, bid, nblk, smem, wv); xcd_barrier(bar);
    run_phase<8>(p, bid, nblk, smem, wv); xcd_barrier(bar);
    run_phase<9>(p, bid, nblk, smem, wv); xcd_barrier(bar);
    run_phase<11>(p, bid, nblk, smem, wv); xcd_barrier(bar);
    run_phase<12>(p, bid, nblk, smem, wv);
}

template <int PH> static void launch_phase(const Params& p, int grid, hipStream_t stream) {
    static bool attr = false;
    if (!attr) { (void)hipFuncSetAttribute((const void*)k_phase<PH>, hipFuncAttributeMaxDynamicSharedMemorySize, LDS_BYTES); attr = true; }
    hipLaunchKernelGGL(k_phase<PH>, dim3(grid), dim3(512), LDS_BYTES, stream, p);
}

extern "C" void kernel_launch(void* const* d_in, const int* in_sizes, int n_in,
                              void* d_out, int out_size, void* d_ws, size_t ws_size,
                              hipStream_t stream) {
    constexpr size_t MiB = 1048576;
    char* ws = (char*)d_ws;
    size_t off = 0;
    auto take = [&](size_t bytes) { char* r = ws + off; off += (bytes + 255) & ~(size_t)255; return r; };
    Params p{};
    const float** in = (const float**)&p.x;
    for (int i = 0; i < 34; ++i) in[i] = (const float*)d_in[i];
    p.out = (float*)d_out;
    char* ctrl = take(65536);
    p.bar = (unsigned*)ctrl; p.cnt = (int*)(ctrl + 16384); p.lam = (float*)(ctrl + 32768); p.kmax = (int*)(ctrl + 20480);
    p.rope = (float2*)take(1 * MiB);
    p.kt = (float*)take(16 * MiB);
    p.pb = (bf16_t*)p.kt;
    p.win_t = (bf16_t*)take(6 * MiB); p.wout_t = (bf16_t*)take(2 * MiB); p.wple_t = (bf16_t*)take(MiB / 2); p.wpg_t = (bf16_t*)take(2 * MiB);
    p.tope = (int*)take(MiB / 2); p.topw = (float*)take(MiB / 2); p.pos = (int*)take(MiB / 2); p.list = (int*)take(4 * MiB); p.listw = (float*)take(4 * MiB); p.listr = (float*)take(4 * MiB); p.rstd_e = (float*)take(MiB / 8);
    p.wd_t = (bf16_t*)take(64 * MiB);
    p.wgu_t = (bf16_t*)take(128 * MiB);
    char* dyn = ws + off;
    p.xn = (bf16_t*)dyn; p.ut = (bf16_t*)dyn; p.hx0t = (bf16_t*)(dyn + 32 * MiB);
    p.q = (bf16_t*)(dyn + 64 * MiB); p.k = (bf16_t*)(dyn + 96 * MiB); p.v = (bf16_t*)(dyn + 128 * MiB);
    p.hy = (bf16_t*)(dyn + 160 * MiB); p.zt = (bf16_t*)(dyn + 160 * MiB); p.mixin = (bf16_t*)(dyn + 192 * MiB);
    p.hn = (bf16_t*)dyn; p.act = (bf16_t*)(dyn + 64 * MiB);
    p.y = p.wgu_t;
    p.h2b = (bf16_t*)(dyn + 64 * MiB); p.epre = (bf16_t*)(dyn + 128 * MiB);
    const size_t need = off + 64 * MiB + (size_t)(131072 + 256) * 2048;
    if (ws_size < need || n_in != 34 || out_size != T * DM) { fprintf(stderr, "kernel_launch: bad sizes ws %zu need %zu\n", ws_size, need); return; }

    (void)hipMemsetAsync(ctrl, 0, 32768, stream);
#if MK_ONE_LAUNCH
    static int grid = 0;
    if (!grid) {
        int dev = 0, cus = 0, per_cu = 0;
        (void)hipGetDevice(&dev);
        (void)hipDeviceGetAttribute(&cus, hipDeviceAttributeMultiprocessorCount, dev);
        (void)hipFuncSetAttribute((const void*)k_mega, hipFuncAttributeMaxDynamicSharedMemorySize, LDS_BYTES);
        (void)hipOccupancyMaxActiveBlocksPerMultiprocessor(&per_cu, (const void*)k_mega, 512, LDS_BYTES);
        grid = cus * (per_cu < 1 ? per_cu : 1);
    }
    if (grid > 0) hipLaunchKernelGGL(k_mega, dim3(grid), dim3(512), LDS_BYTES, stream, p);
#else
    const int grid = 256;
    launch_phase<0>(p, grid, stream); launch_phase<1>(p, grid, stream); launch_phase<2>(p, grid, stream); launch_phase<3>(p, grid, stream);
    launch_phase<4>(p, grid, stream); launch_phase<5>(p, grid, stream); launch_phase<6>(p, grid, stream); launch_phase<7>(p, grid, stream);
    launch_phase<8>(p, grid, stream); launch_phase<9>(p, grid, stream); launch_phase<10>(p, grid, stream); launch_phase<11>(p, grid, stream);
    launch_phase<12>(p, grid, stream);
#endif
}
```

```cpp
#include <hip/hip_runtime.h>
#include <stdint.h>
#include <stdio.h>

#ifndef MK_ONE_LAUNCH
#define MK_ONE_LAUNCH 1
#endif

#define LAS __attribute__((address_space(3)))
typedef unsigned short bf16_t;
typedef short bf16x8 __attribute__((ext_vector_type(8)));
typedef float f32x4 __attribute__((ext_vector_type(4)));
typedef unsigned u32x4 __attribute__((ext_vector_type(4)));
typedef unsigned u32x2 __attribute__((ext_vector_type(2)));

constexpr int T = 32768, DM = 1024, SEQ = 4096, NBATCH = 8, NH = 4, NEXP = 32, HW = 512;
constexpr int LDS_BYTES = 163840;

#define XB_TMO      128
#define XB_XCNT(j)  (256  + 64 * (j))
#define XB_XSUB(j)  (1280 + 64 * (j))
#define XB_XGEN(j)  (2304 + 64 * (j))
#define XB_TOP      3328
#define XB_TOPGEN   3392
#define XCD_BAR_WORDS 3456
#define XB_SPIN_CAP (1u << 18)

__device__ __forceinline__ unsigned xb_ld(unsigned* p)              { return __hip_atomic_load(p, __ATOMIC_RELAXED, __HIP_MEMORY_SCOPE_AGENT); }
__device__ __forceinline__ unsigned xb_add(unsigned* p, unsigned v) { return __hip_atomic_fetch_add(p, v, __ATOMIC_RELAXED, __HIP_MEMORY_SCOPE_AGENT); }
__device__ __forceinline__ unsigned xb_xcc_id() { return (unsigned)__builtin_amdgcn_s_getreg((3 << 11) | 20) & 0xFu; }
#define XB_SPIN(cond, bar) do { unsigned _sp = 0; while (cond) { __builtin_amdgcn_s_sleep(1); \
    if ((++_sp & 255u) == 0u) { if (xb_ld(&(bar)[XB_TMO])) break; if (_sp > XB_SPIN_CAP) { atomicAdd(&(bar)[XB_TMO], 1u); break; } } } } while (0)

struct XcdBarrier { unsigned* bar; unsigned x; volatile LAS unsigned* st; int wv; };
__device__ __forceinline__ unsigned lane_id_volatile() { unsigned l; asm volatile("v_mbcnt_lo_u32_b32 %0, -1, 0\n\tv_mbcnt_hi_u32_b32 %0, -1, %0" : "=v"(l)); return l; }
__device__ __forceinline__ bool xb_thread0(int wv) { return wv == 0 && lane_id_volatile() == 0u; }

__device__ __forceinline__ XcdBarrier xcd_barrier_post(unsigned* bar, volatile LAS unsigned* st, int wv) {
    XcdBarrier b; b.bar = bar; b.x = xb_xcc_id(); b.st = st; b.wv = wv;
    if (xb_thread0(wv)) (void)xb_add(&bar[XB_XCNT(b.x)], 1u);
    return b;
}
__device__ __forceinline__ void xcd_barrier_complete(unsigned* bar, unsigned x, unsigned& nloc, unsigned& nx) {
    const unsigned G = gridDim.x * gridDim.y * gridDim.z;
    unsigned sum, cnt, mine, sp = 0u;
    for (;;) {
        sum = 0u; cnt = 0u; mine = 0u;
#pragma unroll
        for (unsigned j = 0; j < 16; ++j) { const unsigned c = xb_ld(&bar[XB_XCNT(j)]); sum += c; cnt += (c > 0u) ? 1u : 0u; mine = (j == x) ? c : mine; }
        if (sum == G) break;
        __builtin_amdgcn_s_sleep(1);
        if ((++sp & 255u) == 0u) { if (xb_ld(&bar[XB_TMO])) break; if (sp > XB_SPIN_CAP) { atomicAdd(&bar[XB_TMO], 1u); break; } }
    }
    nloc = mine > 0u ? mine : 1u; nx = cnt > 0u ? cnt : 1u;
}
__device__ __forceinline__ void xcd_barrier(const XcdBarrier& b) {
    asm volatile("s_waitcnt vmcnt(0)" ::: "memory");
    __syncthreads();
    if (xb_thread0(b.wv)) {
        unsigned* bar = b.bar;
        __builtin_amdgcn_s_waitcnt(0);
        unsigned nloc = b.st[0], nx = b.st[1];
        if (nloc == 0u) { xcd_barrier_complete(bar, b.x, nloc, nx); b.st[0] = nloc; b.st[1] = nx; }
        const unsigned old = xb_add(&bar[XB_XSUB(b.x)], 1u);
        const unsigned gen = old / nloc;
        if (old + 1u == (gen + 1u) * nloc) {
            __builtin_amdgcn_fence(__ATOMIC_RELEASE, "agent");
            asm volatile("s_waitcnt vmcnt(0)" ::: "memory");
            const unsigned og = xb_add(&bar[XB_TOP], 1u);
            const unsigned tg = og / nx;
            if (og + 1u == (tg + 1u) * nx) xb_add(&bar[XB_TOPGEN], 1u);
            else XB_SPIN(xb_ld(&bar[XB_TOPGEN]) == tg, bar);
            __builtin_amdgcn_fence(__ATOMIC_ACQUIRE, "agent");
            xb_add(&bar[XB_XGEN(b.x)], 1u);
            asm volatile("s_waitcnt vmcnt(0)" ::: "memory");
        } else {
            XB_SPIN(xb_ld(&bar[XB_XGEN(b.x)]) == gen, bar);
            __builtin_amdgcn_fence(__ATOMIC_ACQUIRE, "agent");
            asm volatile("s_waitcnt vmcnt(0)" ::: "memory");
        }
    }
    __syncthreads();
}

__device__ __forceinline__ float bf2f(bf16_t b) { return __uint_as_float(((unsigned)b) << 16); }
typedef float f32x2_t __attribute__((ext_vector_type(2)));
typedef __bf16 bf16x2_t __attribute__((ext_vector_type(2)));
__device__ __forceinline__ unsigned pk2(float lo, float hi) { const f32x2_t v = {lo, hi}; bf16x2_t b = __builtin_convertvector(v, bf16x2_t); return *reinterpret_cast<unsigned*>(&b); }
__device__ __forceinline__ bf16_t f2bf(float f) { return (bf16_t)(pk2(f, 0.f) & 0xFFFFu); }
__device__ __forceinline__ float wave_sum(float v) {
#pragma unroll
    for (int o = 32; o >= 1; o >>= 1) v += __shfl_xor(v, o);
    return v;
}
__device__ __forceinline__ int opaque_tid(int wv) { int t = wv * 64 + (int)lane_id_volatile(); return t; }
__device__ __forceinline__ float sigmoidf_(float x) { return __builtin_amdgcn_rcpf(1.0f + __builtin_amdgcn_exp2f(-1.4426950408889634f * x)); }

struct Params {
    const float *x, *p, *g_mix, *w_in, *conv_w, *conv_b, *flt_w1, *flt_b1, *flt_wi, *flt_bi, *flt_freq, *flt_wo, *hy_d, *hy_gn,
                *lq1, *lk1, *lq2, *lk2, *subln, *w_out, *g_ffn, *router_w, *router_b, *w_gate, *b_gate, *w_up, *b_up, *w_down, *b_down,
                *w_ple, *g_ple, *w_pg, *b_pg, *g_final;
    float* out;
    unsigned* bar; int* cnt; float* lam; int* kmax;
    float2* rope; float* kt;
    bf16_t *win_t, *wout_t, *wple_t, *wpg_t, *wgu_t, *wd_t;
    int *tope, *pos, *list; float *topw, *rstd_e, *listw, *listr;
    bf16_t *xn, *q, *k, *v, *hy, *ut, *hx0t, *zt, *mixin, *hn, *act, *y, *pb, *h2b, *epre;
};

__device__ __forceinline__ float lambda_full(const Params& p) {
    float s1 = 0.f, s2 = 0.f;
    for (int i = 0; i < 64; ++i) { s1 += p.lq1[i] * p.lk1[i]; s2 += p.lq2[i] * p.lk2[i]; }
    return expf(s1) - expf(s2) + 0.2f;
}

template <class ARow, class Epi>
__device__ __forceinline__ void gemm_tile_simple(int K, ARow arow, const bf16_t* __restrict__ Bt, Epi epi) {
    const int lane = threadIdx.x & 63, wid = threadIdx.x >> 6, wm = wid & 3, wn = wid >> 2, fr = lane & 15, fq = lane >> 4;
    f32x4 acc[4][4];
#pragma unroll
    for (int i = 0; i < 4; ++i)
#pragma unroll
        for (int j = 0; j < 4; ++j) acc[i][j] = (f32x4){0.f, 0.f, 0.f, 0.f};
    const bf16_t* ap[4]; const bf16_t* bp[4];
#pragma unroll
    for (int i = 0; i < 4; ++i) ap[i] = arow(wm * 64 + i * 16 + fr) + fq * 8;
#pragma unroll
    for (int j = 0; j < 4; ++j) bp[j] = Bt + (size_t)(wn * 64 + j * 16 + fr) * K + fq * 8;
    for (int k = 0; k < K; k += 32) {
        bf16x8 a[4], b[4];
#pragma unroll
        for (int i = 0; i < 4; ++i) a[i] = *(const bf16x8*)(ap[i] + k);
#pragma unroll
        for (int j = 0; j < 4; ++j) b[j] = *(const bf16x8*)(bp[j] + k);
#pragma unroll
        for (int i = 0; i < 4; ++i)
#pragma unroll
            for (int j = 0; j < 4; ++j) acc[i][j] = __builtin_amdgcn_mfma_f32_16x16x32_bf16(b[j], a[i], acc[i][j], 0, 0, 0);
    }
#pragma unroll
    for (int i = 0; i < 4; ++i)
#pragma unroll
        for (int j = 0; j < 4; ++j) epi(wm * 64 + i * 16 + fr, wn * 64 + j * 16 + fq * 4, acc[i][j]);
}


namespace pg8 {
constexpr int BM = 256, BK = 64, HALF = 128, HTB = HALF * BK * 2, STAGE_BYTES = 8 * HTB;
__device__ __forceinline__ int lds_byte(int r, int c) { const int st = (r >> 4) * 2 + (c >> 5), rr = r & 15, cc = c & 31, ob = rr * 64 + cc * 2; return st * 1024 + (ob ^ (((ob >> 9) & 1) << 5)); }
__device__ __forceinline__ int perm32(int rho) { const int n = rho >> 4, i = rho & 15; return 8 * (i >> 2) + 4 * n + (i & 3); }
__device__ __forceinline__ void stage_rc(int b, int& R, int& C) { const int st = b / 1024, sb = b % 1024, swz = sb ^ (((sb >> 9) & 1) << 5); R = (st >> 1) * 16 + swz / 64; C = (st & 1) * 32 + (swz % 64) / 2; }

template <class Sched, class Epi>
__device__ __forceinline__ void gemm_phase(LAS unsigned char* lds, const char* Abase, int K_, const Sched& S, const Epi& E, int wv) {
    int K = K_;
    typedef typename Sched::Unit Unit;
    const int tid = opaque_tid(wv);
    const int wid = __builtin_amdgcn_readfirstlane(tid >> 6), lane = tid & 63, wr = wid >> 2, wc = wid & 3, fr = lane & 15, fq = lane >> 4;
    asm volatile("" : "+s"(K));
    const int nt = K / BK;
    int sR[2], sC[2]; unsigned voffB[2];
#pragma unroll
    for (int i = 0; i < 2; ++i) { stage_rc(tid * 16 + i * 8192, sR[i], sC[i]); const int Rb = (sR[i] & ~31) + perm32(sR[i] & 31); voffB[i] = (unsigned)(Rb * K + sC[i]) * 2u; }
    const size_t kstep = (size_t)(BK * 2);
    const size_t hstep = (size_t)HALF * K * 2;
    const unsigned ldsw = (unsigned)wid * 1024u;
    const int aoff = lds_byte(wr * 64 + fr, fq * 8), boff = lds_byte(wc * 32 + fr, fq * 8);
#define PG8_SA(b, h) (((b) * 2 + (h)) * HTB)
#define PG8_SB(b, h) ((4 + (b) * 2 + (h)) * HTB)
#define PG8_STAGEB(bufoff, gbase) do { _Pragma("unroll") for (int _i = 0; _i < 2; ++_i) \
        __builtin_amdgcn_global_load_lds((const unsigned*)((const char*)(gbase) + voffB[_i]), (LAS unsigned*)(lds + (bufoff) + ldsw + _i * 8192), 16, 0, 0); } while (0)
#define PG8_STAGEA(bufoff, gbase, o0, o1) do { \
        __builtin_amdgcn_global_load_lds((const unsigned*)((const char*)(gbase) + (o0)), (LAS unsigned*)(lds + (bufoff) + ldsw), 16, 0, 0); \
        __builtin_amdgcn_global_load_lds((const unsigned*)((const char*)(gbase) + (o1)), (LAS unsigned*)(lds + (bufoff) + ldsw + 8192), 16, 0, 0); } while (0)
#define PG8_LDA(dst, b, h) do { _Pragma("unroll") for (int m = 0; m < 4; ++m) _Pragma("unroll") for (int k = 0; k < 2; ++k) dst[m][k] = *(const LAS bf16x8*)(lds + PG8_SA(b, h) + aoff + m * 2048 + k * 1024); } while (0)
#define PG8_LDB(dst, b, h) do { _Pragma("unroll") for (int n = 0; n < 2; ++n) _Pragma("unroll") for (int k = 0; k < 2; ++k) dst[n][k] = *(const LAS bf16x8*)(lds + PG8_SB(b, h) + boff + n * 2048 + k * 1024); } while (0)
#define PG8_MMA(ai, bj, At, Bt) do { __builtin_amdgcn_s_setprio(1); _Pragma("unroll") for (int m = 0; m < 4; ++m) _Pragma("unroll") for (int n = 0; n < 2; ++n) _Pragma("unroll") for (int k = 0; k < 2; ++k) \
        acc[ai][bj][m][n] = __builtin_amdgcn_mfma_f32_16x16x32_bf16(Bt[n][k], At[m][k], acc[ai][bj][m][n], 0, 0, 0); __builtin_amdgcn_s_setprio(0); } while (0)
#define PG8_WAIT_V(n) asm volatile("s_waitcnt vmcnt(" #n ")" ::: "memory")
#define PG8_WAIT_L(n) asm volatile("s_waitcnt lgkmcnt(" #n ")" ::: "memory")
#define PG8_BAR __builtin_amdgcn_s_barrier()
#define PG8_SCHED __builtin_amdgcn_sched_barrier(0)
    Unit cur, nxt; int ui = 0;
    if (!S.next(0, cur)) return;
    f32x4 acc[2][2][4][2];
#pragma unroll
    for (int a = 0; a < 2; ++a)
#pragma unroll
        for (int b = 0; b < 2; ++b)
#pragma unroll
            for (int m = 0; m < 4; ++m)
#pragma unroll
                for (int n = 0; n < 2; ++n) acc[a][b][m][n] = (f32x4){0.f, 0.f, 0.f, 0.f};
    bf16x8 At[4][2], B0[2][2], B1[2][2];
    constexpr bool GATHER = Unit::GATHER;
    unsigned pa0 = 0, pa1 = 0, pn0 = 0, pn1 = 0;
    const unsigned rowb = S.rowbytes();
    const unsigned voffA0 = (unsigned)sR[0] * rowb + sC[0] * 2, voffA1 = (unsigned)sR[1] * rowb + sC[1] * 2;
    const unsigned cbyte = (unsigned)sC[0] * 2u;
    const size_t hstepA = (size_t)HALF * rowb;
    const char* cA = Abase; const char* nA = Abase;
    if constexpr (GATHER) {
        pa0 = cur.arow_idx(sR[0]) | (cur.arow_idx(sR[0] + 64) << 16); pa1 = cur.arow_idx(HALF + sR[0]) | (cur.arow_idx(HALF + sR[0] + 64) << 16);
    } else { cA = Abase + cur.abyte(); }
#define PG8_GLO(pk) ((((pk) & 0xFFFFu) << 11) + cbyte)
#define PG8_GHI(pk) ((((pk) >> 16) << 11) + cbyte)
#define PG8_STAGEA0(bufoff, gbase, pk) do { if constexpr (GATHER) PG8_STAGEA(bufoff, gbase, PG8_GLO(pk), PG8_GHI(pk)); else PG8_STAGEA(bufoff, gbase, voffA0, voffA1); } while (0)
#define PG8_STAGEA1(bufoff, gbase, pk) do { if constexpr (GATHER) PG8_STAGEA(bufoff, gbase, PG8_GLO(pk), PG8_GHI(pk)); else PG8_STAGEA(bufoff, (gbase) + hstepA, voffA0, voffA1); } while (0)
    const char* cB = cur.bbase();
    PG8_STAGEB(PG8_SB(0, 0), cB); PG8_STAGEA0(PG8_SA(0, 0), cA, pa0); PG8_STAGEB(PG8_SB(0, 1), cB + hstep); PG8_STAGEA1(PG8_SA(0, 1), cA, pa1);
    if (wr == 1) PG8_BAR;
    PG8_WAIT_V(4); PG8_BAR;
    PG8_STAGEB(PG8_SB(1, 0), cB + kstep); PG8_STAGEA0(PG8_SA(1, 0), cA + kstep, pa0); PG8_STAGEB(PG8_SB(1, 1), cB + hstep + kstep);
    PG8_WAIT_V(6); PG8_BAR;
    for (;;) {
        const bool has_next = S.next(ui + 1, nxt);
        const char* nB = has_next ? nxt.bbase() : cB;
        if constexpr (!GATHER) nA = has_next ? Abase + nxt.abyte() : cA;
        for (int t = 0; t < nt; t += 2) {
            const bool last = (t == nt - 2);
            if constexpr (GATHER) {
                if (t == nt - 4) {
                    int R0, C0; stage_rc(tid * 16, R0, C0);
                    if (has_next) { pn0 = nxt.arow_idx(R0) | (nxt.arow_idx(R0 + 64) << 16); pn1 = nxt.arow_idx(HALF + R0) | (nxt.arow_idx(HALF + R0 + 64) << 16); }
                    else { pn0 = pa0; pn1 = pa1; }
                }
            }
            const char* a1 = cA + (size_t)(t + 1) * kstep;
            const char* a2 = last ? nA : cA + (size_t)(t + 2) * kstep; const char* a3 = a2 + kstep;
            unsigned q0 = pa0, q1 = pa1;
            if constexpr (GATHER) { q0 = last ? pn0 : pa0; q1 = last ? pn1 : pa1; }
            const char* b2 = last ? nB : cB + (size_t)(t + 2) * kstep; const char* b3 = b2 + kstep;
            PG8_LDB(B0, 0, 0); PG8_SCHED; PG8_LDA(At, 0, 0); PG8_STAGEA1(PG8_SA(1, 1), a1, pa1);
            PG8_WAIT_L(8); PG8_BAR; PG8_WAIT_L(0); PG8_MMA(0, 0, At, B0); PG8_BAR; PG8_SCHED;
            PG8_LDB(B1, 0, 1); PG8_STAGEB(PG8_SB(0, 0), b2);
            PG8_BAR; PG8_WAIT_L(0); PG8_MMA(0, 1, At, B1); PG8_BAR;
            PG8_LDA(At, 0, 1); PG8_STAGEA0(PG8_SA(0, 0), a2, q0);
            PG8_BAR; PG8_WAIT_L(0); PG8_MMA(1, 0, At, B0); PG8_BAR; PG8_SCHED;
            PG8_STAGEB(PG8_SB(0, 1), b2 + hstep);
            PG8_WAIT_V(6); PG8_BAR; PG8_MMA(1, 1, At, B1); PG8_BAR;
            PG8_LDB(B0, 1, 0); PG8_SCHED; PG8_LDA(At, 1, 0); PG8_STAGEA1(PG8_SA(0, 1), a2, q1);
            PG8_WAIT_L(8); PG8_BAR; PG8_WAIT_L(0); PG8_MMA(0, 0, At, B0); PG8_BAR; PG8_SCHED;
            PG8_LDB(B1, 1, 1); PG8_STAGEB(PG8_SB(1, 0), b3);
            PG8_BAR; PG8_WAIT_L(0); PG8_MMA(0, 1, At, B1); PG8_BAR;
            PG8_LDA(At, 1, 1); PG8_STAGEA0(PG8_SA(1, 0), a3, q0);
            PG8_BAR; PG8_WAIT_L(0); PG8_MMA(1, 0, At, B0); PG8_BAR; PG8_SCHED;
            PG8_STAGEB(PG8_SB(1, 1), b3 + hstep);
            PG8_WAIT_V(6); PG8_BAR; PG8_MMA(1, 1, At, B1); PG8_BAR;
        }
        if (wr == 0) PG8_BAR;
        {
            int fr_e = fr, cb = wc * 32 + fq * 8; asm volatile("" : "+v"(fr_e), "+v"(cb));
#define PG8_ROW(g) (((g) >> 2) * HALF + wr * 64 + ((g) & 3) * 16 + fr_e)
            const typename Epi::ColPre cp = E.colpre(cur, cb);
            typename Epi::RowPre rp[8];
#pragma unroll
            for (int g = 0; g < 8; ++g) rp[g] = E.rowpre(cur, PG8_ROW(g), cb);
            constexpr int GB = Epi::BATCH;
#pragma unroll
            for (int b0 = 0; b0 < 8; b0 += GB) {
                typename Epi::Pre pr[GB];
#pragma unroll
                for (int gg = 0; gg < GB; ++gg) pr[gg] = E.pre(cur, PG8_ROW(b0 + gg), cb, rp[b0 + gg], cp);
#pragma unroll
                for (int gg = 0; gg < GB; ++gg) { const int g = b0 + gg;
                    E.store(cur, PG8_ROW(g), cb, acc[g >> 2][0][g & 3][0], acc[g >> 2][0][g & 3][1], acc[g >> 2][1][g & 3][0], acc[g >> 2][1][g & 3][1], rp[g], cp, pr[gg]); }
            }
#undef PG8_ROW
        }
        if (!has_next) break;
#pragma unroll
        for (int a = 0; a < 2; ++a)
#pragma unroll
            for (int b = 0; b < 2; ++b)
#pragma unroll
                for (int m = 0; m < 4; ++m)
#pragma unroll
                    for (int n = 0; n < 2; ++n) acc[a][b][m][n] = (f32x4){0.f, 0.f, 0.f, 0.f};
        cur = nxt; cB = nB; cA = nA; if constexpr (GATHER) { pa0 = pn0; pa1 = pn1; } ++ui;
        if (wr == 1) PG8_BAR;
    }
    PG8_WAIT_V(0);
    PG8_BAR;
#undef PG8_SA
#undef PG8_SB
#undef PG8_GLO
#undef PG8_GHI
#undef PG8_STAGEA0
#undef PG8_STAGEA1
#undef PG8_STAGEA
#undef PG8_STAGEB
#undef PG8_LDA
#undef PG8_LDB
#undef PG8_MMA
#undef PG8_WAIT_V
#undef PG8_WAIT_L
#undef PG8_BAR
#undef PG8_SCHED
}

struct DenseUnit {
    static constexpr bool GATHER = false;
    int pm, pn; const char* bt; unsigned rowb;
    __device__ __forceinline__ const char* bbase() const { return bt; }
    __device__ __forceinline__ size_t abyte() const { return (size_t)pm * BM * rowb; }
    __device__ __forceinline__ unsigned arow_idx(int) const { return 0u; }
};
struct DenseOrder {
    typedef DenseUnit Unit;
    int nM, nN, nwg, G, c, K; const bf16_t* Bt;
    __device__ __forceinline__ unsigned rowbytes() const { return (unsigned)K * 2u; }
    __device__ __forceinline__ void init(int M, int N, int K_, const bf16_t* Bt_, int G_, int c_) { nM = M / BM; nN = N / BM; nwg = nM * nN; G = G_; c = c_; K = K_; Bt = Bt_; }
    __device__ __forceinline__ bool next(int i, Unit& u) const {
        const long L = (long)i * G + c; if (L >= nwg) return false;
        int wgid = (int)L; { const int q = nwg / 8, r = nwg % 8, xcd = wgid % 8, off = wgid / 8; wgid = (xcd < r ? xcd * (q + 1) : r * (q + 1) + (xcd - r) * q) + off; }
        const int nig = 8 * nN, gid = wgid / nig, fm = gid * 8, gsz = (nM - fm) < 8 ? (nM - fm) : 8;
        u.pm = fm + ((wgid % nig) % gsz); u.pn = (wgid % nig) / gsz;
        u.bt = (const char*)Bt + (size_t)u.pn * BM * K * 2; u.rowb = (unsigned)K * 2u;
        return true;
    }
};
}

__device__ __forceinline__ int rowmap(int mode, int n) {
    if (mode == 1) { if (n < 1024) { const int d = n & 63; return (n & ~63) + 2 * (d & 31) + (d >> 5); } return n; }
    if (mode == 2) return (n >> 7) * 256 + (n & 127);
    if (mode == 3) return (n >> 7) * 256 + 128 + (n & 127);
    return n;
}
__device__ __forceinline__ void transpose_tile(const float* __restrict__ src, int N, bf16_t* __restrict__ dst, int K, int k0, int n0, int mode, float* tile, int lane) {
    float4 v[16];
#pragma unroll
    for (int it = 0; it < 16; ++it) v[it] = *(const float4*)(src + (size_t)(k0 + it * 4 + (lane >> 4)) * N + n0 + (lane & 15) * 4);
#pragma unroll
    for (int it = 0; it < 16; ++it) { float* t = tile + (it * 4 + (lane >> 4)) * 65 + (lane & 15) * 4; t[0] = v[it].x; t[1] = v[it].y; t[2] = v[it].z; t[3] = v[it].w; }
    asm volatile("s_waitcnt lgkmcnt(0)" ::: "memory");
#pragma unroll
    for (int it = 0; it < 8; ++it) {
        const int n = it * 8 + (lane >> 3), k8 = (lane & 7) * 8;
        u32x4 w;
        w.x = pk2(tile[(k8 + 0) * 65 + n], tile[(k8 + 1) * 65 + n]);
        w.y = pk2(tile[(k8 + 2) * 65 + n], tile[(k8 + 3) * 65 + n]);
        w.z = pk2(tile[(k8 + 4) * 65 + n], tile[(k8 + 5) * 65 + n]);
        w.w = pk2(tile[(k8 + 6) * 65 + n], tile[(k8 + 7) * 65 + n]);
        *(u32x4*)(dst + (size_t)rowmap(mode, n0 + n) * K + k0 + k8) = w;
    }
    asm volatile("s_waitcnt lgkmcnt(0)" ::: "memory");
}
__device__ __forceinline__ void transpose_matrix(const float* src, int Ksrc, int N, bf16_t* dst, int mode, int gw, int nw, float* tile, int lane) {
    const int tk = Ksrc / 64, tn = N / 64;
    for (int u = gw; u < tk * tn; u += nw) transpose_tile(src, N, dst, Ksrc, (u / tn) * 64, (u % tn) * 64, mode, tile, lane);
}

__device__ __forceinline__ void phase_prologue(const Params& p, int bid, int nblk, char* smem, int wv) {
    const int tid = opaque_tid(wv), lane = tid & 63, wid = tid >> 6;
    float* tile = (float*)smem + wid * (64 * 65);
    const int gw = bid * 8 + wid, nw = nblk * 8;
    transpose_matrix(p.w_in, 1024, 3072, p.win_t, 1, gw, nw, tile, lane);
    transpose_matrix(p.w_out, 1024, 1024, p.wout_t, 0, gw, nw, tile, lane);
    transpose_matrix(p.w_ple, 256, 1024, p.wple_t, 0, gw, nw, tile, lane);
    transpose_matrix(p.w_pg, 1024, 1024, p.wpg_t, 0, gw, nw, tile, lane);
    if (bid == 0 && tid == 0) p.lam[0] = lambda_full(p);
    for (int i = bid * 512 + tid; i < T; i += nblk * 512) p.rstd_e[i] = 0.f;
    for (int row = (bid * 8 + wid) * 2; row < T; row += nblk * 16) {
        const float4* xr0 = (const float4*)(p.x + (size_t)row * DM); const float4* xr1 = xr0 + DM / 4;
        float4 v0[4], v1[4]; float s0 = 0.f, s1 = 0.f;
#pragma unroll
        for (int i = 0; i < 4; ++i) { v0[i] = xr0[lane + 64 * i]; v1[i] = xr1[lane + 64 * i]; }
#pragma unroll
        for (int i = 0; i < 4; ++i) { s0 += v0[i].x * v0[i].x + v0[i].y * v0[i].y + v0[i].z * v0[i].z + v0[i].w * v0[i].w; s1 += v1[i].x * v1[i].x + v1[i].y * v1[i].y + v1[i].z * v1[i].z + v1[i].w * v1[i].w; }
        s0 = wave_sum(s0); s1 = wave_sum(s1);
        const float r0 = 1.0f / sqrtf(s0 * (1.0f / 1024.0f) + 1e-6f), r1 = 1.0f / sqrtf(s1 * (1.0f / 1024.0f) + 1e-6f);
#pragma unroll
        for (int i = 0; i < 4; ++i) {
            const float4 g = ((const float4*)p.g_mix)[lane + 64 * i];
            u32x2 w0, w1; w0.x = pk2(v0[i].x * r0 * g.x, v0[i].y * r0 * g.y); w0.y = pk2(v0[i].z * r0 * g.z, v0[i].w * r0 * g.w);
            w1.x = pk2(v1[i].x * r1 * g.x, v1[i].y * r1 * g.y); w1.y = pk2(v1[i].z * r1 * g.z, v1[i].w * r1 * g.w);
            *(u32x2*)(p.xn + (size_t)row * DM + (lane + 64 * i) * 4) = w0;
            *(u32x2*)(p.xn + (size_t)(row + 1) * DM + (lane + 64 * i) * 4) = w1;
        }
    }
    for (int idx = bid * 512 + tid; idx < SEQ * 32; idx += nblk * 512) {
        const int s = idx >> 5, f = idx & 31;
        const float inv = exp2f(-(float)f * (13.287712379549449f / 32.0f));
        const float ang = (float)s * inv;
        p.rope[idx] = make_float2(cosf(ang), sinf(ang));
    }
    {
        float* zs = (float*)smem;
        float* ha = zs + 16 * 36;
        float* hb = ha + 16 * 64;
        float* h3t = hb + 16 * 64;
        for (int blk = bid; blk < SEQ / 16; blk += nblk) {
            const int l0 = blk * 16;
            __syncthreads();
            for (int idx = tid; idx < 16 * 33; idx += 512) {
                const int ps = idx / 33, i = idx % 33, l = l0 + ps;
                float zi;
                if (i == 0) zi = (float)l / 4095.0f;
                else {
                    const int fi = (i - 1) & 15;
                    const float f = 1e-4f + (float)fi * ((15.0f - 1e-4f) / 15.0f);
                    const float w = (float)(2.0 * 3.14159265358979323846 / 4096.0) * (float)l;
                    const float fw = w * f;
                    zi = i <= 16 ? cosf(fw) : -sinf(fw);
                }
                zs[ps * 36 + i] = zi;
            }
            __syncthreads();
            const int j = tid & 63;
#pragma unroll
            for (int r = 0; r < 2; ++r) { const int ps = (tid >> 6) + 8 * r; float s = p.flt_b1[j];
#pragma unroll 4
                for (int i = 0; i < 33; ++i) s += zs[ps * 36 + i] * p.flt_w1[i * 64 + j];
                ha[ps * 64 + j] = sinf(p.flt_freq[j] * s); }
            __syncthreads();
#pragma unroll
            for (int r = 0; r < 2; ++r) { const int ps = (tid >> 6) + 8 * r; float s = p.flt_bi[j];
#pragma unroll 4
                for (int i = 0; i < 64; ++i) s += ha[ps * 64 + i] * p.flt_wi[i * 64 + j];
                hb[ps * 64 + j] = sinf(p.flt_freq[64 + j] * s); }
            __syncthreads();
#pragma unroll
            for (int r = 0; r < 2; ++r) { const int ps = (tid >> 6) + 8 * r; float s = p.flt_bi[64 + j];
#pragma unroll 4
                for (int i = 0; i < 64; ++i) s += hb[ps * 64 + i] * p.flt_wi[(64 + i) * 64 + j];
                h3t[j * 16 + ps] = sinf(p.flt_freq[128 + j] * s); }
            __syncthreads();
            float of[16], ob[16];
#pragma unroll
            for (int q = 0; q < 16; ++q) { of[q] = 0.f; ob[q] = 0.f; }
#pragma unroll 2
            for (int i = 0; i < 64; ++i) {
                const float wf = p.flt_wo[i * 1024 + tid], wb = p.flt_wo[i * 1024 + 512 + tid];
#pragma unroll
                for (int q4 = 0; q4 < 4; ++q4) { const float4 h = *(const float4*)(h3t + i * 16 + q4 * 4);
                    of[q4 * 4] += h.x * wf; of[q4 * 4 + 1] += h.y * wf; of[q4 * 4 + 2] += h.z * wf; of[q4 * 4 + 3] += h.w * wf;
                    ob[q4 * 4] += h.x * wb; ob[q4 * 4 + 1] += h.y * wb; ob[q4 * 4 + 2] += h.z * wb; ob[q4 * 4 + 3] += h.w * wb; }
            }
            const float mind = -4.605170185988091f / 1.5f, maxd = -4.605170185988091f / 0.3f;
            const float delta = fabsf(mind + (float)tid * ((maxd - mind) / 511.0f));
            float* kr = p.kt + (size_t)tid * 8192;
#pragma unroll
            for (int q = 0; q < 16; ++q) {
                const int l = l0 + q;
                const float dec = expf(-((float)l / 4095.0f) * delta);
                const float hf = of[q] * dec, hbk = ob[q] * dec;
                if (l == 0) { kr[4096] = hf + hbk; kr[0] = 0.f; }
                else { kr[4096 + l] = hf; kr[4096 - l] = hbk; }
            }
        }
    }
}

__device__ __forceinline__ void inproj_store(const Params& p, int row, int col, f32x4 v) {
    const int b = row >> 12, s = row & 4095;
    if (col < 1024) {
        const int j = col & 63, f = j >> 1;
        const float2 c0 = p.rope[s * 32 + f], c1 = p.rope[s * 32 + f + 1];
        const float o0 = v[0] * c0.x - v[1] * c0.y, o1 = v[1] * c0.x + v[0] * c0.y;
        const float o2 = v[2] * c1.x - v[3] * c1.y, o3 = v[3] * c1.x + v[2] * c1.y;
        const int hh = (col & 511) >> 7, dd = col & 127;
        bf16_t* dst = (col < 512 ? p.q : p.k) + ((size_t)((b * NH + hh) * SEQ + s)) * 128 + dd;
        u32x2 w; w.x = pk2(o0, o1); w.y = pk2(o2, o3);
        *(u32x2*)dst = w;
    } else if (col < 1536) {
        const int hh = (col - 1024) >> 7, dd = col & 127;
        bf16_t* dst = p.v + ((size_t)((b * NH + hh) * SEQ + s)) * 128 + dd;
        u32x2 w; w.x = pk2(v[0], v[1]); w.y = pk2(v[2], v[3]);
        *(u32x2*)dst = w;
    } else {
        u32x2 w; w.x = pk2(v[0], v[1]); w.y = pk2(v[2], v[3]);
        *(u32x2*)(p.hy + (size_t)row * 1536 + (col - 1536)) = w;
    }
}
__device__ __forceinline__ u32x4 pk8(f32x4 a, f32x4 b) { u32x4 w; w.x = pk2(a[0], a[1]); w.y = pk2(a[2], a[3]); w.z = pk2(b[0], b[1]); w.w = pk2(b[2], b[3]); return w; }
struct EpiNone {};
struct EpiInproj {
    const Params& p;
    static constexpr int BATCH = 8;
    typedef EpiNone ColPre; struct RowPre { f32x4 a, b; }; typedef EpiNone Pre;
    __device__ __forceinline__ ColPre colpre(const pg8::DenseUnit&, int) const { return ColPre{}; }
    __device__ __forceinline__ RowPre rowpre(const pg8::DenseUnit& u, int r, int cb) const {
        RowPre x; x.a = (f32x4){1.f, 0.f, 1.f, 0.f}; x.b = x.a;
        if (u.pn < 4) { const int s = (u.pm * 256 + r) & 4095; const f32x4* rp = (const f32x4*)(p.rope + s * 32 + ((cb & 63) >> 1)); x.a = rp[0]; x.b = rp[1]; }
        return x;
    }
    __device__ __forceinline__ Pre pre(const pg8::DenseUnit&, int, int, const RowPre&, const ColPre&) const { return Pre{}; }
    __device__ __forceinline__ void store(const pg8::DenseUnit& u, int r, int cb, f32x4 v00, f32x4 v01, f32x4 v10, f32x4 v11, const RowPre& rp, const ColPre&, const Pre&) const {
        const int row = u.pm * 256 + r, b = row >> 12, s = row & 4095;
#pragma unroll
        for (int bj = 0; bj < 2; ++bj) {
            f32x4 v0 = bj ? v10 : v00, v1 = bj ? v11 : v01;
            const int col = u.pn * 256 + bj * 128 + cb;
            if (u.pn < 4) {
                f32x4 o0, o1;
                o0[0] = v0[0] * rp.a[0] - v0[1] * rp.a[1]; o0[1] = v0[1] * rp.a[0] + v0[0] * rp.a[1];
                o0[2] = v0[2] * rp.a[2] - v0[3] * rp.a[3]; o0[3] = v0[3] * rp.a[2] + v0[2] * rp.a[3];
                o1[0] = v1[0] * rp.b[0] - v1[1] * rp.b[1]; o1[1] = v1[1] * rp.b[0] + v1[0] * rp.b[1];
                o1[2] = v1[2] * rp.b[2] - v1[3] * rp.b[3]; o1[3] = v1[3] * rp.b[2] + v1[2] * rp.b[3];
                const int hh = (col & 511) >> 7, dd = col & 127;
                if (col < 512) { o0 = o0 * (0.125f * 1.4426950408889634f); o1 = o1 * (0.125f * 1.4426950408889634f); }
                *(u32x4*)((col < 512 ? p.q : p.k) + ((size_t)((b * NH + hh) * SEQ + s)) * 128 + dd) = pk8(o0, o1);
            } else if (u.pn < 6) {
                const int hh = (col - 1024) >> 7, dd = col & 127;
                *(u32x4*)(p.v + ((size_t)((b * NH + hh) * SEQ + s)) * 128 + dd) = pk8(v0, v1);
            } else {
                *(u32x4*)(p.hy + (size_t)row * 1536 + (col - 1536)) = pk8(v0, v1);
            }
        }
    }
};
__device__ __forceinline__ void phase_inproj(const Params& p, int bid, int nblk, char* smem, int wv) {
    pg8::DenseOrder S; S.init(T, 3072, 1024, p.win_t, nblk, bid);
    pg8::gemm_phase((LAS unsigned char*)smem, (const char*)p.xn, 1024, S, EpiInproj{p}, wv);
}

__device__ __forceinline__ void phase_hyprep(const Params& p, int bid, int nblk, char* smem, int wv) {
    bf16_t* tu = (bf16_t*)smem;
    const int tid = opaque_tid(wv);
    constexpr int NU = 8 * 64 * 8;
    for (int u0 = bid; u0 < NU; u0 += 2 * nblk) {
        bf16x8 vm[2][3], vc[2][3], vp[2][3];
#pragma unroll
        for (int q = 0; q < 2; ++q) { const int u = u0 + q * nblk < NU ? u0 + q * nblk : u0;
            const int ct = u & 7, st = (u >> 3) & 63, b = u >> 9, s = st * 64 + (tid >> 3), c8 = (tid & 7) * 8;
#pragma unroll
            for (int part = 0; part < 3; ++part) {
                const bf16_t* base = p.hy + (size_t)(b * SEQ + s) * 1536 + part * 512 + ct * 64 + c8;
                vc[q][part] = *(const bf16x8*)base;
                vm[q][part] = (bf16x8){0, 0, 0, 0, 0, 0, 0, 0}; vp[q][part] = vm[q][part];
                if (s > 0) vm[q][part] = *(const bf16x8*)(base - 1536);
                if (s < SEQ - 1) vp[q][part] = *(const bf16x8*)(base + 1536);
            } }
#pragma unroll
        for (int q = 0; q < 2; ++q) { const int u = u0 + q * nblk < NU ? u0 + q * nblk : u0;
            const int ct = u & 7, sl = tid >> 3, c8 = (tid & 7) * 8;
            float hyv[3][8];
#pragma unroll
            for (int part = 0; part < 3; ++part) { const int ch = part * 512 + ct * 64 + c8;
#pragma unroll
                for (int i = 0; i < 8; ++i)
                    hyv[part][i] = p.conv_b[ch + i] + bf2f((bf16_t)vm[q][part][i]) * p.conv_w[ch + i] + bf2f((bf16_t)vc[q][part][i]) * p.conv_w[1536 + ch + i] + bf2f((bf16_t)vp[q][part][i]) * p.conv_w[3072 + ch + i]; }
#pragma unroll
            for (int i = 0; i < 8; ++i) {
                tu[q * (2 * 64 * 72) + (c8 + i) * 72 + sl] = f2bf(hyv[0][i] * hyv[2][i]);
                tu[q * (2 * 64 * 72) + 64 * 72 + (c8 + i) * 72 + sl] = f2bf(hyv[1][i]);
            } }
        __syncthreads();
#pragma unroll
        for (int q = 0; q < 2; ++q) { const int u = u0 + q * nblk;
            if (u < NU) {
                const int ct = u & 7, st = (u >> 3) & 63, b = u >> 9, c = tid >> 3, s8 = (tid & 7) * 8;
                const size_t off = ((size_t)(ct * 64 + c) * NBATCH + b) * SEQ + st * 64 + s8;
                *(u32x4*)(p.ut + off) = *(const u32x4*)(tu + q * (2 * 64 * 72) + c * 72 + s8);
                *(u32x4*)(p.hx0t + off) = *(const u32x4*)(tu + q * (2 * 64 * 72) + 64 * 72 + c * 72 + s8);
            } }
        __syncthreads();
    }
    for (int item = bid * 512 + tid; item < NBATCH * NH * 2 * SEQ; item += nblk * 512) {
        const int key = item & 4095, grp = item >> 12, map = grp & 1, bh = grp >> 1;
        const bf16_t* kp = p.k + ((size_t)bh * SEQ + key) * 128 + map * 64;
        float ss = 0.f;
#pragma unroll
        for (int i = 0; i < 8; ++i) { const bf16x8 v = *(const bf16x8*)(kp + i * 8);
#pragma unroll
            for (int jj = 0; jj < 8; ++jj) { const float f = bf2f((bf16_t)v[jj]); ss += f * f; } }
#pragma unroll
        for (int o = 32; o >= 1; o >>= 1) ss = fmaxf(ss, __shfl_xor(ss, o));
        if ((tid & 63) == 0) atomicMax(p.kmax + grp, (int)__float_as_uint(sqrtf(ss)));
    }
}

typedef float f32x16 __attribute__((ext_vector_type(16)));
typedef short s16x4 __attribute__((ext_vector_type(4)));
constexpr float AT_SCALE = 0.125f, AT_THR = 8.f;
constexpr int AT_SHM_V = 64 * 128 * 2, AT_SHM_K = 64 * 128 * 2;
#define KSWZ(row, colB) ((row) * 256 + ((colB) ^ (((row) & 7) << 4)))
#define SBAR() __builtin_amdgcn_sched_barrier(0)
__device__ __forceinline__ int crow(int r, int hi) { return (r & 3) + 8 * (r >> 2) + 4 * hi; }
__device__ __forceinline__ unsigned cvtpk(float lo, float hi) { unsigned r; asm volatile("v_cvt_pk_bf16_f32 %0, %1, %2" : "=v"(r) : "v"(lo), "v"(hi)); return r; }
__device__ __forceinline__ void partialSM(f32x16& p0, f32x16& p1, float) {
#pragma unroll
    for (int r = 0; r < 16; ++r) p0[r] = __builtin_amdgcn_exp2f(p0[r]);
}
__device__ __forceinline__ void finishSM(f32x16& p0, f32x16& p1, float& l_reg, bf16x8& pa0, bf16x8& pa1, bf16x8& pa2, bf16x8& pa3) {
#pragma unroll
    for (int r = 0; r < 16; ++r) p1[r] = __builtin_amdgcn_exp2f(p1[r]);
    float ps = 0;
#pragma unroll
    for (int r = 0; r < 16; ++r) ps += p0[r];
#pragma unroll
    for (int r = 0; r < 16; ++r) ps += p1[r];
    l_reg += ps;
#define PK4(P, BASE, OUT) do { unsigned a0 = cvtpk(P[BASE + 0], P[BASE + 1]), a1 = cvtpk(P[BASE + 2], P[BASE + 3]);   \
    unsigned b0 = cvtpk(P[BASE + 4], P[BASE + 5]), b1 = cvtpk(P[BASE + 6], P[BASE + 7]);                              \
    auto r0 = __builtin_amdgcn_permlane32_swap(a0, b0, false, false); auto r1 = __builtin_amdgcn_permlane32_swap(a1, b1, false, false); \
    u32x4 w = {r0[0], r1[0], r0[1], r1[1]}; OUT = *reinterpret_cast<bf16x8*>(&w); } while (0)
    PK4(p0, 0, pa0); PK4(p0, 8, pa1); PK4(p1, 0, pa2); PK4(p1, 8, pa3);
#undef PK4
}
__device__ __forceinline__ void qkt(f32x16& p0, f32x16& p1, const char* Ks, const bf16x8* qr, int r32, int hi, int mb, float mC) {
#pragma unroll
    for (int r = 0; r < 16; ++r) { p0[r] = -mC; p1[r] = -mC; }
#pragma unroll
    for (int d0 = 0; d0 < 4; ++d0) { const int cb = mb + (d0 * 16 + hi * 8) * 2;
        const bf16x8 b0 = *reinterpret_cast<const bf16x8*>(Ks + KSWZ(r32, cb));
        const bf16x8 b1 = *reinterpret_cast<const bf16x8*>(Ks + KSWZ(32 + r32, cb));
        p0 = __builtin_amdgcn_mfma_f32_32x32x16_bf16(b0, qr[d0], p0, 0, 0, 0);
        p1 = __builtin_amdgcn_mfma_f32_32x32x16_bf16(b1, qr[d0], p1, 0, 0, 0); }
}
__device__ __forceinline__ int v_st(int k, int c) { const int kk = (k & ~0xC) | ((k & 4) << 1) | ((k & 8) >> 1); return ((kk >> 3) * 4 + (c >> 5)) * 512 + ((kk & 7) * 32 + (c & 31)) * 2; }
__device__ __forceinline__ int v_rd_base(int lane) { return ((lane & 3) << 3) | (((lane >> 2) & 3) << 6) | (((lane >> 4) & 1) << 5) | (((lane >> 5) & 1) << 8); }
constexpr int v_rd_off(int d0, int ks, int half) { return d0 * 512 + ks * 4096 + half * 2048; }
template <int OFF> __device__ __forceinline__ s16x4 tr_read(int vb) {
    s16x4 r; asm volatile("ds_read_b64_tr_b16 %0, %1 offset:%2" : "=&v"(r) : "v"(vb), "i"(OFF) : "memory"); return r;
}
template <int D0> __device__ __forceinline__ void pv_one(f32x16& od, int vb, bf16x8 pa0, bf16x8 pa1, bf16x8 pa2, bf16x8 pa3) {
    const s16x4 l0 = tr_read<v_rd_off(D0, 0, 0)>(vb), h0 = tr_read<v_rd_off(D0, 0, 1)>(vb), l1 = tr_read<v_rd_off(D0, 1, 0)>(vb), h1 = tr_read<v_rd_off(D0, 1, 1)>(vb);
    const s16x4 l2 = tr_read<v_rd_off(D0, 2, 0)>(vb), h2 = tr_read<v_rd_off(D0, 2, 1)>(vb), l3 = tr_read<v_rd_off(D0, 3, 0)>(vb), h3 = tr_read<v_rd_off(D0, 3, 1)>(vb);
    asm volatile("s_waitcnt lgkmcnt(0)" ::: "memory"); SBAR();
#define PKV(L, H) (bf16x8){L[0], L[1], L[2], L[3], H[0], H[1], H[2], H[3]}
    od = __builtin_amdgcn_mfma_f32_32x32x16_bf16(pa0, PKV(l0, h0), od, 0, 0, 0);
    od = __builtin_amdgcn_mfma_f32_32x32x16_bf16(pa1, PKV(l1, h1), od, 0, 0, 0);
    od = __builtin_amdgcn_mfma_f32_32x32x16_bf16(pa2, PKV(l2, h2), od, 0, 0, 0);
    od = __builtin_amdgcn_mfma_f32_32x32x16_bf16(pa3, PKV(l3, h3), od, 0, 0, 0);
#undef PKV
}
__device__ __forceinline__ void pv_d0(f32x16* o, int vb, bf16x8 pa0, bf16x8 pa1, bf16x8 pa2, bf16x8 pa3) {
    pv_one<0>(o[0], vb, pa0, pa1, pa2, pa3); pv_one<1>(o[1], vb, pa0, pa1, pa2, pa3); pv_one<2>(o[2], vb, pa0, pa1, pa2, pa3); pv_one<3>(o[3], vb, pa0, pa1, pa2, pa3);
}
__device__ __forceinline__ void attn_unit(const Params& p, int unit, char* lds, int wv) {
    const int qb = unit & 31, h = (unit >> 5) & 3, b = unit >> 7;
    const int tid = opaque_tid(wv);
    const int wid = tid >> 6, lane = tid & 63, r32 = lane & 31, hi = lane >> 5, map = wid >> 2, wq = wid & 3;
    const size_t hb = (size_t)(b * NH + h) * SEQ;
    const bf16_t* Kh = p.k + hb * 128; const bf16_t* Vh = p.v + hb * 128;
    char* V_lds = lds; char* K_lds = lds + 2 * AT_SHM_V;
    float* wsl = (float*)(lds + 2 * AT_SHM_V + 2 * AT_SHM_K) + wid * 64; float* li_l = wsl; float* al_l = wsl + 32;
    float l_reg = 0; f32x16 o[4] = {}; bf16x8 qr[4];
    const int mb = map * 128;
    __syncthreads();
    float mC;
    {
        const bf16_t* Qw = p.q + (hb + qb * 128 + wq * 32 + r32) * 128 + map * 64 + hi * 8;
        float qs = 0.f;
#pragma unroll
        for (int d0 = 0; d0 < 4; ++d0) { qr[d0] = *(const bf16x8*)(Qw + d0 * 16);
#pragma unroll
            for (int jj = 0; jj < 8; ++jj) { const float f = bf2f((bf16_t)qr[d0][jj]); qs += f * f; } }
        qs += __shfl_xor(qs, 32);
        const float kmx = __uint_as_float((unsigned)p.kmax[(b * NH + h) * 2 + map]);
        mC = sqrtf(qs) * kmx;
    }
    const int sr = tid >> 4, sc = (tid & 15) * 8, vst0 = v_st(sr, sc), vst1 = v_st(32 + sr, sc);
    const int vb0 = (int)(uintptr_t)(LAS char*)V_lds + v_rd_base(lane);
    struct { bf16x8 vs0, vs1, ks0, ks1; } sr_[1];
#define SLOAD(i, k0) do { sr_[i].vs0 = *(const bf16x8*)(&Vh[(size_t)((k0) + sr) * 128 + sc]); sr_[i].vs1 = *(const bf16x8*)(&Vh[(size_t)((k0) + 32 + sr) * 128 + sc]); \
    sr_[i].ks0 = *(const bf16x8*)(&Kh[(size_t)((k0) + sr) * 128 + sc]); sr_[i].ks1 = *(const bf16x8*)(&Kh[(size_t)((k0) + 32 + sr) * 128 + sc]); } while (0)
#define SWRITE(bb, i) do { *(bf16x8*)(V_lds + (bb) * AT_SHM_V + vst0) = sr_[i].vs0;          \
    *(bf16x8*)(V_lds + (bb) * AT_SHM_V + vst1) = sr_[i].vs1; const int kc = sc * 2;               \
    *(bf16x8*)(K_lds + (bb) * AT_SHM_K + KSWZ(sr, kc)) = sr_[i].ks0;                       \
    *(bf16x8*)(K_lds + (bb) * AT_SHM_K + KSWZ(32 + sr, kc)) = sr_[i].ks1; } while (0)
#define SWAIT() asm volatile("s_waitcnt vmcnt(0)" ::: "memory")
    f32x16 pA0, pA1, pB0, pB1; bf16x8 pa0, pa1, pa2, pa3; constexpr int NT = SEQ / 64;
    SLOAD(0, 0); SWAIT(); SWRITE(0, 0); __syncthreads();
    qkt(pA0, pA1, K_lds, qr, r32, hi, mb, mC); partialSM(pA0, pA1, mC);
    SLOAD(0, 64);
    SWAIT(); SWRITE(1, 0); __syncthreads();
    for (int j = 1; j + 1 < NT; j += 2) {
        SBAR(); qkt(pB0, pB1, K_lds + AT_SHM_K, qr, r32, hi, mb, mC);
        finishSM(pA0, pA1, l_reg, pa0, pa1, pa2, pa3); SBAR();
        SLOAD(0, (j + 1) * 64); SBAR();
        pv_d0(o, vb0, pa0, pa1, pa2, pa3); partialSM(pB0, pB1, mC);
        __syncthreads(); SWAIT(); SWRITE(0, 0);
        __syncthreads();
        SBAR(); qkt(pA0, pA1, K_lds, qr, r32, hi, mb, mC);
        finishSM(pB0, pB1, l_reg, pa0, pa1, pa2, pa3); SBAR();
        SLOAD(0, (j + 2) * 64); SBAR();
        pv_d0(o, vb0 + AT_SHM_V, pa0, pa1, pa2, pa3); partialSM(pA0, pA1, mC);
        __syncthreads(); SWAIT(); SWRITE(1, 0);
        __syncthreads();
    }
    SBAR(); qkt(pB0, pB1, K_lds + AT_SHM_K, qr, r32, hi, mb, mC);
    finishSM(pA0, pA1, l_reg, pa0, pa1, pa2, pa3); SBAR();
    pv_d0(o, vb0, pa0, pa1, pa2, pa3); partialSM(pB0, pB1, mC);
    __syncthreads();
    finishSM(pB0, pB1, l_reg, pa0, pa1, pa2, pa3); SBAR();
    pv_d0(o, vb0 + AT_SHM_V, pa0, pa1, pa2, pa3);
    l_reg += __shfl_xor(l_reg, 32);
    if (hi == 0) li_l[r32] = l_reg;
    asm volatile("s_waitcnt lgkmcnt(0)" ::: "memory");
    float rli[16];
#pragma unroll
    for (int r = 0; r < 16; ++r) rli[r] = 1.0f / li_l[crow(r, hi)];
    __syncthreads();
    float* X = (float*)lds;
    bf16_t* Ob = (bf16_t*)(lds + 65536 + 2048) + wq * 4096;
    if (map == 1) {
        const float lam = p.lam[0];
#pragma unroll
        for (int r = 0; r < 16; ++r)
#pragma unroll
            for (int d0 = 0; d0 < 4; ++d0) X[(wq * 32 + crow(r, hi)) * 128 + d0 * 32 + r32] = o[d0][r] * rli[r] * lam;
    }
    __syncthreads();
    if (map == 0) {
        float ss[16];
#pragma unroll
        for (int r = 0; r < 16; ++r) { ss[r] = 0.f;
#pragma unroll
            for (int d0 = 0; d0 < 4; ++d0) { const float f = o[d0][r] * rli[r] - X[(wq * 32 + crow(r, hi)) * 128 + d0 * 32 + r32]; o[d0][r] = f; ss[r] += f * f; } }
#pragma unroll
        for (int r = 0; r < 16; ++r) {
#pragma unroll
            for (int off = 16; off >= 1; off >>= 1) ss[r] += __shfl_xor(ss[r], off);
            ss[r] = 0.8f / sqrtf(ss[r] * (1.0f / 128.0f) + 1e-5f);
        }
#pragma unroll
        for (int d0 = 0; d0 < 4; ++d0) { const float g = p.subln[d0 * 32 + r32];
#pragma unroll
            for (int r = 0; r < 16; ++r) Ob[crow(r, hi) * 128 + d0 * 32 + r32] = f2bf(o[d0][r] * ss[r] * g); }
        asm volatile("s_waitcnt lgkmcnt(0)" ::: "memory");
        bf16_t* dst = p.mixin + (size_t)(b * SEQ + qb * 128 + wq * 32) * DM + h * 128;
#pragma unroll
        for (int i = 0; i < 8; ++i) { const int id = lane + 64 * i, row = id >> 4, c8 = (id & 15) * 8;
            *(u32x4*)(dst + (size_t)row * DM + c8) = *(const u32x4*)(Ob + row * 128 + c8); }
    }
#undef SLOAD
#undef SWRITE
#undef SWAIT
}

constexpr int CV_UPITCH = 144;
constexpr int CV_UBYTES = 8 * 64 * CV_UPITCH;
constexpr int CV_CPITCH = 8200 * 2 + 64;
__device__ __forceinline__ void conv_unit(const Params& p, int c, char* smem, int wv) {
    const int tid = opaque_tid(wv);
    const int lane = tid & 63, b = __builtin_amdgcn_readfirstlane(tid >> 6), fr = lane & 15, fq = lane >> 4;
    LAS char* lds = (LAS char*)smem;
    LAS char* Us = lds;
    LAS char* Cs = lds + CV_UBYTES;
    __syncthreads();
    {
        const u32x4* src = (const u32x4*)(p.ut + (size_t)c * NBATCH * SEQ);
#pragma unroll
        for (int i = 0; i < 8; ++i) { const int id = tid + i * 512, row = id >> 3, ch = id & 7; *(LAS u32x4*)(Us + row * CV_UPITCH + ch * 16) = src[id]; }
    }
    {
        const float* kt = p.kt + (size_t)c * 8192;
#pragma unroll 11
        for (int id = tid; id < 4 * 4100; id += 512) {
            const int r = id / 4100, pos = (id % 4100) * 2;
            const int i0 = 8192 + r - pos, i1 = i0 - 1;
            const float v0 = (i0 >= 1 && i0 <= 8191) ? kt[i0] : 0.f, v1 = (i1 >= 1 && i1 <= 8191) ? kt[i1] : 0.f;
            *(LAS unsigned*)(Cs + r * CV_CPITCH + pos * 2) = pk2(v0, v1);
        }
    }
    __syncthreads();
    f32x4 acc[4][4];
#pragma unroll
    for (int mi = 0; mi < 4; ++mi)
#pragma unroll
        for (int ni = 0; ni < 4; ++ni) acc[mi][ni] = (f32x4){0.f, 0.f, 0.f, 0.f};
    LAS char* Ub = Us + b * 64 * CV_UPITCH;
    const int r4 = fr & 3;
    LAS char* lb = Cs + r4 * CV_CPITCH + (8 * fq - fr + r4 + 4096 - 48) * 2;
    typedef short s16x4 __attribute__((ext_vector_type(4)));
#define CV_LOAD(D, BF, AF) do { LAS char* bD_ = lb - 128 * (D); \
        _Pragma("unroll") for (int ni = 0; ni < 4; ++ni) _Pragma("unroll") for (int kk = 0; kk < 2; ++kk) { const int off_ = (kk * 32 + (3 - ni) * 16) * 2; \
            const s16x4 lo_ = *(const LAS s16x4*)(bD_ + off_), hi_ = *(const LAS s16x4*)(bD_ + off_ + 8); \
            BF[ni][kk] = (bf16x8){lo_[0], lo_[1], lo_[2], lo_[3], hi_[0], hi_[1], hi_[2], hi_[3]}; } \
        _Pragma("unroll") for (int mi = 0; mi < 4; ++mi) { const int ru_ = 16 * mi + fr - (D); const int rc_ = ru_ < 0 ? 0 : (ru_ > 63 ? 63 : ru_); \
            AF[mi][0] = *(const LAS bf16x8*)(Ub + rc_ * CV_UPITCH + fq * 16); AF[mi][1] = *(const LAS bf16x8*)(Ub + rc_ * CV_UPITCH + 64 + fq * 16); \
            if ((unsigned)ru_ >= 64u) { AF[mi][0] = (bf16x8){0, 0, 0, 0, 0, 0, 0, 0}; AF[mi][1] = AF[mi][0]; } } } while (0)
#define CV_MMA(D, BF, AF) do { const int ilo_ = (D) > 0 ? (D) : 0, ihi_ = (D) < 0 ? 63 + (D) : 63; \
        _Pragma("unroll") for (int mi = 0; mi < 4; ++mi) { if (16 * mi + 15 >= ilo_ && 16 * mi <= ihi_) { \
            _Pragma("unroll") for (int ni = 0; ni < 4; ++ni) { \
                acc[mi][ni] = __builtin_amdgcn_mfma_f32_16x16x32_bf16(AF[mi][0], BF[ni][0], acc[mi][ni], 0, 0, 0); \
                acc[mi][ni] = __builtin_amdgcn_mfma_f32_16x16x32_bf16(AF[mi][1], BF[ni][1], acc[mi][ni], 0, 0, 0); } } } } while (0)
    {
        bf16x8 bA[4][2], aA[4][2], bB[4][2], aB[4][2];
        CV_LOAD(-63, bA, aA);
        for (int D = -63; D <= 61; D += 2) {
            CV_LOAD(D + 1, bB, aB);
            CV_MMA(D, bA, aA);
            CV_LOAD(D + 2, bA, aA);
            CV_MMA(D + 1, bB, aB);
        }
        CV_MMA(63, bA, aA);
    }
#undef CV_LOAD
#undef CV_MMA
    const float dsk = p.hy_d[c];
#pragma unroll
    for (int mi = 0; mi < 4; ++mi)
#pragma unroll
        for (int ni = 0; ni < 4; ++ni)
#pragma unroll
            for (int rg = 0; rg < 4; ++rg) {
                LAS bf16_t* up = (LAS bf16_t*)(Ub + (16 * mi + 4 * fq + rg) * CV_UPITCH + (16 * ni + fr) * 2);
                const float y = acc[mi][ni][rg] + dsk * bf2f(*up);
                *up = f2bf(y);
            }
    asm volatile("s_waitcnt lgkmcnt(0)" ::: "memory");
    {
        const size_t base = ((size_t)c * NBATCH + b) * SEQ;
        bf16x8 hvs[8];
#pragma unroll
        for (int i = 0; i < 8; ++i) { const int id = lane + 64 * i; hvs[i] = *(const bf16x8*)(p.hx0t + base + (id >> 3) * 64 + (id & 7) * 8); }
#pragma unroll
        for (int i = 0; i < 8; ++i) {
            const int id = lane + 64 * i, row = id >> 3, c8 = (id & 7) * 8;
            const bf16x8 yv = *(const LAS bf16x8*)(Ub + row * CV_UPITCH + c8 * 2);
            const bf16x8 hv = hvs[i];
            u32x4 w;
            w.x = pk2(bf2f((bf16_t)yv[0]) * bf2f((bf16_t)hv[0]), bf2f((bf16_t)yv[1]) * bf2f((bf16_t)hv[1]));
            w.y = pk2(bf2f((bf16_t)yv[2]) * bf2f((bf16_t)hv[2]), bf2f((bf16_t)yv[3]) * bf2f((bf16_t)hv[3]));
            w.z = pk2(bf2f((bf16_t)yv[4]) * bf2f((bf16_t)hv[4]), bf2f((bf16_t)yv[5]) * bf2f((bf16_t)hv[5]));
            w.w = pk2(bf2f((bf16_t)yv[6]) * bf2f((bf16_t)hv[6]), bf2f((bf16_t)yv[7]) * bf2f((bf16_t)hv[7]));
            *(u32x4*)(p.zt + base + row * 64 + c8) = w;
        }
    }
}
__device__ __forceinline__ void moew_unit(const Params& p, int tu, char* smem, int wv) {
    const int tid = opaque_tid(wv), lane = tid & 63, wid = tid >> 6;
    LAS char* lds = (LAS char*)smem;
    __syncthreads();
    f32x4 ld[16];
#define MW_SRC(t, SRC, DST, MODE, K0, N0) do { const int tile_ = tu * 6 + (t), mat_ = tile_ >> 5, tt_ = tile_ & 31, which_ = mat_ / 32, e_ = mat_ % 32; \
        SRC = (which_ == 0 ? p.w_gate : which_ == 1 ? p.w_up : p.w_down) + (size_t)e_ * 1048576; \
        DST = which_ == 2 ? p.wd_t + (size_t)e_ * 1048576 : p.wgu_t + (size_t)e_ * 2097152; MODE = which_ == 0 ? 2 : which_ == 1 ? 3 : 0; K0 = (tt_ >> 2) * 128; N0 = (tt_ & 3) * 256; } while (0)
    {
        const float* src; bf16_t* dst; int mode, k0, n0; MW_SRC(0, src, dst, mode, k0, n0);
#pragma unroll
        for (int i = 0; i < 16; ++i) ld[i] = *(const f32x4*)(src + (size_t)(k0 + 16 * wid + i) * 1024 + n0 + lane * 4);
    }
    for (int t = 0; t < 6; ++t) {
        LAS char* buf = lds + (t & 1) * 65536;
#pragma unroll
        for (int c = 0; c < 4; ++c) {
            u32x4 w0, w1;
            w0.x = pk2(ld[0][c], ld[1][c]); w0.y = pk2(ld[2][c], ld[3][c]); w0.z = pk2(ld[4][c], ld[5][c]); w0.w = pk2(ld[6][c], ld[7][c]);
            w1.x = pk2(ld[8][c], ld[9][c]); w1.y = pk2(ld[10][c], ld[11][c]); w1.z = pk2(ld[12][c], ld[13][c]); w1.w = pk2(ld[14][c], ld[15][c]);
            LAS char* row = buf + (4 * lane + c) * 256;
            *(LAS u32x4*)(row + (((2 * wid) ^ (lane & 15)) << 4)) = w0;
            *(LAS u32x4*)(row + (((2 * wid + 1) ^ (lane & 15)) << 4)) = w1;
        }
        const float* src; bf16_t* dst; int mode, k0, n0; MW_SRC(t, src, dst, mode, k0, n0);
        if (t + 1 < 6) {
            const float* src2; bf16_t* dst2; int mode2, k02, n02; MW_SRC(t + 1, src2, dst2, mode2, k02, n02);
#pragma unroll
            for (int i = 0; i < 16; ++i) ld[i] = *(const f32x4*)(src2 + (size_t)(k02 + 16 * wid + i) * 1024 + n02 + lane * 4);
        }
        __syncthreads();
#pragma unroll
        for (int i = 0; i < 8; ++i) {
            const int n = i * 32 + (tid >> 4), kc = tid & 15;
            const u32x4 w = *(const LAS u32x4*)(buf + n * 256 + ((kc ^ ((n >> 2) & 15)) << 4));
            *(u32x4*)(dst + (size_t)rowmap(mode, n0 + n) * 1024 + k0 + kc * 8) = w;
        }
    }
#undef MW_SRC
}
__device__ __forceinline__ void phase_mix(const Params& p, int bid, int nblk, char* smem, int wv) {
    const int nsteps = (2048 + nblk - 1) / nblk;
    for (int j = 0; j < nsteps; ++j) {
        const int u = j * nblk + (bid + j) % nblk;
        if (u >= 2048) continue;
        const int g = u >> 3, r = u & 7;
        if (r < 4) attn_unit(p, ((g >> 5) * 4 + r) * 32 + (g & 31), smem, wv);
        else if (r < 6) conv_unit(p, g * 2 + (r - 4), smem, wv);
        else moew_unit(p, g * 2 + (r - 6), smem, wv);
    }
}

__device__ __forceinline__ void phase_hypost(const Params& p, int bid, int nblk, char* smem, int wv) {
    float* tz = (float*)smem;
    const int tid = opaque_tid(wv);
    constexpr int NU = 8 * 64 * 8;
    for (int u0 = bid; u0 < NU; u0 += 4 * nblk) {
        bf16x8 v[4];
#pragma unroll
        for (int q = 0; q < 4; ++q) { const int u = u0 + q * nblk; v[q] = (bf16x8){0, 0, 0, 0, 0, 0, 0, 0};
            if (u < NU) { const int g = u & 7, st = (u >> 3) & 63, b = u >> 9, s0 = st * 64, c = tid >> 3, s8 = (tid & 7) * 8;
                v[q] = *(const bf16x8*)(p.zt + ((size_t)(g * 64 + c) * NBATCH + b) * SEQ + s0 + s8); } }
#pragma unroll
        for (int q = 0; q < 4; ++q) { const int c = tid >> 3, s8 = (tid & 7) * 8;
#pragma unroll
            for (int i = 0; i < 8; ++i) tz[q * (64 * 65) + c * 65 + s8 + i] = bf2f((bf16_t)v[q][i]); }
        __syncthreads();
#pragma unroll
        for (int q = 0; q < 4; ++q) { const int u = u0 + q * nblk;
            if (u < NU) {
                const int g = u & 7, st = (u >> 3) & 63, b = u >> 9, s0 = st * 64;
                const int s = tid >> 3, c8 = (tid & 7) * 8;
                float z[8]; float ss = 0.f;
#pragma unroll
                for (int i = 0; i < 8; ++i) { z[i] = tz[q * (64 * 65) + (c8 + i) * 65 + s]; ss += z[i] * z[i]; }
                ss += __shfl_xor(ss, 1); ss += __shfl_xor(ss, 2); ss += __shfl_xor(ss, 4);
                const float rstd = 1.0f / sqrtf(ss * (1.0f / 64.0f) + 1e-6f);
                u32x4 w;
                const float* gn = p.hy_gn + g * 64 + c8;
                w.x = pk2(z[0] * rstd * gn[0], z[1] * rstd * gn[1]); w.y = pk2(z[2] * rstd * gn[2], z[3] * rstd * gn[3]);
                w.z = pk2(z[4] * rstd * gn[4], z[5] * rstd * gn[5]); w.w = pk2(z[6] * rstd * gn[6], z[7] * rstd * gn[7]);
                *(u32x4*)(p.mixin + (size_t)(b * SEQ + s0 + s) * DM + 512 + g * 64 + c8) = w;
            } }
        __syncthreads();
    }
}

struct EpiOutproj {
    const Params& p;
    static constexpr int BATCH = 4;
    typedef EpiNone ColPre; typedef EpiNone RowPre; struct Pre { f32x4 x[2][2]; };
    __device__ __forceinline__ ColPre colpre(const pg8::DenseUnit&, int) const { return ColPre{}; }
    __device__ __forceinline__ RowPre rowpre(const pg8::DenseUnit&, int, int) const { return RowPre{}; }
    __device__ __forceinline__ Pre pre(const pg8::DenseUnit& u, int r, int cb, const RowPre&, const ColPre&) const {
        const float* xp = p.x + (size_t)(u.pm * 256 + r) * DM + u.pn * 256 + cb; Pre x;
        x.x[0][0] = *(const f32x4*)xp; x.x[0][1] = *(const f32x4*)(xp + 4); x.x[1][0] = *(const f32x4*)(xp + 128); x.x[1][1] = *(const f32x4*)(xp + 132); return x; }
    __device__ __forceinline__ void store(const pg8::DenseUnit& u, int r, int cb, f32x4 v00, f32x4 v01, f32x4 v10, f32x4 v11, const RowPre&, const ColPre&, const Pre& x) const {
        float* op = p.out + (size_t)(u.pm * 256 + r) * DM + u.pn * 256 + cb;
        *(f32x4*)op = x.x[0][0] + v00; *(f32x4*)(op + 4) = x.x[0][1] + v01; *(f32x4*)(op + 128) = x.x[1][0] + v10; *(f32x4*)(op + 132) = x.x[1][1] + v11; }
};
__device__ __forceinline__ void phase_outproj(const Params& p, int bid, int nblk, char* smem, int wv) {
    pg8::DenseOrder S; S.init(T, 1024, 1024, p.wout_t, nblk, bid);
    pg8::gemm_phase((LAS unsigned char*)smem, (const char*)p.mixin, 1024, S, EpiOutproj{p}, wv);
}

constexpr int RT_PITCH = 1032;
__device__ __forceinline__ void phase_router(const Params& p, int bid, int nblk, char* smem, int wv) {
    const int tid = opaque_tid(wv), lane = tid & 63, wid = tid >> 6, fr = lane & 15, fq = lane >> 4;
    bf16_t* rwh = (bf16_t*)smem;
    bf16_t* rwl = rwh + 32 * RT_PITCH;
    float* lgs = (float*)(smem + 2 * 32 * RT_PITCH * 2) + wid * 512;
#pragma unroll 8
    for (int i = tid; i < 1024 * 32; i += 512) {
        const int k = i >> 5, e = i & 31; const float w = p.router_w[i];
        const bf16_t h = f2bf(w); rwh[e * RT_PITCH + k] = h; rwl[e * RT_PITCH + k] = f2bf(w - bf2f(h));
    }
    __syncthreads();
    int* hist = (int*)(smem + 2 * 32 * RT_PITCH * 2 + 8 * 2048);
    for (int g0 = bid * 8; g0 < T / 16; g0 += nblk * 8) {
        const int grp = g0 + wid; const bool live = grp < T / 16;
        const int t0 = (live ? grp : 0) * 16;
        if (tid < 32) hist[tid] = 0;
        const float* hrow = p.out + (size_t)(t0 + fr) * DM + fq * 8;
        bf16_t* hnrow = p.hn + (size_t)(t0 + fr) * DM + fq * 8;
        f32x4 acc0 = (f32x4){0.f, 0.f, 0.f, 0.f}, acc1 = acc0; float ss = 0.f;
#pragma unroll 4
        for (int ks = 0; ks < 32; ++ks) {
            const f32x4 h0 = *(const f32x4*)(hrow + ks * 32), h1 = *(const f32x4*)(hrow + ks * 32 + 4);
            const f32x4 g0 = *(const f32x4*)(p.g_ffn + ks * 32 + fq * 8), g1 = *(const f32x4*)(p.g_ffn + ks * 32 + fq * 8 + 4);
            ss += h0[0] * h0[0] + h0[1] * h0[1] + h0[2] * h0[2] + h0[3] * h0[3] + h1[0] * h1[0] + h1[1] * h1[1] + h1[2] * h1[2] + h1[3] * h1[3];
            const f32x4 x0 = h0 * g0, x1 = h1 * g1;
            const u32x4 hi = pk8(x0, x1);
            f32x4 r0, r1;
            r0[0] = x0[0] - __uint_as_float(hi.x << 16); r0[1] = x0[1] - __uint_as_float(hi.x & 0xFFFF0000u); r0[2] = x0[2] - __uint_as_float(hi.y << 16); r0[3] = x0[3] - __uint_as_float(hi.y & 0xFFFF0000u);
            r1[0] = x1[0] - __uint_as_float(hi.z << 16); r1[1] = x1[1] - __uint_as_float(hi.z & 0xFFFF0000u); r1[2] = x1[2] - __uint_as_float(hi.w << 16); r1[3] = x1[3] - __uint_as_float(hi.w & 0xFFFF0000u);
            const u32x4 lo = pk8(r0, r1);
            if (live) *(u32x4*)(hnrow + ks * 32) = hi;
            const bf16x8 ah = *reinterpret_cast<const bf16x8*>(&hi), al = *reinterpret_cast<const bf16x8*>(&lo);
            const bf16x8 bh0 = *(const bf16x8*)(rwh + fr * RT_PITCH + ks * 32 + fq * 8), bh1 = *(const bf16x8*)(rwh + (16 + fr) * RT_PITCH + ks * 32 + fq * 8);
            const bf16x8 bl0 = *(const bf16x8*)(rwl + fr * RT_PITCH + ks * 32 + fq * 8), bl1 = *(const bf16x8*)(rwl + (16 + fr) * RT_PITCH + ks * 32 + fq * 8);
            acc0 = __builtin_amdgcn_mfma_f32_16x16x32_bf16(ah, bh0, acc0, 0, 0, 0); acc1 = __builtin_amdgcn_mfma_f32_16x16x32_bf16(ah, bh1, acc1, 0, 0, 0);
            acc0 = __builtin_amdgcn_mfma_f32_16x16x32_bf16(al, bh0, acc0, 0, 0, 0); acc1 = __builtin_amdgcn_mfma_f32_16x16x32_bf16(al, bh1, acc1, 0, 0, 0);
            acc0 = __builtin_amdgcn_mfma_f32_16x16x32_bf16(ah, bl0, acc0, 0, 0, 0); acc1 = __builtin_amdgcn_mfma_f32_16x16x32_bf16(ah, bl1, acc1, 0, 0, 0);
        }
        ss += __shfl_xor(ss, 16); ss += __shfl_xor(ss, 32);
#pragma unroll
        for (int rg = 0; rg < 4; ++rg) { lgs[(4 * fq + rg) * 32 + fr] = acc0[rg]; lgs[(4 * fq + rg) * 32 + 16 + fr] = acc1[rg]; }
        asm volatile("s_waitcnt lgkmcnt(0)" ::: "memory");
        const int tk = lane >> 2;
        const float rstd = 1.0f / sqrtf(__shfl(ss, tk) * (1.0f / 1024.0f) + 1e-6f);
        float lg[32];
#pragma unroll
        for (int e4 = 0; e4 < 8; ++e4) { const f32x4 v = *(const f32x4*)(lgs + tk * 32 + e4 * 4); const f32x4 bb = *(const f32x4*)(p.router_b + e4 * 4);
            lg[4 * e4] = v[0] * rstd + bb[0]; lg[4 * e4 + 1] = v[1] * rstd + bb[1]; lg[4 * e4 + 2] = v[2] * rstd + bb[2]; lg[4 * e4 + 3] = v[3] * rstd + bb[3]; }
        int te[4]; float tl[4];
#pragma unroll
        for (int k = 0; k < 4; ++k) {
            float best = -3.0e38f; int bi = 0;
#pragma unroll
            for (int e = 0; e < 32; ++e) { if (lg[e] > best) { best = lg[e]; bi = e; } }
            te[k] = bi; tl[k] = best;
#pragma unroll
            for (int e = 0; e < 32; ++e) if (e == bi) lg[e] = -3.0e38f;
        }
        const float e1 = expf(tl[1] - tl[0]), e2 = expf(tl[2] - tl[0]), e3 = expf(tl[3] - tl[0]);
        const float inv = 1.0f / (1.0f + e1 + e2 + e3);
        const int kk = lane & 3;
        const int my_e = kk == 0 ? te[0] : kk == 1 ? te[1] : kk == 2 ? te[2] : te[3];
        const float my_w = (kk == 0 ? 1.0f : kk == 1 ? e1 : kk == 2 ? e2 : e3) * inv;
        __syncthreads();
        int lp = 0;
        if (live) lp = atomicAdd(hist + my_e, 1);
        __syncthreads();
        if (tid < 32) { const int n = hist[tid]; hist[32 + tid] = n ? atomicAdd(p.cnt + tid, n) : 0; }
        __syncthreads();
        if (live) {
            const int asg = grp * 64 + lane;
            const int ps = hist[32 + my_e] + lp;
            p.list[my_e * T + ps] = asg; p.listw[my_e * T + ps] = my_w; p.listr[my_e * T + ps] = rstd;
            p.tope[asg] = my_e; p.topw[asg] = my_w; p.pos[asg] = ps;
        }
        __syncthreads();
    }
    for (int i = bid * 512 + tid; i < T * 256 / 4; i += 4 * nblk * 512) {
        float4 pv[4];
#pragma unroll
        for (int q = 0; q < 4; ++q) { const int ii = i + q * nblk * 512; pv[q] = ii < T * 256 / 4 ? ((const float4*)p.p)[ii] : make_float4(0.f, 0.f, 0.f, 0.f); }
#pragma unroll
        for (int q = 0; q < 4; ++q) { const int ii = i + q * nblk * 512; if (ii < T * 256 / 4) { u32x2 w; w.x = pk2(pv[q].x, pv[q].y); w.y = pk2(pv[q].z, pv[q].w); *(u32x2*)(p.pb + (size_t)ii * 4) = w; } }
    }
}

struct MoeTab { int tiles[33]; int start[33]; };
__device__ __forceinline__ void moe_setup(const Params& p, MoeTab* tab, int wv) {
    __syncthreads();
    if (xb_thread0(wv)) {
        int a = 0, b = 0;
        for (int e = 0; e < 32; ++e) { const int c = p.cnt[e]; tab->tiles[e] = a; tab->start[e] = b; a += (c + 255) >> 8; b += c; }
        tab->tiles[32] = a; tab->start[32] = b;
    }
    __syncthreads();
}
__device__ __forceinline__ int moe_find(const MoeTab* tab, int tile) {
    int e = 0;
#pragma unroll
    for (int i = 0; i < 32; ++i) if (tile >= tab->tiles[i + 1]) e = i + 1;
    return e;
}

struct MoeUnit1 {
    static constexpr bool GATHER = true;
    int e, tn, nvalid, slot0; const int* lst; const float* lstr; const char* bt;
    __device__ __forceinline__ const char* bbase() const { return bt; }
    __device__ __forceinline__ size_t abyte() const { return 0; }
    __device__ __forceinline__ unsigned arow_idx(int r) const { const int rr = r < nvalid ? r : nvalid - 1; return (unsigned)(lst[rr] >> 2); }
};
struct MoeUnit2 {
    static constexpr bool GATHER = false;
    int e, tn, nvalid, slot0; const int* lst; const float* lstw; const char* bt;
    __device__ __forceinline__ const char* bbase() const { return bt; }
    __device__ __forceinline__ size_t abyte() const { return (size_t)slot0 * 2048; }
    __device__ __forceinline__ unsigned arow_idx(int) const { return 0u; }
};
template <class U, int NT  > struct MoeOrder {
    typedef U Unit;
    const MoeTab* tab; const Params* p; int G, c;
    __device__ __forceinline__ unsigned rowbytes() const { return 2048u; }
    __device__ __forceinline__ bool next(int i, Unit& u) const {
        int tile, tn;
        if (G == 256) { const int x = c & 7, j = c >> 3; constexpr int TPX = 32 / NT; tile = i * (256 / NT) + x * TPX + j / NT; tn = j % NT; }
        else { const long L = (long)i * G + c; tile = (int)(L / NT); tn = (int)(L % NT); }
        if (tile >= __builtin_amdgcn_readfirstlane(tab->tiles[32])) return false;
        const int e = __builtin_amdgcn_readfirstlane(moe_find(tab, tile)), mt = tile - __builtin_amdgcn_readfirstlane(tab->tiles[e]);
        const int st0 = __builtin_amdgcn_readfirstlane(tab->start[e]), cnt = __builtin_amdgcn_readfirstlane(tab->start[e + 1]) - st0;
        u.e = e; u.tn = tn; u.nvalid = cnt - mt * 256 < 256 ? cnt - mt * 256 : 256; u.slot0 = st0 + mt * 256;
        u.lst = p->list + (size_t)e * T + mt * 256;
        fill(u, e, mt, tn);
        return true;
    }
    __device__ __forceinline__ void fill(MoeUnit1& u, int e, int mt, int tn) const { u.bt = (const char*)(p->wgu_t + (size_t)e * 2097152 + (size_t)tn * 256 * 1024); u.lstr = p->listr + (size_t)e * T + mt * 256; }
    __device__ __forceinline__ void fill(MoeUnit2& u, int e, int mt, int tn) const { u.bt = (const char*)(p->wd_t + (size_t)e * 1048576 + (size_t)tn * 256 * 1024); u.lstw = p->listw + (size_t)e * T + mt * 256; }
};
struct EpiMoe1 {
    const Params& p;
    static constexpr int BATCH = 8;
    struct ColPre { f32x4 bg[2], bu[2]; }; typedef float RowPre; typedef EpiNone Pre;
    __device__ __forceinline__ ColPre colpre(const MoeUnit1& u, int cb) const { const int j = u.e * 1024 + u.tn * 128 + cb; ColPre x;
        x.bg[0] = *(const f32x4*)(p.b_gate + j); x.bg[1] = *(const f32x4*)(p.b_gate + j + 4); x.bu[0] = *(const f32x4*)(p.b_up + j); x.bu[1] = *(const f32x4*)(p.b_up + j + 4); return x; }
    __device__ __forceinline__ RowPre rowpre(const MoeUnit1& u, int r, int) const { return r < u.nvalid ? u.lstr[r] : 0.f; }
    __device__ __forceinline__ Pre pre(const MoeUnit1&, int, int, const RowPre&, const ColPre&) const { return Pre{}; }
    __device__ __forceinline__ void store(const MoeUnit1& u, int r, int cb, f32x4 g0, f32x4 g1, f32x4 u0, f32x4 u1, const RowPre& rs, const ColPre& cp, const Pre&) const {
        if (r < u.nvalid) {
            f32x4 ga = g0 * rs + cp.bg[0], gb = g1 * rs + cp.bg[1], ua = u0 * rs + cp.bu[0], ub = u1 * rs + cp.bu[1];
#pragma unroll
            for (int i = 0; i < 4; ++i) { ga[i] = fminf(ga[i], 7.0f); gb[i] = fminf(gb[i], 7.0f); ua[i] = __builtin_amdgcn_fmed3f(ua[i], -7.0f, 7.0f); ub[i] = __builtin_amdgcn_fmed3f(ub[i], -7.0f, 7.0f); }
            f32x4 ea = ga * (-1.702f * 1.4426950408889634f), eb = gb * (-1.702f * 1.4426950408889634f);
#pragma unroll
            for (int i = 0; i < 4; ++i) { ea[i] = __builtin_amdgcn_exp2f(ea[i]); eb[i] = __builtin_amdgcn_exp2f(eb[i]); }
            ea = ea + 1.0f; eb = eb + 1.0f;
#pragma unroll
            for (int i = 0; i < 4; ++i) { ea[i] = __builtin_amdgcn_rcpf(ea[i]); eb[i] = __builtin_amdgcn_rcpf(eb[i]); }
            const f32x4 sa = ga * ea, sb = gb * eb;
            const f32x4 a0 = ua * sa + sa, a1 = ub * sb + sb;
            *(u32x4*)(p.act + (size_t)(u.slot0 + r) * DM + u.tn * 128 + cb) = pk8(a0, a1);
        }
    }
};
__device__ __forceinline__ void phase_moe1(const Params& p, int bid, int nblk, char* smem, int wv) {
    MoeTab* tab = (MoeTab*)(smem + 131072);
    moe_setup(p, tab, wv);
    MoeOrder<MoeUnit1, 8> S; S.tab = tab; S.p = &p; S.G = nblk; S.c = bid;
    pg8::gemm_phase((LAS unsigned char*)smem, (const char*)p.hn, 1024, S, EpiMoe1{p}, wv);
}
struct EpiMoe2 {
    const Params& p;
    static constexpr int BATCH = 2;
    struct ColPre { f32x4 bd[2][2]; }; struct RowPre { int asg; float w; }; struct Pre { f32x4 h[2][2]; };
    __device__ __forceinline__ ColPre colpre(const MoeUnit2& u, int cb) const { const float* bp = p.b_down + u.e * 1024 + u.tn * 256 + cb; ColPre x;
        x.bd[0][0] = *(const f32x4*)bp; x.bd[0][1] = *(const f32x4*)(bp + 4); x.bd[1][0] = *(const f32x4*)(bp + 128); x.bd[1][1] = *(const f32x4*)(bp + 132); return x; }
    __device__ __forceinline__ RowPre rowpre(const MoeUnit2& u, int r, int) const { RowPre x; x.asg = -1; x.w = 0.f; if (r < u.nvalid) { x.asg = u.lst[r]; x.w = u.lstw[r]; } return x; }
    __device__ __forceinline__ Pre pre(const MoeUnit2& u, int, int cb, const RowPre& rp, const ColPre&) const {
        Pre x; x.h[0][0] = (f32x4){0.f, 0.f, 0.f, 0.f}; x.h[0][1] = x.h[0][0]; x.h[1][0] = x.h[0][0]; x.h[1][1] = x.h[0][0];
        if (rp.asg >= 0 && (rp.asg & 3) == 0) { const float* hp = p.out + (size_t)(rp.asg >> 2) * DM + u.tn * 256 + cb;
            x.h[0][0] = *(const f32x4*)hp; x.h[0][1] = *(const f32x4*)(hp + 4); x.h[1][0] = *(const f32x4*)(hp + 128); x.h[1][1] = *(const f32x4*)(hp + 132); }
        return x; }
    __device__ __forceinline__ void store(const MoeUnit2& u, int, int cb, f32x4 v00, f32x4 v01, f32x4 v10, f32x4 v11, const RowPre& rp, const ColPre& cp, const Pre& x) const {
        if (rp.asg >= 0) {
            const int tok = rp.asg >> 2, k = rp.asg & 3, col = u.tn * 256 + cb;
            const f32x4 a = (v00 + cp.bd[0][0]) * rp.w, b = (v01 + cp.bd[0][1]) * rp.w, c = (v10 + cp.bd[1][0]) * rp.w, d = (v11 + cp.bd[1][1]) * rp.w;
            if (k == 0) { float* hp = p.out + (size_t)tok * DM + col;
                *(f32x4*)hp = x.h[0][0] + a; *(f32x4*)(hp + 4) = x.h[0][1] + b; *(f32x4*)(hp + 128) = x.h[1][0] + c; *(f32x4*)(hp + 132) = x.h[1][1] + d; }
            else { bf16_t* yp = p.y + ((size_t)tok * 3 + (k - 1)) * DM + col; *(u32x4*)yp = pk8(a, b); *(u32x4*)(yp + 128) = pk8(c, d); }
        }
    }
};
__device__ __forceinline__ void phase_moe2(const Params& p, int bid, int nblk, char* smem, int wv) {
    MoeTab* tab = (MoeTab*)(smem + 131072);
    moe_setup(p, tab, wv);
    MoeOrder<MoeUnit2, 4> S; S.tab = tab; S.p = &p; S.G = nblk; S.c = bid;
    pg8::gemm_phase((LAS unsigned char*)smem, (const char*)p.act, 1024, S, EpiMoe2{p}, wv);
}
struct EpiPle {
    const Params& p;
    static constexpr int BATCH = 8;
    typedef EpiNone ColPre; typedef EpiNone RowPre; typedef EpiNone Pre;
    __device__ __forceinline__ ColPre colpre(const pg8::DenseUnit&, int) const { return ColPre{}; }
    __device__ __forceinline__ RowPre rowpre(const pg8::DenseUnit&, int, int) const { return RowPre{}; }
    __device__ __forceinline__ Pre pre(const pg8::DenseUnit&, int, int, const RowPre&, const ColPre&) const { return Pre{}; }
    __device__ __forceinline__ void store(const pg8::DenseUnit& u, int r, int cb, f32x4 v00, f32x4 v01, f32x4 v10, f32x4 v11, const RowPre&, const ColPre&, const Pre&) const {
        const int row = u.pm * 256 + r;
        bf16_t* ep = p.epre + (size_t)row * DM + u.pn * 256 + cb;
        const u32x4 w0 = pk8(v00, v01), w1 = pk8(v10, v11);
        *(u32x4*)ep = w0; *(u32x4*)(ep + 128) = w1;
        float s = 0.f;
#pragma unroll
        for (int i = 0; i < 4; ++i) { const unsigned a = w0[i], b = w1[i];
            const float a0 = __uint_as_float(a << 16), a1 = __uint_as_float(a & 0xFFFF0000u), b0 = __uint_as_float(b << 16), b1 = __uint_as_float(b & 0xFFFF0000u);
            s += a0 * a0 + a1 * a1 + b0 * b0 + b1 * b1; }
        s += __shfl_xor(s, 16); s += __shfl_xor(s, 32);
        if (((cb >> 3) & 3) == 0) atomicAdd(p.rstd_e + row, s); }
};
__device__ __forceinline__ void phase_ple(const Params& p, int bid, int nblk, char* smem, int wv) {
    pg8::DenseOrder S; S.init(T, 1024, 256, p.wple_t, nblk, bid);
    pg8::gemm_phase((LAS unsigned char*)smem, (const char*)p.pb, 256, S, EpiPle{p}, wv);
}
__device__ __forceinline__ void phase_combine(const Params& p, int bid, int nblk, char* smem, int wv) {
    const int tid = opaque_tid(wv), lane = tid & 63, wid = tid >> 6;
    for (int t0 = (bid * 8 + wid) * 2; t0 < T; t0 += nblk * 16) {
        float4 h[2][4]; u32x2 yv[2][4][3];
#pragma unroll
        for (int rr = 0; rr < 2; ++rr)
#pragma unroll
            for (int i = 0; i < 4; ++i) { const int c4 = lane + 64 * i; h[rr][i] = ((const float4*)(p.out + (size_t)(t0 + rr) * DM))[c4];
#pragma unroll
                for (int k = 0; k < 3; ++k) yv[rr][i][k] = *(const u32x2*)(p.y + ((size_t)(t0 + rr) * 3 + k) * DM + c4 * 4); }
#pragma unroll
        for (int rr = 0; rr < 2; ++rr)
#pragma unroll
            for (int i = 0; i < 4; ++i) { const int c4 = lane + 64 * i; float4 hh = h[rr][i];
#pragma unroll
                for (int k = 0; k < 3; ++k) { const u32x2 y = yv[rr][i][k];
                    hh.x += __uint_as_float(y.x << 16); hh.y += __uint_as_float(y.x & 0xFFFF0000u); hh.z += __uint_as_float(y.y << 16); hh.w += __uint_as_float(y.y & 0xFFFF0000u); }
                ((float4*)(p.out + (size_t)(t0 + rr) * DM))[c4] = hh;
                u32x2 w; w.x = pk2(hh.x, hh.y); w.y = pk2(hh.z, hh.w);
                *(u32x2*)(p.h2b + (size_t)(t0 + rr) * DM + c4 * 4) = w; }
    }
}
struct EpiGate {
    const Params& p;
    static constexpr int BATCH = 2;
    struct ColPre { f32x4 bg[2][2], gp[2][2]; }; typedef float RowPre; struct Pre { f32x4 h[2][2]; u32x4 ev[2]; };
    __device__ __forceinline__ ColPre colpre(const pg8::DenseUnit& u, int cb) const { ColPre x;
#pragma unroll
        for (int bj = 0; bj < 2; ++bj)
#pragma unroll
            for (int n = 0; n < 2; ++n) { const int c = u.pn * 256 + bj * 128 + cb + 4 * n; x.bg[bj][n] = *(const f32x4*)(p.b_pg + c); x.gp[bj][n] = *(const f32x4*)(p.g_ple + c); }
        return x; }
    __device__ __forceinline__ RowPre rowpre(const pg8::DenseUnit& u, int r, int) const { return __builtin_amdgcn_rsqf(p.rstd_e[u.pm * 256 + r] * (1.0f / 1024.0f) + 1e-6f); }
    __device__ __forceinline__ Pre pre(const pg8::DenseUnit& u, int r, int cb, const RowPre&, const ColPre&) const {
        const size_t off = (size_t)(u.pm * 256 + r) * DM + u.pn * 256 + cb; Pre x;
        x.h[0][0] = *(const f32x4*)(p.out + off); x.h[0][1] = *(const f32x4*)(p.out + off + 4); x.h[1][0] = *(const f32x4*)(p.out + off + 128); x.h[1][1] = *(const f32x4*)(p.out + off + 132);
        x.ev[0] = *(const u32x4*)(p.epre + off); x.ev[1] = *(const u32x4*)(p.epre + off + 128); return x; }
    __device__ __forceinline__ void store(const pg8::DenseUnit& u, int r, int cb, f32x4 v00, f32x4 v01, f32x4 v10, f32x4 v11, const RowPre& rs, const ColPre& cp, const Pre& x) const {
        const size_t off = (size_t)(u.pm * 256 + r) * DM + u.pn * 256 + cb;
#pragma unroll
        for (int bj = 0; bj < 2; ++bj)
#pragma unroll
            for (int n = 0; n < 2; ++n) {
                const f32x4 v = bj ? (n ? v11 : v10) : (n ? v01 : v00);
                const unsigned w0 = n ? x.ev[bj].z : x.ev[bj].x, w1 = n ? x.ev[bj].w : x.ev[bj].y;
                f32x4 e; e[0] = __uint_as_float(w0 << 16); e[1] = __uint_as_float(w0 & 0xFFFF0000u); e[2] = __uint_as_float(w1 << 16); e[3] = __uint_as_float(w1 & 0xFFFF0000u);
                f32x4 h = x.h[bj][n];
#pragma unroll
                for (int i = 0; i < 4; ++i) h[i] += sigmoidf_(v[i] + cp.bg[bj][n][i]) * (e[i] * rs * cp.gp[bj][n][i]);
                *(f32x4*)(p.out + off + bj * 128 + n * 4) = h;
            }
    }
};
__device__ __forceinline__ void phase_gate(const Params& p, int bid, int nblk, char* smem, int wv) {
    pg8::DenseOrder S; S.init(T, 1024, 1024, p.wpg_t, nblk, bid);
    pg8::gemm_phase((LAS unsigned char*)smem, (const char*)p.h2b, 1024, S, EpiGate{p}, wv);
}
__device__ __forceinline__ void phase_final(const Params& p, int bid, int nblk, char* smem, int wv) {
    const int tid = opaque_tid(wv), lane = tid & 63, wid = tid >> 6;
    float4 g[4];
#pragma unroll
    for (int i = 0; i < 4; ++i) g[i] = ((const float4*)p.g_final)[lane + 64 * i];
    for (int t = (bid * 8 + wid) * 2; t < T; t += nblk * 16) {
        float4* hr0 = (float4*)(p.out + (size_t)t * DM); float4* hr1 = hr0 + DM / 4;
        float4 v0[4], v1[4]; float s0 = 0.f, s1 = 0.f;
#pragma unroll
        for (int i = 0; i < 4; ++i) { v0[i] = hr0[lane + 64 * i]; v1[i] = hr1[lane + 64 * i]; }
#pragma unroll
        for (int i = 0; i < 4; ++i) { s0 += v0[i].x * v0[i].x + v0[i].y * v0[i].y + v0[i].z * v0[i].z + v0[i].w * v0[i].w; s1 += v1[i].x * v1[i].x + v1[i].y * v1[i].y + v1[i].z * v1[i].z + v1[i].w * v1[i].w; }
        s0 = wave_sum(s0); s1 = wave_sum(s1);
        const float r0 = __builtin_amdgcn_rsqf(s0 * (1.0f / 1024.0f) + 1e-6f), r1 = __builtin_amdgcn_rsqf(s1 * (1.0f / 1024.0f) + 1e-6f);
#pragma unroll
        for (int i = 0; i < 4; ++i) {
            hr0[lane + 64 * i] = make_float4(v0[i].x * r0 * g[i].x, v0[i].y * r0 * g[i].y, v0[i].z * r0 * g[i].z, v0[i].w * r0 * g[i].w);
            hr1[lane + 64 * i] = make_float4(v1[i].x * r1 * g[i].x, v1[i].y * r1 * g[i].y, v1[i].z * r1 * g[i].z, v1[i].w * r1 * g[i].w);
        }
    }
}

template <int PH> __device__ __forceinline__ void run_phase(const Params& p, int bid, int nblk, char* smem, int wv) {
    if constexpr (PH == 0) phase_prologue(p, bid, nblk, smem, wv);
    else if constexpr (PH == 1) phase_inproj(p, bid, nblk, smem, wv);
    else if constexpr (PH == 2) phase_hyprep(p, bid, nblk, smem, wv);
    else if constexpr (PH == 3) phase_mix(p, bid, nblk, smem, wv);
    else if constexpr (PH == 4) phase_hypost(p, bid, nblk, smem, wv);
    else if constexpr (PH == 5) phase_outproj(p, bid, nblk, smem, wv);
    else if constexpr (PH == 6) phase_router(p, bid, nblk, smem, wv);
    else if constexpr (PH == 7) phase_moe1(p, bid, nblk, smem, wv);
    else if constexpr (PH == 8) phase_moe2(p, bid, nblk, smem, wv);
    else if constexpr (PH == 9) { phase_ple(p, bid, nblk, smem, wv); phase_combine(p, bid, nblk, smem, wv); }
    else if constexpr (PH == 10) {}
    else if constexpr (PH == 11) phase_gate(p, bid, nblk, smem, wv);
    else if constexpr (PH == 12) phase_final(p, bid, nblk, smem, wv);
}

template <int PH> __global__ void __launch_bounds__(512, 2) k_phase(Params p) {
    extern __shared__ __attribute__((aligned(16))) char smem[];
    run_phase<PH>(p, blockIdx.x, gridDim.x, smem, __builtin_amdgcn_readfirstlane(threadIdx.x >> 6));
}

__global__ void __launch_bounds__(512, 2) k_mega(Params p) {
    extern __shared__ __attribute__((aligned(16))) char smem[];
    const int bid = blockIdx.x, nblk = gridDim.x, wv = __builtin_amdgcn_readfirstlane(threadIdx.x >> 6);
    uint4* xbw = (uint4*)(smem + LDS_BYTES - 16);
    if (xb_thread0(wv)) *xbw = make_uint4(0u, 0u, 0u, 0u);
    __syncthreads();
    XcdBarrier bar = xcd_barrier_post(p.bar, (volatile LAS unsigned*)xbw, wv);
    run_phase<0>(p, bid, nblk, smem, wv); xcd_barrier(bar);
    run_phase<1>(p, bid, nblk, smem, wv); xcd_barrier(bar);
    run_phase<2>(p, bid, nblk, smem, wv); xcd_barrier(bar);
    run_phase<3>(p, bid, nblk, smem, wv); xcd_barrier(bar);
    run_phase<4>(p, bid, nblk, smem, wv); xcd_barrier(bar);
    run_phase<5>(p, bid, nblk, smem, wv); xcd_barrier(bar);
    run_phase<6>(p, bid, nblk, smem, wv); xcd_barrier(bar);
    run_phase<7>(p, bid, nblk, smem, wv); xcd_barrier(bar);
    run_phase<8>(p, bid, nblk, smem, wv); xcd_barrier(bar);
    run_phase<9>(p, bid, nblk, smem, wv); xcd_barrier(bar);
    run_phase<11>(p, bid, nblk, smem, wv); xcd_barrier(bar);
    run_phase<12>(p, bid, nblk, smem, wv);
}

template <int PH> static void launch_phase(const Params& p, int grid, hipStream_t stream) {
    static bool attr = false;
    if (!attr) { (void)hipFuncSetAttribute((const void*)k_phase<PH>, hipFuncAttributeMaxDynamicSharedMemorySize, LDS_BYTES); attr = true; }
    hipLaunchKernelGGL(k_phase<PH>, dim3(grid), dim3(512), LDS_BYTES, stream, p);
}

extern "C" void kernel_launch(void* const* d_in, const int* in_sizes, int n_in,
                              void* d_out, int out_size, void* d_ws, size_t ws_size,
                              hipStream_t stream) {
    constexpr size_t MiB = 1048576;
    char* ws = (char*)d_ws;
    size_t off = 0;
    auto take = [&](size_t bytes) { char* r = ws + off; off += (bytes + 255) & ~(size_t)255; return r; };
    Params p{};
    const float** in = (const float**)&p.x;
    for (int i = 0; i < 34; ++i) in[i] = (const float*)d_in[i];
    p.out = (float*)d_out;
    char* ctrl = take(65536);
    p.bar = (unsigned*)ctrl; p.cnt = (int*)(ctrl + 16384); p.lam = (float*)(ctrl + 32768); p.kmax = (int*)(ctrl + 20480);
    p.rope = (float2*)take(1 * MiB);
    p.kt = (float*)take(16 * MiB);
    p.pb = (bf16_t*)p.kt;
    p.win_t = (bf16_t*)take(6 * MiB); p.wout_t = (bf16_t*)take(2 * MiB); p.wple_t = (bf16_t*)take(MiB / 2); p.wpg_t = (bf16_t*)take(2 * MiB);
    p.tope = (int*)take(MiB / 2); p.topw = (float*)take(MiB / 2); p.pos = (int*)take(MiB / 2); p.list = (int*)take(4 * MiB); p.listw = (float*)take(4 * MiB); p.listr = (float*)take(4 * MiB); p.rstd_e = (float*)take(MiB / 8);
    p.wd_t = (bf16_t*)take(64 * MiB);
    p.wgu_t = (bf16_t*)take(128 * MiB);
    char* dyn = ws + off;
    p.xn = (bf16_t*)dyn; p.ut = (bf16_t*)dyn; p.hx0t = (bf16_t*)(dyn + 32 * MiB);
    p.q = (bf16_t*)(dyn + 64 * MiB); p.k = (bf16_t*)(dyn + 96 * MiB); p.v = (bf16_t*)(dyn + 128 * MiB);
    p.hy = (bf16_t*)(dyn + 160 * MiB); p.zt = (bf16_t*)(dyn + 160 * MiB); p.mixin = (bf16_t*)(dyn + 192 * MiB);
    p.hn = (bf16_t*)dyn; p.act = (bf16_t*)(dyn + 64 * MiB);
    p.y = p.wgu_t;
    p.h2b = (bf16_t*)(dyn + 64 * MiB); p.epre = (bf16_t*)(dyn + 128 * MiB);
    const size_t need = off + 64 * MiB + (size_t)(131072 + 256) * 2048;
    if (ws_size < need || n_in != 34 || out_size != T * DM) { fprintf(stderr, "kernel_launch: bad sizes ws %zu need %zu\n", ws_size, need); return; }

    (void)hipMemsetAsync(ctrl, 0, 32768, stream);
#if MK_ONE_LAUNCH
    static int grid = 0;
    if (!grid) {
        int dev = 0, cus = 0, per_cu = 0;
        (void)hipGetDevice(&dev);
        (void)hipDeviceGetAttribute(&cus, hipDeviceAttributeMultiprocessorCount, dev);
        (void)hipFuncSetAttribute((const void*)k_mega, hipFuncAttributeMaxDynamicSharedMemorySize, LDS_BYTES);
        (void)hipOccupancyMaxActiveBlocksPerMultiprocessor(&per_cu, (const void*)k_mega, 512, LDS_BYTES);
        grid = cus * (per_cu < 1 ? per_cu : 1);
    }
    if (grid > 0) hipLaunchKernelGGL(k_mega, dim3(grid), dim3(512), LDS_BYTES, stream, p);
#else
    const int grid = 256;
    launch_phase<0>(p, grid, stream); launch_phase<1>(p, grid, stream); launch_phase<2>(p, grid, stream); launch_phase<3>(p, grid, stream);
    launch_phase<4>(p, grid, stream); launch_phase<5>(p, grid, stream); launch_phase<6>(p, grid, stream); launch_phase<7>(p, grid, stream);
    launch_phase<8>(p, grid, stream); launch_phase<9>(p, grid, stream); launch_phase<10>(p, grid, stream); launch_phase<11>(p, grid, stream);
    launch_phase<12>(p, grid, stream);
#endif
}
```
